# Optimizing an MI355X kernel written in HIP

```python
import jax
import jax.numpy as jnp
from jax import lax
import numpy as np

D_MODEL = 2048
BATCH = 8
SEQ = 2048
DEPTH = 1

CHUNK = 64
LEFT_CHUNKS = 8
BAND = (LEFT_CHUNKS + 1) * CHUNK
HEAD_DIM = 128
ATTN_WIDTH = D_MODEL // 2
ATTN_HEADS = ATTN_WIDTH // HEAD_DIM
MAX_REL = 128
GMLP_WIDTH = D_MODEL - ATTN_WIDTH
GMLP_GROUP_DIM = 128
GMLP_GROUPS = GMLP_WIDTH // GMLP_GROUP_DIM
SPATIAL = 128
MIX_WIDTH = ATTN_WIDTH + GMLP_WIDTH
IN_WIDTH = 3 * ATTN_WIDTH + 2 * GMLP_WIDTH
D_FF = 4 * D_MODEL
N_MOD = 6
EPS = 1e-6
NEG_INF = -1e30

kernel_name = 'streaming_hybrid_attn_gmlp_block'


def rms_norm(x, g):
    xf = x.astype(jnp.float32)
    y = xf * lax.rsqrt(jnp.mean(xf * xf, axis=-1, keepdims=True) + EPS)
    return (y * g.astype(jnp.float32)).astype(x.dtype)


def modulate(h, shift, scale):
    return h * (1 + scale[:, None, :]) + shift[:, None, :]


def chunk_band(t, nc):
    tp = jnp.pad(t, ((0, 0), (LEFT_CHUNKS, 0), (0, 0), (0, 0), (0, 0)))
    return jnp.concatenate([tp[:, i:i + nc] for i in range(LEFT_CHUNKS + 1)], axis=2)


def chunked_rel_attention(q, k, v, q_g, k_g, rel_bias):
    B, S = q.shape[0], q.shape[1]
    nc = S // CHUNK
    q = rms_norm(q, q_g).reshape(B, nc, CHUNK, ATTN_HEADS, HEAD_DIM)
    k = chunk_band(rms_norm(k, k_g).reshape(B, nc, CHUNK, ATTN_HEADS, HEAD_DIM), nc)
    v = chunk_band(v.reshape(B, nc, CHUNK, ATTN_HEADS, HEAD_DIM), nc)
    scores = jnp.einsum('bcqhd,bckhd->bhcqk', q, k).astype(jnp.float32) * (HEAD_DIM ** -0.5)
    qi = jnp.arange(CHUNK)[:, None]
    kj = jnp.arange(BAND)[None, :]
    rel = jnp.clip(qi + LEFT_CHUNKS * CHUNK - kj, -MAX_REL, MAX_REL) + MAX_REL
    bias = rel_bias.astype(jnp.float32)[:, rel]
    key_chunk = jnp.arange(nc)[:, None] - LEFT_CHUNKS + jnp.arange(BAND)[None, :] // CHUNK
    valid = key_chunk >= 0
    scores = jnp.where(valid[None, None, :, None, :], scores + bias[None, :, None], NEG_INF)
    probs = jax.nn.softmax(scores, axis=-1).astype(v.dtype)
    out = jnp.einsum('bhcqk,bckhd->bcqhd', probs, v)
    return out.reshape(B, S, ATTN_WIDTH)


def spatial_gating(u, v, v_g, w_s, b_s):
    B, S = u.shape[0], u.shape[1]
    nb = S // SPATIAL
    v = rms_norm(v.reshape(B, S, GMLP_GROUPS, GMLP_GROUP_DIM), v_g)
    v = v.reshape(B, nb, SPATIAL, GMLP_GROUPS, GMLP_GROUP_DIM)
    t = jnp.arange(SPATIAL)
    mask = (t[:, None] // CHUNK) >= (t[None, :] // CHUNK)
    w = jnp.where(mask[None], w_s, 0)
    y = jnp.einsum('gts,bnsgc->bntgc', w, v) + jnp.transpose(b_s)[:, :, None]
    out = u.reshape(B, nb, SPATIAL, GMLP_GROUPS, GMLP_GROUP_DIM) * y
    return out.reshape(B, S, GMLP_WIDTH)


def setup_inputs(seed: int = 0) -> dict:
    key = jax.random.key(seed)
    ks = jax.random.split(key, 18)
    f32 = jnp.float32
    L = DEPTH

    def nrm(k, shape, s):
        return jax.random.normal(k, shape, f32) * s

    return {
        'x': nrm(ks[0], (BATCH, SEQ, D_MODEL), 1.0),
        'c': nrm(ks[1], (BATCH, D_MODEL), 1.0),
        'w_ada': nrm(ks[2], (L, D_MODEL, N_MOD * D_MODEL), D_MODEL ** -0.5),
        'b_ada': nrm(ks[3], (L, N_MOD * D_MODEL), 0.01),
        'mix_norm_g': 1.0 + nrm(ks[4], (L, D_MODEL), 0.01),
        'w_in': nrm(ks[5], (L, D_MODEL, IN_WIDTH), D_MODEL ** -0.5),
        'q_norm_g': 1.0 + nrm(ks[6], (L, HEAD_DIM), 0.01),
        'k_norm_g': 1.0 + nrm(ks[7], (L, HEAD_DIM), 0.01),
        'rel_bias': nrm(ks[8], (L, ATTN_HEADS, 2 * MAX_REL + 1), 0.1),
        'gmlp_norm_g': 1.0 + nrm(ks[9], (L, GMLP_GROUPS, GMLP_GROUP_DIM), 0.01),
        'w_spatial': nrm(ks[10], (L, GMLP_GROUPS, SPATIAL, SPATIAL), SPATIAL ** -0.5),
        'b_spatial': 1.0 + nrm(ks[11], (L, GMLP_GROUPS, SPATIAL), 0.01),
        'attn_out_g': 1.0 + nrm(ks[12], (L, ATTN_WIDTH), 0.01),
        'gmlp_out_g': 1.0 + nrm(ks[13], (L, GMLP_WIDTH), 0.01),
        'w_out': nrm(ks[14], (L, MIX_WIDTH, D_MODEL), MIX_WIDTH ** -0.5),
        'ff_norm_g': 1.0 + nrm(ks[15], (L, D_MODEL), 0.01),
        'w_ff1': nrm(ks[16], (L, D_MODEL, D_FF), D_MODEL ** -0.5),
        'w_ff2': nrm(ks[17], (L, D_FF, D_MODEL), D_FF ** -0.5),
    }


def reference(x, c, w_ada, b_ada, mix_norm_g, w_in, q_norm_g, k_norm_g, rel_bias, gmlp_norm_g,
              w_spatial, b_spatial, attn_out_g, gmlp_out_g, w_out, ff_norm_g, w_ff1, w_ff2):
    B, S = x.shape[0], x.shape[1]
    head_shape = (B, S, ATTN_HEADS, HEAD_DIM)
    cond = jax.nn.silu(c)
    for l in range(DEPTH):
        mod = cond @ w_ada[l] + b_ada[l]
        shift_m, scale_m, gate_m, shift_f, scale_f, gate_f = jnp.split(mod, N_MOD, axis=-1)
        h = modulate(rms_norm(x, mix_norm_g[l]), shift_m, scale_m)
        proj = h @ w_in[l]
        q, k, v, u, z = jnp.split(
            proj, [ATTN_WIDTH, 2 * ATTN_WIDTH, 3 * ATTN_WIDTH, 3 * ATTN_WIDTH + GMLP_WIDTH], axis=-1)
        attn = chunked_rel_attention(q.reshape(head_shape), k.reshape(head_shape), v.reshape(head_shape),
                                     q_norm_g[l], k_norm_g[l], rel_bias[l])
        gm = spatial_gating(jax.nn.gelu(u, approximate=False), jax.nn.gelu(z, approximate=False),
                            gmlp_norm_g[l], w_spatial[l], b_spatial[l])
        mix = jnp.concatenate([rms_norm(attn, attn_out_g[l]), rms_norm(gm, gmlp_out_g[l])], axis=-1)
        x = x + gate_m[:, None, :] * (mix @ w_out[l])
        h = modulate(rms_norm(x, ff_norm_g[l]), shift_f, scale_f)
        x = x + gate_f[:, None, :] * (jnp.square(jax.nn.relu(h @ w_ff1[l])) @ w_ff2[l])
    return x
```

```cpp
#include <hip/hip_runtime.h>
#include <cstdio>
#include <cstdint>

#ifndef MK_N_LAUNCHES
#define MK_N_LAUNCHES 1
#endif

#define LAS __attribute__((address_space(3)))
#define GAS __attribute__((address_space(1)))
typedef unsigned short bf16_t;
typedef short bf16x8 __attribute__((ext_vector_type(8)));
typedef short v4i16_t __attribute__((ext_vector_type(4)));
typedef float f32x4 __attribute__((ext_vector_type(4)));
typedef float f32x2 __attribute__((ext_vector_type(2)));
typedef float f32x16 __attribute__((ext_vector_type(16)));
typedef unsigned u32x4 __attribute__((ext_vector_type(4)));
typedef unsigned u32x2 __attribute__((ext_vector_type(2)));
typedef __bf16 bf16x2_t __attribute__((ext_vector_type(2)));

constexpr int DM = 2048, NBATCH = 8, SEQ = 2048, MROWS = NBATCH * SEQ;
constexpr int AW = 1024, NH = 8, HD = 128, INW = 5120, DFF = 8192, NMOD = 6 * DM;
constexpr int CHUNK = 64, LEFT = 8, MAXREL = 128, NREL = 2 * MAXREL + 1;
constexpr float EPS = 1e-6f;
constexpr float LOG2E = 1.4426950408889634f;
constexpr float QSCALE = 0.08838834764831845f * LOG2E;

constexpr size_t MiB = 1u << 20;
constexpr size_t WS_CTL = 0, CTL_ZERO_BYTES = 64 * 1024;
constexpr size_t WS_MOD = 1 * MiB;
constexpr size_t WS_SSA = 2 * MiB;
constexpr size_t WS_SSG = 3 * MiB;
constexpr size_t WS_WSP = 6 * MiB;
constexpr size_t WS_WIN = 8 * MiB, WS_WOUT = 28 * MiB, WS_WF1 = 36 * MiB, WS_WF2 = 68 * MiB;
constexpr size_t WS_H = 100 * MiB;
constexpr size_t WS_Q = 164 * MiB, WS_K = 196 * MiB, WS_V = 228 * MiB, WS_U = 260 * MiB, WS_ZN = 292 * MiB;
constexpr size_t WS_MIX = 324 * MiB;
constexpr size_t WS_ACT = 164 * MiB;
constexpr size_t WS_END = 420 * MiB;

constexpr int RING_BYTES = 131072;
constexpr int XCH_OFF = RING_BYTES;
constexpr int LDSCTL_OFF = RING_BYTES + 8192, MISC_OFF = LDSCTL_OFF + 320;
constexpr int LDS_BYTES = 147456;

__device__ __forceinline__ unsigned cvtpk(float lo, float hi) { f32x2 v = {lo, hi}; bf16x2_t b = __builtin_convertvector(v, bf16x2_t); return __builtin_bit_cast(unsigned, b); }
__device__ __forceinline__ float bf2f(unsigned short h) { return __uint_as_float((unsigned)h << 16); }
__device__ __forceinline__ float wave_sum(float v) {
#pragma unroll
    for (int o = 1; o < 64; o <<= 1) v += __shfl_xor(v, o);
    return v;
}
__device__ __forceinline__ f32x2 gelu_pk(f32x2 v) {
    const f32x2 av = __builtin_elementwise_abs(v), d = av * 0.2316418882f + 1.0f;
    f32x2 t; t.x = __builtin_amdgcn_rcpf(d.x); t.y = __builtin_amdgcn_rcpf(d.y);
    f32x2 q = t * 0.5307027145f + (-0.7265760135f); q = q * t + 0.7107068705f; q = q * t + (-0.142248368f); q = q * t + 0.127414796f; q = q * t;
    const f32x2 s = (v * v) * (-0.72134752044f);
    f32x2 e; e.x = __builtin_amdgcn_exp2f(s.x); e.y = __builtin_amdgcn_exp2f(s.y);
    const f32x2 m = v * (q * e), r = v - m;
    f32x2 o; o.x = v.x < 0.f ? m.x : r.x; o.y = v.y < 0.f ? m.y : r.y; return o;
}
__device__ __forceinline__ f32x4 gelu4(f32x4 v) { const f32x2 a = gelu_pk((f32x2){v[0], v[1]}), b = gelu_pk((f32x2){v[2], v[3]}); return (f32x4){a.x, a.y, b.x, b.y}; }

namespace pg8 {
constexpr int BM = 256, BK = 64, HALF = 128, HTB = HALF * BK * 2, STAGE_BYTES = 8 * HTB, NXCD = 8, WGM = 8;
__host__ __device__ __forceinline__ int lds_byte(int r, int c) { const int st = (r >> 4) * 2 + (c >> 5), rr = r & 15, cc = c & 31, ob = rr * 64 + cc * 2; return st * 1024 + (ob ^ (((ob >> 9) & 1) << 5)); }
__host__ __device__ __forceinline__ void stage_rc(int b, int& R, int& C) { const int st = b / 1024, sb = b % 1024, swz = sb ^ (((sb >> 9) & 1) << 5); R = (st >> 1) * 16 + swz / 64; C = (st & 1) * 32 + (swz % 64) / 2; }
__host__ __device__ __forceinline__ int perm32(int rho) { const int n = rho >> 4, i = rho & 15; return 8 * (i >> 2) + 4 * n + (i & 3); }

struct Unit { int pm, pn; };
struct Gemm { const bf16_t* A; const bf16_t* Bt; int M, N, K; };

struct StaticOrder {
    int nM, nN, nwg, G, c;
    __device__ void init(int M, int N, int G_, int c_) { nM = M / BM; nN = N / BM; nwg = nM * nN; G = G_; c = c_; }
    __device__ bool next(int i, Unit& u) const {
        const long L = (long)i * G + c; if (L >= nwg) return false;
        int wgid = (int)L; { const int q = nwg / NXCD, r = nwg % NXCD, xcd = wgid % NXCD, off = wgid / NXCD; wgid = (xcd < r ? xcd * (q + 1) : r * (q + 1) + (xcd - r) * q) + off; }
        const int nig = WGM * nN, gid = wgid / nig, fm = gid * WGM, gsz = (nM - fm) < WGM ? (nM - fm) : WGM;
        u.pm = fm + ((wgid % nig) % gsz); u.pn = (wgid % nig) / gsz; return true;
    }
};

#define PG8_BARRIER() do { asm volatile("s_waitcnt lgkmcnt(0)" ::: "memory"); __builtin_amdgcn_s_barrier(); asm volatile("" ::: "memory"); } while (0)

struct EpiProj {
    static constexpr bool PERM = true, HOOKS = false; static constexpr int MIDT = 0;
    bf16_t* base;
    size_t tstride;
    const float *qg, *kg, *zg;
    LAS float* xch;
    __device__ __forceinline__ void begin(const Unit&, int, int) const {}
    __device__ __forceinline__ void mid(f32x4 (&)[2][2][4][2], int, int, int) const {}
    __device__ __forceinline__ void operator()(f32x4 (&acc)[2][2][4][2], const Unit& u, int ui, int wr, int wc, int fr, int fq) const {
        const int type = u.pn >> 2, colt = (u.pn & 3) * 256;
        bf16_t* O = base + (size_t)type * tstride;
        const int row0 = u.pm * BM + wr * 64 + fr, col0 = colt + wc * 32 + 8 * fq;
        if (type >= 3) {
#pragma unroll
            for (int ai = 0; ai < 2; ++ai)
#pragma unroll
                for (int bj = 0; bj < 2; ++bj)
#pragma unroll
                    for (int m = 0; m < 4; ++m)
#pragma unroll
                        for (int n = 0; n < 2; ++n) acc[ai][bj][m][n] = gelu4(acc[ai][bj][m][n]);
        }
        if (type == 0 || type == 1 || type == 4) {
#pragma unroll
            for (int ai = 0; ai < 2; ++ai)
#pragma unroll
                for (int m = 0; m < 4; ++m)
#pragma unroll
                    for (int bj = 0; bj < 2; ++bj) {
                        const f32x4 a = acc[ai][bj][m][0], b = acc[ai][bj][m][1];
                        float s = (a[0] * a[0] + a[1] * a[1]) + (a[2] * a[2] + a[3] * a[3]) + (b[0] * b[0] + b[1] * b[1]) + (b[2] * b[2] + b[3] * b[3]);
                        s += __shfl_xor(s, 16); s += __shfl_xor(s, 32);
                        if (fq == 0) xch[((ai * HALF + wr * 64 + m * 16 + fr) * 2 + bj) * 4 + wc] = s;
                    }
            PG8_BARRIER();
            const float* gp = type == 0 ? qg : (type == 1 ? kg : zg + (u.pn & 3) * 256);
            const float sc = type == 0 ? QSCALE : 1.0f;
            f32x4 gv[2][2];
#pragma unroll
            for (int bj = 0; bj < 2; ++bj)
#pragma unroll
                for (int n = 0; n < 2; ++n) gv[bj][n] = *(const f32x4*)(gp + (type == 4 ? bj * 128 : 0) + wc * 32 + 8 * fq + 4 * n) * sc;
#pragma unroll
            for (int ai = 0; ai < 2; ++ai)
#pragma unroll
                for (int m = 0; m < 4; ++m)
#pragma unroll
                    for (int bj = 0; bj < 2; ++bj) {
                        const f32x4 p = *(const LAS f32x4*)(xch + ((ai * HALF + wr * 64 + m * 16 + fr) * 2 + bj) * 4);
                        const float rinv = 1.0f / sqrtf(((p[0] + p[1]) + (p[2] + p[3])) * (1.0f / 128.0f) + EPS);
                        acc[ai][bj][m][0] = acc[ai][bj][m][0] * rinv * gv[bj][0]; acc[ai][bj][m][1] = acc[ai][bj][m][1] * rinv * gv[bj][1];
                    }
        }
#pragma unroll
        for (int ai = 0; ai < 2; ++ai)
#pragma unroll
            for (int m = 0; m < 4; ++m) { bf16_t* rowp = O + (size_t)(row0 + ai * HALF + m * 16) * AW + col0;
#pragma unroll
                for (int bj = 0; bj < 2; ++bj) { const f32x4 v0 = acc[ai][bj][m][0], v1 = acc[ai][bj][m][1];
                    u32x4 w; w.x = cvtpk(v0[0], v0[1]); w.y = cvtpk(v0[2], v0[3]); w.z = cvtpk(v1[0], v1[1]); w.w = cvtpk(v1[2], v1[3]);
                    *(u32x4*)(rowp + bj * HALF) = w; } }
    }
};

struct EpiRes1 {
    static constexpr bool PERM = false, HOOKS = true; static constexpr int MIDT = 16;
    const float* x; float* out; const float* mod;
    const float *ssa, *ssg;
    LAS float* rt;
    __device__ __forceinline__ void begin(const Unit&, int, int) const {}
    __device__ __forceinline__ void fill(const Unit& u, int ui, int row) const {
        const size_t gr = (size_t)u.pm * BM + row;
        const f32x4 a0 = *(const f32x4*)(ssa + gr * 8), a1 = *(const f32x4*)(ssa + gr * 8 + 4);
        const float sa = ((a0[0] + a0[1]) + (a0[2] + a0[3])) + ((a1[0] + a1[1]) + (a1[2] + a1[3]));
        const f32x4 a = *(const f32x4*)(ssg + gr * 16), b = *(const f32x4*)(ssg + gr * 16 + 4), c = *(const f32x4*)(ssg + gr * 16 + 8), d = *(const f32x4*)(ssg + gr * 16 + 12);
        const float sg = (((a[0] + a[1]) + (a[2] + a[3])) + ((b[0] + b[1]) + (b[2] + b[3]))) + (((c[0] + c[1]) + (c[2] + c[3])) + ((d[0] + d[1]) + (d[2] + d[3])));
        const float ra = 1.0f / sqrtf(sa * (1.0f / 1024.0f) + EPS), rg = 1.0f / sqrtf(sg * (1.0f / 1024.0f) + EPS);
        *(LAS f32x2*)(rt + ((ui & 3) * 256 + row) * 2) = (f32x2){ra / rg, rg};
    }
    __device__ __forceinline__ void mid(f32x4 (&acc)[2][2][4][2], int ui, int wr, int fr) const {
#pragma unroll
        for (int ai = 0; ai < 2; ++ai)
#pragma unroll
            for (int m = 0; m < 4; ++m) { const float f = rt[((ui & 3) * 256 + ai * HALF + wr * 64 + m * 16 + fr) * 2];
#pragma unroll
                for (int bj = 0; bj < 2; ++bj)
#pragma unroll
                    for (int n = 0; n < 2; ++n) acc[ai][bj][m][n] = acc[ai][bj][m][n] * f; }
    }
    __device__ __forceinline__ void operator()(f32x4 (&acc)[2][2][4][2], const Unit& u, int ui, int wr, int wc, int fr, int fq) const {
        const int row0 = u.pm * BM + wr * 64 + fr, col0 = u.pn * BM + wc * 32 + 4 * fq;
        const float* gp = mod + (size_t)(u.pm >> 3) * NMOD + 2 * DM + col0;
        f32x4 gv[2][2];
#pragma unroll
        for (int bj = 0; bj < 2; ++bj)
#pragma unroll
            for (int n = 0; n < 2; ++n) gv[bj][n] = *(const f32x4*)(gp + bj * HALF + n * 16);
#pragma unroll
        for (int ai = 0; ai < 2; ++ai)
#pragma unroll
            for (int m = 0; m < 4; ++m) { const size_t off = (size_t)(row0 + ai * HALF + m * 16) * DM + col0;
                const float rg = rt[((ui & 3) * 256 + ai * HALF + wr * 64 + m * 16 + fr) * 2 + 1];
#pragma unroll
                for (int bj = 0; bj < 2; ++bj)
#pragma unroll
                    for (int n = 0; n < 2; ++n) { const f32x4 xv = *(const f32x4*)(x + off + bj * HALF + n * 16);
                        *(f32x4*)(out + off + bj * HALF + n * 16) = xv + gv[bj][n] * (acc[ai][bj][m][n] * rg); } }
    }
};

struct EpiRelu2 {
    static constexpr bool PERM = true, HOOKS = false; static constexpr int MIDT = 0;
    bf16_t* O; int ldc;
    __device__ __forceinline__ void begin(const Unit&, int, int) const {}
    __device__ __forceinline__ void mid(f32x4 (&)[2][2][4][2], int, int, int) const {}
    __device__ __forceinline__ void operator()(f32x4 (&acc)[2][2][4][2], const Unit& u, int ui, int wr, int wc, int fr, int fq) const {
        const int row0 = u.pm * BM + wr * 64 + fr, col0 = u.pn * BM + wc * 32 + 8 * fq;
#pragma unroll
        for (int ai = 0; ai < 2; ++ai)
#pragma unroll
            for (int m = 0; m < 4; ++m) { bf16_t* rowp = O + (size_t)(row0 + ai * HALF + m * 16) * ldc + col0;
#pragma unroll
                for (int bj = 0; bj < 2; ++bj) { f32x4 v0 = acc[ai][bj][m][0], v1 = acc[ai][bj][m][1];
                    v0 = __builtin_elementwise_max(v0, (f32x4){0.f, 0.f, 0.f, 0.f}); v1 = __builtin_elementwise_max(v1, (f32x4){0.f, 0.f, 0.f, 0.f}); v0 = v0 * v0; v1 = v1 * v1;
                    u32x4 w; w.x = cvtpk(v0[0], v0[1]); w.y = cvtpk(v0[2], v0[3]); w.z = cvtpk(v1[0], v1[1]); w.w = cvtpk(v1[2], v1[3]);
                    *(u32x4*)(rowp + bj * HALF) = w; } }
    }
};

struct EpiRes2 {
    static constexpr bool PERM = false, HOOKS = false; static constexpr int MIDT = 0;
    float* out; const float* mod;
    __device__ __forceinline__ void begin(const Unit&, int, int) const {}
    __device__ __forceinline__ void mid(f32x4 (&)[2][2][4][2], int, int, int) const {}
    __device__ __forceinline__ void operator()(f32x4 (&acc)[2][2][4][2], const Unit& u, int ui, int wr, int wc, int fr, int fq) const {
        const int row0 = u.pm * BM + wr * 64 + fr, col0 = u.pn * BM + wc * 32 + 4 * fq;
        const float* gp = mod + (size_t)(u.pm >> 3) * NMOD + 5 * DM + col0;
        f32x4 gv[2][2];
#pragma unroll
        for (int bj = 0; bj < 2; ++bj)
#pragma unroll
            for (int n = 0; n < 2; ++n) gv[bj][n] = *(const f32x4*)(gp + bj * HALF + n * 16);
#pragma unroll
        for (int ai = 0; ai < 2; ++ai)
#pragma unroll
            for (int m = 0; m < 4; ++m) { const size_t off = (size_t)(row0 + ai * HALF + m * 16) * DM + col0;
#pragma unroll
                for (int bj = 0; bj < 2; ++bj)
#pragma unroll
                    for (int n = 0; n < 2; ++n) { const f32x4 xv = *(const f32x4*)(out + off + bj * HALF + n * 16);
                        *(f32x4*)(out + off + bj * HALF + n * 16) = xv + gv[bj][n] * acc[ai][bj][m][n]; } }
    }
};

template <class Epi, class Sched>
__device__ __forceinline__ void gemm_phase(LAS unsigned char* lds, const Gemm g, const Sched& S, const Epi& E) {
    const int tid = threadIdx.x, wid = __builtin_amdgcn_readfirstlane(tid >> 6), lane = tid & 63, wr = wid >> 2, wc = wid & 3, fr = lane & 15, fq = lane >> 4;
    const int K = g.K, nt = K / BK;
    unsigned voffA[2], voffB[2];
#pragma unroll
    for (int i = 0; i < 2; ++i) { int R, C; stage_rc(tid * 16 + i * 8192, R, C); const int Rb = Epi::PERM ? ((R & ~31) + perm32(R & 31)) : R;
        voffA[i] = (unsigned)(R * K + C) * 2u; voffB[i] = (unsigned)(Rb * K + C) * 2u; }
    const size_t kstep = (size_t)(BK * 2);
    const size_t hstep = (size_t)HALF * K * 2;
    const size_t tstep = 2 * hstep;
    const unsigned ldsw = (unsigned)wid * 1024u;
    const int aoff = lds_byte(wr * 64 + fr, fq * 8), boff = lds_byte(wc * 32 + fr, fq * 8);
#define PG8_SA(b, h) (((b) * 2 + (h)) * HTB)
#define PG8_SB(b, h) ((4 + (b) * 2 + (h)) * HTB)
#define PG8_STAGE(bufoff, gbase, voff) do { _Pragma("unroll") for (int _i = 0; _i < 2; ++_i) \
        __builtin_amdgcn_global_load_lds((const unsigned*)((const char*)(gbase) + (voff)[_i]), (LAS unsigned*)(lds + (bufoff) + ldsw + _i * 8192), 16, 0, 0); } while (0)
#define PG8_LDA(dst, b, h) do { _Pragma("unroll") for (int m = 0; m < 4; ++m) _Pragma("unroll") for (int k = 0; k < 2; ++k) dst[m][k] = *(const LAS bf16x8*)(lds + PG8_SA(b, h) + aoff + m * 2048 + k * 1024); } while (0)
#define PG8_LDB(dst, b, h) do { _Pragma("unroll") for (int n = 0; n < 2; ++n) _Pragma("unroll") for (int k = 0; k < 2; ++k) dst[n][k] = *(const LAS bf16x8*)(lds + PG8_SB(b, h) + boff + n * 2048 + k * 1024); } while (0)
#define PG8_MMA(ai, bj, At, Bt) do { __builtin_amdgcn_s_setprio(1); _Pragma("unroll") for (int m = 0; m < 4; ++m) _Pragma("unroll") for (int n = 0; n < 2; ++n) _Pragma("unroll") for (int k = 0; k < 2; ++k) \
        acc[ai][bj][m][n] = __builtin_amdgcn_mfma_f32_16x16x32_bf16(Bt[n][k], At[m][k], acc[ai][bj][m][n], 0, 0, 0); __builtin_amdgcn_s_setprio(0); } while (0)
#define PG8_WAIT_V(n) asm volatile("s_waitcnt vmcnt(" #n ")" ::: "memory")
#define PG8_WAIT_L(n) asm volatile("s_waitcnt lgkmcnt(" #n ")" ::: "memory")
#define PG8_BAR __builtin_amdgcn_s_barrier()
#define PG8_SCHED __builtin_amdgcn_sched_barrier(0)
    Unit cur, nxt; int ui = 0;
    if (!S.next(0, cur)) return;
    f32x4 acc[2][2][4][2];
#pragma unroll
    for (int a = 0; a < 2; ++a)
#pragma unroll
        for (int b = 0; b < 2; ++b)
#pragma unroll
            for (int m = 0; m < 4; ++m)
#pragma unroll
                for (int n = 0; n < 2; ++n) acc[a][b][m][n] = (f32x4){0.f, 0.f, 0.f, 0.f};
    bf16x8 At[4][2], B0[2][2], B1[2][2];
    const char* cA = (const char*)g.A + (size_t)cur.pm * tstep; const char* cB = (const char*)g.Bt + (size_t)cur.pn * tstep;
    PG8_STAGE(PG8_SB(0, 0), cB, voffB); PG8_STAGE(PG8_SB(0, 1), cB + hstep, voffB); PG8_STAGE(PG8_SA(0, 0), cA, voffA); PG8_STAGE(PG8_SA(0, 1), cA + hstep, voffA);
    if (wr == 1) PG8_BAR;
    PG8_WAIT_V(2); PG8_BAR;
    PG8_STAGE(PG8_SB(1, 0), cB + kstep, voffB); PG8_STAGE(PG8_SA(1, 0), cA + kstep, voffA); PG8_STAGE(PG8_SB(1, 1), cB + hstep + kstep, voffB);
    PG8_WAIT_V(6); PG8_BAR;
    for (;;) {
        const bool has_next = S.next(ui + 1, nxt);
        const char* nA = has_next ? (const char*)g.A + (size_t)nxt.pm * tstep : cA; const char* nB = has_next ? (const char*)g.Bt + (size_t)nxt.pn * tstep : cB;
        for (int t = 0; t < nt; t += 2) {
            const bool last = (t == nt - 2);
            const char* a1 = cA + (size_t)(t + 1) * kstep;
            const char* a2 = last ? nA : cA + (size_t)(t + 2) * kstep; const char* b2 = last ? nB : cB + (size_t)(t + 2) * kstep;
            const char* a3 = a2 + kstep; const char* b3 = b2 + kstep;
            if constexpr (Epi::HOOKS) { if (t == Epi::MIDT) E.mid(acc, ui, wr, fr); }
            PG8_LDB(B0, 0, 0); PG8_LDB(B1, 0, 1); PG8_SCHED; PG8_LDA(At, 0, 0); PG8_STAGE(PG8_SA(1, 1), a1 + hstep, voffA);
            PG8_WAIT_V(8); PG8_WAIT_L(0); PG8_BAR; PG8_MMA(0, 0, At, B0); PG8_MMA(0, 1, At, B1); PG8_BAR; PG8_SCHED;
            PG8_LDA(At, 0, 1); PG8_STAGE(PG8_SB(0, 0), b2, voffB); PG8_STAGE(PG8_SB(0, 1), b2 + hstep, voffB); PG8_STAGE(PG8_SA(0, 0), a2, voffA);
            PG8_WAIT_V(8); PG8_WAIT_L(0); PG8_BAR; PG8_MMA(1, 0, At, B0); PG8_MMA(1, 1, At, B1); PG8_BAR; PG8_SCHED;
            PG8_LDB(B0, 1, 0); PG8_LDB(B1, 1, 1); PG8_SCHED; PG8_LDA(At, 1, 0); PG8_STAGE(PG8_SA(0, 1), a2 + hstep, voffA);
            PG8_WAIT_V(8); PG8_WAIT_L(0); PG8_BAR; PG8_MMA(0, 0, At, B0); PG8_MMA(0, 1, At, B1); PG8_BAR; PG8_SCHED;
            PG8_LDA(At, 1, 1); PG8_STAGE(PG8_SB(1, 0), b3, voffB); PG8_STAGE(PG8_SB(1, 1), b3 + hstep, voffB); PG8_STAGE(PG8_SA(1, 0), a3, voffA);
            PG8_WAIT_V(8); PG8_WAIT_L(0); PG8_BAR; PG8_MMA(1, 0, At, B0); PG8_MMA(1, 1, At, B1); PG8_BAR; PG8_SCHED;
        }
        if (wr == 0) PG8_BAR;
        E(acc, cur, ui, wr, wc, fr, fq);
        if (!has_next) break;
#pragma unroll
        for (int a = 0; a < 2; ++a)
#pragma unroll
            for (int b = 0; b < 2; ++b)
#pragma unroll
                for (int m = 0; m < 4; ++m)
#pragma unroll
                    for (int n = 0; n < 2; ++n) acc[a][b][m][n] = (f32x4){0.f, 0.f, 0.f, 0.f};
        cur = nxt; cA = nA; cB = nB; ++ui;
        if (wr == 1) PG8_BAR;
    }
    PG8_WAIT_V(0);
    PG8_BAR;
#undef PG8_SA
#undef PG8_SB
#undef PG8_STAGE
#undef PG8_LDA
#undef PG8_LDB
#undef PG8_MMA
#undef PG8_WAIT_V
#undef PG8_WAIT_L
#undef PG8_BAR
#undef PG8_SCHED
}
}

typedef GAS unsigned gu32;
#define RLX_AGENT __ATOMIC_RELAXED, __HIP_MEMORY_SCOPE_AGENT
#define XB_TMO      128
#define XB_XCNT(j)  (256  + 64 * (j))
#define XB_XSUB(j)  (1280 + 64 * (j))
#define XB_XGEN(j)  (2304 + 64 * (j))
#define XB_TOP      3328
#define XB_TOPGEN   3392
#define XCD_BAR_WORDS 3456
#define XB_SPIN_CAP (1u << 20)
__device__ __forceinline__ unsigned xb_ld(unsigned* p)              { return __hip_atomic_load(p, __ATOMIC_RELAXED, __HIP_MEMORY_SCOPE_AGENT); }
__device__ __forceinline__ unsigned xb_add(unsigned* p, unsigned v) { return __hip_atomic_fetch_add(p, v, __ATOMIC_RELAXED, __HIP_MEMORY_SCOPE_AGENT); }
__device__ __forceinline__ unsigned xb_xcc_id() { return (unsigned)__builtin_amdgcn_s_getreg((3 << 11) | 20) & 0xFu; }
#define XB_SPIN(cond, bar) do { unsigned _sp = 0; while (cond) { __builtin_amdgcn_s_sleep(1); \
    if ((++_sp & 255u) == 0u) { if (xb_ld(&(bar)[XB_TMO])) break; if (_sp > XB_SPIN_CAP) { atomicAdd(&(bar)[XB_TMO], 1u); break; } } } } while (0)
struct XcdBarrier { unsigned* bar; unsigned x; volatile LAS unsigned* st; };
__device__ __forceinline__ XcdBarrier xcd_barrier_post(unsigned* bar, volatile LAS unsigned* st) {
    XcdBarrier b; b.bar = bar; b.x = xb_xcc_id(); b.st = st;
    if (threadIdx.x == 0) (void)xb_add(&bar[XB_XCNT(b.x)], 1u);
    return b;
}
__device__ __forceinline__ void xcd_barrier_complete(unsigned* bar, unsigned x, unsigned& nloc, unsigned& nx) {
    const unsigned G = gridDim.x * gridDim.y * gridDim.z;
    unsigned sum, cnt, mine, sp = 0u;
    for (;;) {
        sum = 0u; cnt = 0u; mine = 0u;
#pragma unroll
        for (unsigned j = 0; j < 16; ++j) { const unsigned c = xb_ld(&bar[XB_XCNT(j)]); sum += c; cnt += (c > 0u) ? 1u : 0u; mine = (j == x) ? c : mine; }
        if (sum == G) break;
        __builtin_amdgcn_s_sleep(1);
        if ((++sp & 255u) == 0u) { if (xb_ld(&bar[XB_TMO])) break; if (sp > XB_SPIN_CAP) { atomicAdd(&bar[XB_TMO], 1u); break; } }
    }
    nloc = mine > 0u ? mine : 1u; nx = cnt > 0u ? cnt : 1u;
}
__device__ __forceinline__ void xcd_barrier(const XcdBarrier& b) {
    asm volatile("s_waitcnt vmcnt(0)" ::: "memory");
    __syncthreads();
    if (threadIdx.x == 0) {
        unsigned* bar = b.bar;
        __builtin_amdgcn_s_waitcnt(0);
        unsigned nloc = b.st[0], nx = b.st[1];
        if (nloc == 0u) { xcd_barrier_complete(bar, b.x, nloc, nx); b.st[0] = nloc; b.st[1] = nx; }
        const unsigned old = xb_add(&bar[XB_XSUB(b.x)], 1u);
        const unsigned gen = old / nloc;
        if (old + 1u == (gen + 1u) * nloc) {
            __builtin_amdgcn_fence(__ATOMIC_RELEASE, "agent");
            asm volatile("s_waitcnt vmcnt(0)" ::: "memory");
            const unsigned og = xb_add(&bar[XB_TOP], 1u);
            const unsigned tg = og / nx;
            if (og + 1u == (tg + 1u) * nx) xb_add(&bar[XB_TOPGEN], 1u);
            else XB_SPIN(xb_ld(&bar[XB_TOPGEN]) == tg, bar);
            __builtin_amdgcn_fence(__ATOMIC_ACQUIRE, "agent");
            xb_add(&bar[XB_XGEN(b.x)], 1u);
            asm volatile("s_waitcnt vmcnt(0)" ::: "memory");
        } else {
            XB_SPIN(xb_ld(&bar[XB_XGEN(b.x)]) == gen, bar);
            __builtin_amdgcn_fence(__ATOMIC_ACQUIRE, "agent");
            asm volatile("s_waitcnt vmcnt(0)" ::: "memory");
        }
    }
    __syncthreads();
}

struct Args { const float* in[18]; float* out; unsigned char* ws; int ph_lo, ph_hi, li, pad; };
struct Frame {
    LAS unsigned char* lds;
    int tid, lane, wave, vcu, G;
};
#define LDS_WAIT() asm volatile("s_waitcnt lgkmcnt(0)" ::: "memory")

__device__ __forceinline__ void p0_ada(const Frame& F, const float* c, const float* w_ada, const float* b_ada, float* mod) {
    LAS float* sc = (LAS float*)F.lds;
    LAS float* part = (LAS float*)(F.lds + 65536);
    for (int i = F.tid; i < NBATCH * DM; i += 512) { const int b = i >> 11, k = i & 2047; const float v = c[i]; sc[k * 8 + b] = v / (1.0f + __expf(-v)); }
    __syncthreads();
    const int kk = F.lane / 12, c4 = F.lane % 12;
    for (int item = blockIdx.x; item < 256; item += F.G) {
        const int n0 = 48 * item, kb = 256 * F.wave;
        f32x4 acc[8];
#pragma unroll
        for (int b = 0; b < 8; ++b) acc[b] = (f32x4){0.f, 0.f, 0.f, 0.f};
        if (F.lane < 60) {
            const float* wp = w_ada + (size_t)(kb + kk) * NMOD + n0 + 4 * c4;
#pragma unroll 3
            for (int i = 0; i < 51; ++i) {
                const int k = kb + kk + 5 * i;
                const f32x4 w = *(const f32x4*)(wp + (size_t)(5 * i) * NMOD);
                const f32x4 s0 = *(const LAS f32x4*)(sc + k * 8), s1 = *(const LAS f32x4*)(sc + k * 8 + 4);
                acc[0] += w * s0[0]; acc[1] += w * s0[1]; acc[2] += w * s0[2]; acc[3] += w * s0[3];
                acc[4] += w * s1[0]; acc[5] += w * s1[1]; acc[6] += w * s1[2]; acc[7] += w * s1[3];
            }
            if (kk == 0) {
                const int k = kb + 255;
                const f32x4 w = *(const f32x4*)(w_ada + (size_t)k * NMOD + n0 + 4 * c4);
                const f32x4 s0 = *(const LAS f32x4*)(sc + k * 8), s1 = *(const LAS f32x4*)(sc + k * 8 + 4);
                acc[0] += w * s0[0]; acc[1] += w * s0[1]; acc[2] += w * s0[2]; acc[3] += w * s0[3];
                acc[4] += w * s1[0]; acc[5] += w * s1[1]; acc[6] += w * s1[2]; acc[7] += w * s1[3];
            }
#pragma unroll
            for (int b = 0; b < 8; ++b) *(LAS f32x4*)(part + (F.wave * 5 + kk) * 384 + b * 48 + 4 * c4) = acc[b];
        }
        __syncthreads();
        if (F.tid < 384) { float s = 0.f;
#pragma unroll 8
            for (int j = 0; j < 40; ++j) s += part[j * 384 + F.tid];
            const int b = F.tid / 48, n = F.tid % 48; mod[(size_t)b * NMOD + n0 + n] = s + b_ada[n0 + n]; }
        __syncthreads();
    }
}

__device__ __forceinline__ void p1_transpose_item(const float* W, int K, int N, bf16_t* WT, LAS float* scr, int item, int lane, const float* ks0, const float* ks1) {
    const int nblk = N / 32, kb = item / nblk, nb = item % nblk, k0 = 64 * kb, n0 = 32 * nb;
#pragma unroll 8
    for (int i = 0; i < 32; ++i) { const int kk = 2 * i + (lane >> 5); float v = W[(size_t)(k0 + kk) * N + n0 + (lane & 31)];
        if (ks0) { const int k = k0 + kk; v *= (k < 1024 ? ks0[k] : ks1[k - 1024]); }
        scr[kk * 33 + (lane & 31)] = v; }
    LDS_WAIT(); asm volatile("" ::: "memory");
    const int c = lane & 7;
#pragma unroll
    for (int j = 0; j < 4; ++j) { const int n = (lane >> 3) + 8 * j; const LAS float* s = scr + (8 * c) * 33 + n;
        u32x4 o; o.x = cvtpk(s[0 * 33], s[1 * 33]); o.y = cvtpk(s[2 * 33], s[3 * 33]); o.z = cvtpk(s[4 * 33], s[5 * 33]); o.w = cvtpk(s[6 * 33], s[7 * 33]);
        *(u32x4*)(WT + (size_t)(n0 + n) * K + k0 + 8 * c) = o; }
    LDS_WAIT(); asm volatile("" ::: "memory");
}
__device__ __forceinline__ void norm_mod_row(const float* xrow, const float* g, const float* shift, const float* scale, bf16_t* orow, int lane) {
    const f32x4* xr = (const f32x4*)xrow + lane;
    f32x4 v[8]; float s = 0.f;
#pragma unroll
    for (int j = 0; j < 8; ++j) { v[j] = xr[64 * j]; s += (v[j][0] * v[j][0] + v[j][1] * v[j][1]) + (v[j][2] * v[j][2] + v[j][3] * v[j][3]); }
    const float rinv = 1.0f / sqrtf(wave_sum(s) * (1.0f / DM) + EPS);
    u32x2* o8 = (u32x2*)orow + lane;
#pragma unroll
    for (int j = 0; j < 8; ++j) { const f32x4 gg = ((const f32x4*)g)[lane + 64 * j], sc = ((const f32x4*)scale)[lane + 64 * j], sh = ((const f32x4*)shift)[lane + 64 * j];
        const f32x4 o = (v[j] * rinv) * gg * (sc + 1.0f) + sh; u32x2 w; w.x = cvtpk(o[0], o[1]); w.y = cvtpk(o[2], o[3]); o8[64 * j] = w; }
}

__device__ __forceinline__ unsigned off_b(unsigned row, unsigned ch) { return 256u * row + 16u * (ch ^ (((row & 3) << 2) | ((row >> 2) & 3))); }
__device__ __forceinline__ v4i16_t vtr(LAS unsigned char* p) { return __builtin_amdgcn_ds_read_tr16_b64_v4i16((LAS v4i16_t*)p); }
__device__ __forceinline__ int crow(int r, int hi) { return (r & 3) + 8 * (r >> 2) + 4 * hi; }

constexpr int AT_BT = 0;
constexpr int AT_K = 2048, AT_V = AT_K + 2 * 16384;
constexpr float ATT_THR = 6.0f;

__device__ __forceinline__ void attn_unit(const Frame& F, const bf16_t* Q, const bf16_t* Kg, const bf16_t* Vg, bf16_t* MIX, float* SSA, const float* relb, int b, int h, int g4) {
    LAS unsigned char* lds = F.lds;
    const int tid = F.tid, lane = F.lane, wid = F.wave, r32 = lane & 31, hi = lane >> 5;
    LAS float* bt = (LAS float*)(lds + AT_BT);
    if (tid < NREL) bt[tid] = relb[h * NREL + tid] * LOG2E;
    const int c = 4 * g4 + (wid >> 1);
    const size_t qrow = (size_t)b * SEQ + 64 * c + 32 * (wid & 1) + r32;
    bf16x8 qf[8];
#pragma unroll
    for (int ks = 0; ks < 8; ++ks) qf[ks] = *(const bf16x8*)(Q + qrow * AW + h * HD + 16 * ks + 8 * hi);
    const int kc_lo = (4 * g4 - LEFT) > 0 ? (4 * g4 - LEFT) : 0, kc_hi = 4 * g4 + 3, nsteps = kc_hi - kc_lo + 1;
    const int srow = tid >> 4, sch = tid & 15;
    const bf16_t* kp = Kg + ((size_t)b * SEQ + (size_t)kc_lo * CHUNK + srow) * AW + h * HD + sch * 8;
    const bf16_t* vp = Vg + ((size_t)b * SEQ + (size_t)kc_lo * CHUNK + srow) * AW + h * HD + sch * 8;
    const unsigned so0 = off_b(srow, sch), so1 = off_b(srow + 32, sch);
    u32x4 sk0, sk1, sv0, sv1;
    sk0 = *(const u32x4*)kp; sk1 = *(const u32x4*)(kp + 32 * AW); sv0 = *(const u32x4*)vp; sv1 = *(const u32x4*)(vp + 32 * AW);
    unsigned ka[8];
#pragma unroll
    for (int ks = 0; ks < 8; ++ks) ka[ks] = off_b(r32, 2 * ks + hi);
    const unsigned blk = (lane >> 4) & 1, q4 = (lane & 15) >> 2, p4 = lane & 3;
    unsigned va[4][2];
#pragma unroll
    for (int dt = 0; dt < 4; ++dt)
#pragma unroll
        for (int tp = 0; tp < 2; ++tp) va[dt][tp] = off_b(4 * hi + q4 + 8 * tp, 4 * dt + 2 * blk + (p4 >> 1)) + 8 * (p4 & 1);
    float m_run = -1e30f, l_run = 0.f;
    f32x16 o[4];
#pragma unroll
    for (int dt = 0; dt < 4; ++dt) o[dt] = (f32x16){};
    const int qin = 32 * (wid & 1) + r32;
    for (int s = 0; s < nsteps; ++s) {
        const int kc = kc_lo + s, buf = s & 1;
        LAS unsigned char* Kb = lds + AT_K + buf * 16384; LAS unsigned char* Vb = lds + AT_V + buf * 16384;
        *(LAS u32x4*)(Kb + so0) = sk0; *(LAS u32x4*)(Kb + so1) = sk1; *(LAS u32x4*)(Vb + so0) = sv0; *(LAS u32x4*)(Vb + so1) = sv1;
        if (s + 1 < nsteps) { kp += (size_t)CHUNK * AW; vp += (size_t)CHUNK * AW;
            sk0 = *(const u32x4*)kp; sk1 = *(const u32x4*)(kp + 32 * AW); sv0 = *(const u32x4*)vp; sv1 = *(const u32x4*)(vp + 32 * AW); }
        LDS_WAIT(); __builtin_amdgcn_s_barrier(); asm volatile("" ::: "memory");
        const int delta = c - kc;
        if (delta >= 0 && delta <= LEFT) {
#pragma unroll
            for (int t = 0; t < 2; ++t) {
                f32x16 sc = (f32x16){};
#pragma unroll
                for (int ks = 0; ks < 8; ++ks) { const bf16x8 kf = *(const LAS bf16x8*)(Kb + ka[ks] + t * 8192); sc = __builtin_amdgcn_mfma_f32_32x32x16_bf16(kf, qf[ks], sc, 0, 0, 0); }
                if (delta >= 3) { const float bc = bt[2 * MAXREL];
#pragma unroll
                    for (int r = 0; r < 16; ++r) sc[r] += bc;
                } else { const int lb = 64 * delta + qin - 32 * t - 4 * hi + MAXREL;
#pragma unroll
                    for (int r = 0; r < 16; ++r) { int idx = lb - ((r & 3) + 8 * (r >> 2)); idx = idx > 2 * MAXREL ? 2 * MAXREL : idx; sc[r] += bt[idx]; } }
                float tm = sc[0];
#pragma unroll
                for (int r = 1; r < 16; ++r) tm = fmaxf(tm, sc[r]);
                tm = fmaxf(tm, __shfl_xor(tm, 32));
                if (!__all(tm <= m_run + ATT_THR)) {
                    const float mn = fmaxf(m_run, tm), al = __builtin_amdgcn_exp2f(m_run - mn); m_run = mn; l_run *= al;
#pragma unroll
                    for (int dt = 0; dt < 4; ++dt) o[dt] = o[dt] * al;
                }
                float ps = 0.f;
#pragma unroll
                for (int r = 0; r < 16; ++r) { sc[r] = __builtin_amdgcn_exp2f(sc[r] - m_run); ps += sc[r]; }
                l_run += ps;
                bf16x8 pb[2];
#pragma unroll
                for (int s2 = 0; s2 < 2; ++s2) { u32x4 w; w.x = cvtpk(sc[8 * s2 + 0], sc[8 * s2 + 1]); w.y = cvtpk(sc[8 * s2 + 2], sc[8 * s2 + 3]); w.z = cvtpk(sc[8 * s2 + 4], sc[8 * s2 + 5]); w.w = cvtpk(sc[8 * s2 + 6], sc[8 * s2 + 7]); pb[s2] = __builtin_bit_cast(bf16x8, w); }
#pragma unroll
                for (int dt = 0; dt < 4; ++dt)
#pragma unroll
                    for (int s2 = 0; s2 < 2; ++s2) {
                        const v4i16_t lo = vtr(Vb + va[dt][0] + (32 * t + 16 * s2) * 256), hh = vtr(Vb + va[dt][1] + (32 * t + 16 * s2) * 256);
                        const bf16x8 vf = (bf16x8){lo[0], lo[1], lo[2], lo[3], hh[0], hh[1], hh[2], hh[3]};
                        o[dt] = __builtin_amdgcn_mfma_f32_32x32x16_bf16(vf, pb[s2], o[dt], 0, 0, 0);
                    }
            }
        }
    }
    const float lt = l_run + __shfl_xor(l_run, 32), inv = 1.0f / lt;
    float ss = 0.f;
    bf16_t* orow = MIX + qrow * DM + h * HD;
#pragma unroll
    for (int dt = 0; dt < 4; ++dt)
#pragma unroll
        for (int rg = 0; rg < 4; ++rg) {
            const float a0 = o[dt][4 * rg] * inv, a1 = o[dt][4 * rg + 1] * inv, a2 = o[dt][4 * rg + 2] * inv, a3 = o[dt][4 * rg + 3] * inv;
            ss += (a0 * a0 + a1 * a1) + (a2 * a2 + a3 * a3);
            u32x2 w; w.x = cvtpk(a0, a1); w.y = cvtpk(a2, a3);
            *(u32x2*)(orow + 32 * dt + 8 * rg + 4 * hi) = w;
        }
    ss += __shfl_xor(ss, 32);
    if (hi == 0) SSA[qrow * 8 + h] = ss;
    LDS_WAIT(); __builtin_amdgcn_s_barrier(); asm volatile("" ::: "memory");
}

__device__ __forceinline__ void gmlp_unit(const Frame& F, const bf16_t* U, const bf16_t* ZN, const bf16_t* WSP, const float* bsp, bf16_t* MIX, float* SSG, int b, int nb, int g) {
    LAS unsigned char* lds = F.lds + AT_K;
    const int tid = F.tid, lane = F.lane, wid = F.wave, r32 = lane & 31, hi = lane >> 5;
    const size_t row0 = (size_t)b * SEQ + 128 * nb;
#pragma unroll
    for (int i = 0; i < 4; ++i) { const int n = tid + 512 * i, row = n >> 4, ch = n & 15;
        const u32x4 v = *(const u32x4*)(ZN + (row0 + row) * AW + g * HD + ch * 8); *(LAS u32x4*)(lds + off_b(row, ch)) = v; }
    const int tt = wid & 3, chh = wid >> 2;
    const int trow = 32 * tt + r32;
    const bf16_t* wrow = WSP + ((size_t)g * 128 + trow) * 128 + 8 * hi;
    const int nks = tt < 2 ? 4 : 8;
    LDS_WAIT(); __builtin_amdgcn_s_barrier(); asm volatile("" ::: "memory");
    const unsigned blk = (lane >> 4) & 1, q4 = (lane & 15) >> 2, p4 = lane & 3;
    f32x16 acc[2]; acc[0] = (f32x16){}; acc[1] = (f32x16){};
    for (int ks = 0; ks < nks; ++ks) {
        const bf16x8 wf = *(const bf16x8*)(wrow + 16 * ks);
#pragma unroll
        for (int c2 = 0; c2 < 2; ++c2) { const int ct = 2 * chh + c2;
            const v4i16_t lo = vtr(lds + off_b(16 * ks + 8 * hi + q4, 4 * ct + 2 * blk + (p4 >> 1)) + 8 * (p4 & 1));
            const v4i16_t hh = vtr(lds + off_b(16 * ks + 8 * hi + 4 + q4, 4 * ct + 2 * blk + (p4 >> 1)) + 8 * (p4 & 1));
            const bf16x8 zf = (bf16x8){lo[0], lo[1], lo[2], lo[3], hh[0], hh[1], hh[2], hh[3]};
            acc[c2] = __builtin_amdgcn_mfma_f32_32x32x16_bf16(zf, wf, acc[c2], 0, 0, 0); }
    }
    const float bs = bsp[g * 128 + trow];
    const size_t grow = row0 + trow;
    float ss = 0.f;
#pragma unroll
    for (int c2 = 0; c2 < 2; ++c2)
#pragma unroll
        for (int rg = 0; rg < 4; ++rg) { const int c0 = 32 * (2 * chh + c2) + 8 * rg + 4 * hi;
            const u32x2 uu = *(const u32x2*)(U + grow * AW + g * HD + c0);
            const float o0 = bf2f((unsigned short)(uu.x & 0xffff)) * (acc[c2][4 * rg] + bs), o1 = bf2f((unsigned short)(uu.x >> 16)) * (acc[c2][4 * rg + 1] + bs);
            const float o2 = bf2f((unsigned short)(uu.y & 0xffff)) * (acc[c2][4 * rg + 2] + bs), o3 = bf2f((unsigned short)(uu.y >> 16)) * (acc[c2][4 * rg + 3] + bs);
            ss += (o0 * o0 + o1 * o1) + (o2 * o2 + o3 * o3);
            u32x2 w; w.x = cvtpk(o0, o1); w.y = cvtpk(o2, o3);
            *(u32x2*)(MIX + grow * DM + AW + g * HD + c0) = w; }
    ss += __shfl_xor(ss, 32);
    if (hi == 0) SSG[grow * 16 + g * 2 + chh] = ss;
    LDS_WAIT(); __builtin_amdgcn_s_barrier(); asm volatile("" ::: "memory");
}

constexpr int NPH = 8;
__global__ void __launch_bounds__(512, 2) mk_fwd(Args args) {
    extern __shared__ __attribute__((aligned(16))) unsigned char lds_raw[];
    Frame F;
    F.lds = (LAS unsigned char*)lds_raw;
    F.tid = threadIdx.x; F.lane = F.tid & 63; F.wave = __builtin_amdgcn_readfirstlane(F.tid >> 6);
    F.G = gridDim.x; { const int bx = blockIdx.x; F.vcu = (F.G % 8 == 0) ? (bx % 8) * (F.G / 8) + bx / 8 : bx; }
    unsigned char* ws = args.ws;
    unsigned* ctl = (unsigned*)(ws + WS_CTL);
    for (int u = F.tid; u < (LDS_BYTES - LDSCTL_OFF) / 4; u += 512) ((LAS unsigned*)(F.lds + LDSCTL_OFF))[u] = 0u;
    __syncthreads();
    XcdBarrier bar; bar.bar = ctl + 4096; bar.x = 0; bar.st = nullptr;
    if (MK_N_LAUNCHES == 1) bar = xcd_barrier_post(ctl + 4096, (volatile LAS unsigned*)(F.lds + MISC_OFF) + 8);
    const int lo = args.ph_lo, hi = args.ph_hi;
#ifndef MK_PHASE_MASK
#define MK_PHASE_MASK 255
#endif
#define IN(k) (((MK_PHASE_MASK >> (k)) & 1) && lo <= (k) && (k) < hi)
#define SEAM(k) do { if (IN(k) && IN((k) + 1)) xcd_barrier(bar); } while (0)

    const float* x = args.in[0]; const float* cnd = args.in[1]; const float* w_ada = args.in[2]; const float* b_ada = args.in[3]; const float* mix_g = args.in[4];
    const float* w_in = args.in[5]; const float* q_g = args.in[6]; const float* k_g = args.in[7]; const float* relb = args.in[8]; const float* gm_g = args.in[9];
    const float* w_sp = args.in[10]; const float* b_sp = args.in[11]; const float* ao_g = args.in[12]; const float* go_g = args.in[13]; const float* w_out = args.in[14];
    const float* ff_g = args.in[15]; const float* w_f1 = args.in[16]; const float* w_f2 = args.in[17];
    float* out = args.out;
    float* MOD = (float*)(ws + WS_MOD); float* SSA = (float*)(ws + WS_SSA); float* SSG = (float*)(ws + WS_SSG);
    bf16_t* WSP = (bf16_t*)(ws + WS_WSP); bf16_t* WIN = (bf16_t*)(ws + WS_WIN); bf16_t* WOUT = (bf16_t*)(ws + WS_WOUT); bf16_t* WF1 = (bf16_t*)(ws + WS_WF1); bf16_t* WF2 = (bf16_t*)(ws + WS_WF2);
    bf16_t* H = (bf16_t*)(ws + WS_H); bf16_t* QB = (bf16_t*)(ws + WS_Q); bf16_t* KB = (bf16_t*)(ws + WS_K); bf16_t* VB = (bf16_t*)(ws + WS_V); bf16_t* UB = (bf16_t*)(ws + WS_U); bf16_t* ZB = (bf16_t*)(ws + WS_ZN);
    bf16_t* MIX = (bf16_t*)(ws + WS_MIX); bf16_t* ACT = (bf16_t*)(ws + WS_ACT);
    const int gw = F.vcu * 8 + F.wave, NGW = F.G * 8;

    if (IN(0)) { p0_ada(F, cnd, w_ada, b_ada, MOD); }
    SEAM(0);

    if (IN(1)) {
        LAS float* scr = (LAS float*)(F.lds + F.wave * 16384);
        constexpr int I_IN = (DM / 64) * (INW / 32), I_OUT = (DM / 64) * (DM / 32), I_F1 = (DM / 64) * (DFF / 32), I_F2 = (DFF / 64) * (DM / 32), I_SP = 64;
        constexpr int NITEMS = I_IN + I_OUT + I_F1 + I_F2 + I_SP;
        for (int it = gw; it < NITEMS; it += NGW) {
            int r = it;
            if (r < I_IN) { p1_transpose_item(w_in, DM, INW, WIN, scr, r, F.lane, nullptr, nullptr); continue; } r -= I_IN;
            if (r < I_OUT) { p1_transpose_item(w_out, DM, DM, WOUT, scr, r, F.lane, ao_g, go_g); continue; } r -= I_OUT;
            if (r < I_F1) { p1_transpose_item(w_f1, DM, DFF, WF1, scr, r, F.lane, nullptr, nullptr); continue; } r -= I_F1;
            if (r < I_F2) { p1_transpose_item(w_f2, DFF, DM, WF2, scr, r, F.lane, nullptr, nullptr); continue; } r -= I_F2;
#pragma unroll
            for (int i = 0; i < 8; ++i) { const int e = r * 2048 + (i * 64 + F.lane) * 4, t = (e >> 7) & 127, s = e & 127;
                f32x4 v = *(const f32x4*)(w_sp + e); if ((t >> 6) < (s >> 6)) v = (f32x4){0.f, 0.f, 0.f, 0.f};
                u32x2 w; w.x = cvtpk(v[0], v[1]); w.y = cvtpk(v[2], v[3]); *(u32x2*)(WSP + e) = w; }
        }
        for (int m = gw; m < MROWS; m += NGW) { const float* mb = MOD + (size_t)(m >> 11) * NMOD;
            norm_mod_row(x + (size_t)m * DM, mix_g, mb, mb + DM, H + (size_t)m * DM, F.lane); }
    }
    SEAM(1);

    if (IN(2)) {
        pg8::Gemm g{H, WIN, MROWS, INW, DM}; pg8::StaticOrder S; S.init(MROWS, INW, F.G, (int)blockIdx.x);
        pg8::EpiProj E{QB, (size_t)(WS_K - WS_Q) / 2, q_g, k_g, gm_g, (LAS float*)(F.lds + XCH_OFF)};
        pg8::gemm_phase<pg8::EpiProj, pg8::StaticOrder>(F.lds, g, S, E);
    }
    SEAM(2);

    if (IN(3)) {
        for (int u = F.vcu; u < NBATCH * NH * 8; u += F.G) { const int g4 = u & 7, h = (u >> 3) & 7, b = u >> 6;
            attn_unit(F, QB, KB, VB, MIX, SSA, relb, b, h, g4); }
        for (int u = F.vcu; u < NBATCH * 16 * 8; u += F.G) { const int g = u & 7, nb = (u >> 3) & 15, b = u >> 7;
            gmlp_unit(F, UB, ZB, WSP, b_sp, MIX, SSG, b, nb, g); }
    }
    SEAM(3);

    if (IN(4)) {
        pg8::Gemm g{MIX, WOUT, MROWS, DM, DM}; pg8::StaticOrder S; S.init(MROWS, DM, F.G, (int)blockIdx.x);
        pg8::EpiRes1 E{x, out, MOD, SSA, SSG, (LAS float*)(F.lds + XCH_OFF)};
        { pg8::Unit uu; for (int i = F.tid >> 8; i < 4 && S.next(i, uu); i += 2) E.fill(uu, i, F.tid & 255); }
        __syncthreads();
        pg8::gemm_phase<pg8::EpiRes1, pg8::StaticOrder>(F.lds, g, S, E);
    }
    SEAM(4);

    if (IN(5)) {
        for (int m = gw; m < MROWS; m += NGW) { const float* mb = MOD + (size_t)(m >> 11) * NMOD;
            norm_mod_row(out + (size_t)m * DM, ff_g, mb + 3 * DM, mb + 4 * DM, H + (size_t)m * DM, F.lane); }
    }
    SEAM(5);

    if (IN(6)) {
        pg8::Gemm g{H, WF1, MROWS, DFF, DM}; pg8::StaticOrder S; S.init(MROWS, DFF, F.G, (int)blockIdx.x);
        pg8::EpiRelu2 E{ACT, DFF};
        pg8::gemm_phase<pg8::EpiRelu2, pg8::StaticOrder>(F.lds, g, S, E);
    }
    SEAM(6);

    if (IN(7)) {
        pg8::Gemm g{ACT, WF2, MROWS, DM, DFF}; pg8::StaticOrder S; S.init(MROWS, DM, F.G, (int)blockIdx.x);
        pg8::EpiRes2 E{out, MOD};
        pg8::gemm_phase<pg8::EpiRes2, pg8::StaticOrder>(F.lds, g, S, E);
    }
#undef IN
#undef SEAM
}

extern "C" void kernel_launch(void* const* d_in, const int* in_sizes, int n_in, void* d_out, int out_size, void* d_ws, size_t ws_size, hipStream_t stream) {
    static int grid = 0;
    if (grid == 0) {
        if (n_in != 18 || in_sizes[0] != MROWS * DM || out_size != MROWS * DM || ws_size < WS_END) {
            fprintf(stderr, "kernel_launch: unexpected shapes (n_in %d, in0 %d, out %d, ws %zu); nothing launched\n", n_in, n_in > 0 ? in_sizes[0] : -1, out_size, ws_size); grid = -1; return; }
        int dev = 0, cus = 0, per_cu = 0;
        if (hipGetDevice(&dev) != hipSuccess || hipDeviceGetAttribute(&cus, hipDeviceAttributeMultiprocessorCount, dev) != hipSuccess) { fprintf(stderr, "kernel_launch: device query failed\n"); grid = -1; return; }
        if (hipFuncSetAttribute((const void*)mk_fwd, hipFuncAttributeMaxDynamicSharedMemorySize, LDS_BYTES) != hipSuccess) { fprintf(stderr, "kernel_launch: hipFuncSetAttribute failed\n"); grid = -1; return; }
        if (hipOccupancyMaxActiveBlocksPerMultiprocessor(&per_cu, (const void*)mk_fwd, 512, LDS_BYTES) != hipSuccess || per_cu < 1) {
            fprintf(stderr, "kernel_launch: occupancy query reports %d workgroups per CU\n", per_cu); per_cu = 1; }
        (void)hipGetLastError();
        grid = cus;
    }
    if (grid < 0) return;
    (void)hipMemsetAsync((char*)d_ws + WS_CTL, 0, CTL_ZERO_BYTES, stream);
    Args a{};
    for (int i = 0; i < 18; ++i) a.in[i] = (const float*)d_in[i];
    a.out = (float*)d_out; a.ws = (unsigned char*)d_ws;
    for (int li = 0; li < MK_N_LAUNCHES; ++li) {
        if (MK_N_LAUNCHES == 1) { a.ph_lo = 0; a.ph_hi = NPH; } else { a.ph_lo = li; a.ph_hi = li + 1; }
        a.li = li;
        hipLaunchKernelGGL(mk_fwd, dim3(grid), dim3(512), LDS_BYTES, stream, a);
        const hipError_t le = hipPeekAtLastError();
        if (le != hipSuccess) { fprintf(stderr, "kernel_launch: launch %d failed: %s\n", li, hipGetErrorName(le)); break; }
    }
}
```

```cpp
#include <hip/hip_runtime.h>
#include <cstdio>
#include <cstdint>

#ifndef MK_N_LAUNCHES
#define MK_N_LAUNCHES 1
#endif

#define LAS __attribute__((address_space(3)))
#define GAS __attribute__((address_space(1)))
typedef unsigned short bf16_t;
typedef short bf16x8 __attribute__((ext_vector_type(8)));
typedef short v4i16_t __attribute__((ext_vector_type(4)));
typedef float f32x4 __attribute__((ext_vector_type(4)));
typedef float f32x2 __attribute__((ext_vector_type(2)));
typedef float f32x16 __attribute__((ext_vector_type(16)));
typedef unsigned u32x4 __attribute__((ext_vector_type(4)));
typedef unsigned u32x2 __attribute__((ext_vector_type(2)));
typedef __bf16 bf16x2_t __attribute__((ext_vector_type(2)));

constexpr int DM = 2048, NBATCH = 8, SEQ = 2048, MROWS = NBATCH * SEQ;
constexpr int AW = 1024, NH = 8, HD = 128, INW = 5120, DFF = 8192, NMOD = 6 * DM;
constexpr int CHUNK = 64, LEFT = 8, MAXREL = 128, NREL = 2 * MAXREL + 1;
constexpr float EPS = 1e-6f;
constexpr float LOG2E = 1.4426950408889634f;
constexpr float QSCALE = 0.08838834764831845f * LOG2E;

constexpr size_t MiB = 1u << 20;
constexpr size_t WS_CTL = 0, CTL_ZERO_BYTES = 64 * 1024;
constexpr size_t WS_MOD = 1 * MiB;
constexpr size_t WS_SSA = 2 * MiB;
constexpr size_t WS_SSG = 3 * MiB;
constexpr size_t WS_WSP = 6 * MiB;
constexpr size_t WS_WIN = 8 * MiB, WS_WOUT = 28 * MiB, WS_WF1 = 36 * MiB, WS_WF2 = 68 * MiB;
constexpr size_t WS_H = 100 * MiB;
constexpr size_t WS_Q = 164 * MiB, WS_K = 196 * MiB, WS_V = 228 * MiB, WS_U = 260 * MiB, WS_ZN = 292 * MiB;
constexpr size_t WS_MIX = 324 * MiB;
constexpr size_t WS_ACT = 164 * MiB;
constexpr size_t WS_END = 420 * MiB;

constexpr int RING_BYTES = 131072;
constexpr int XCH_OFF = RING_BYTES;
constexpr int LDSCTL_OFF = RING_BYTES + 8192, MISC_OFF = LDSCTL_OFF + 320;
constexpr int LDS_BYTES = 147456;

__device__ __forceinline__ unsigned cvtpk(float lo, float hi) { f32x2 v = {lo, hi}; bf16x2_t b = __builtin_convertvector(v, bf16x2_t); return __builtin_bit_cast(unsigned, b); }
__device__ __forceinline__ float bf2f(unsigned short h) { return __uint_as_float((unsigned)h << 16); }
__device__ __forceinline__ float wave_sum(float v) {
#pragma unroll
    for (int o = 1; o < 64; o <<= 1) v += __shfl_xor(v, o);
    return v;
}
__device__ __forceinline__ f32x2 gelu_pk(f32x2 v) {
    const f32x2 av = __builtin_elementwise_abs(v), d = av * 0.2316418882f + 1.0f;
    f32x2 t; t.x = __builtin_amdgcn_rcpf(d.x); t.y = __builtin_amdgcn_rcpf(d.y);
    f32x2 q = t * 0.5307027145f + (-0.7265760135f); q = q * t + 0.7107068705f; q = q * t + (-0.142248368f); q = q * t + 0.127414796f; q = q * t;
    const f32x2 s = (v * v) * (-0.72134752044f);
    f32x2 e; e.x = __builtin_amdgcn_exp2f(s.x); e.y = __builtin_amdgcn_exp2f(s.y);
    const f32x2 m = v * (q * e), r = v - m;
    f32x2 o; o.x = v.x < 0.f ? m.x : r.x; o.y = v.y < 0.f ? m.y : r.y; return o;
}
__device__ __forceinline__ f32x4 gelu4(f32x4 v) { const f32x2 a = gelu_pk((f32x2){v[0], v[1]}), b = gelu_pk((f32x2){v[2], v[3]}); return (f32x4){a.x, a.y, b.x, b.y}; }

__host__ __device__ __forceinline__ size_t blk_off(size_t row, int k, int K) { return (row >> 8) * ((size_t)256 * K) + (size_t)(k >> 6) * 16384 + (row & 255) * 64 + (k & 63); }

namespace pg8 {
constexpr int BM = 256, BK = 64, HALF = 128, HTB = HALF * BK * 2, STAGE_BYTES = 8 * HTB, NXCD = 8, WGM = 8;
__host__ __device__ __forceinline__ int lds_byte(int r, int c) { const int st = (r >> 4) * 2 + (c >> 5), rr = r & 15, cc = c & 31, ob = rr * 64 + cc * 2; return st * 1024 + (ob ^ (((ob >> 9) & 1) << 5)); }
__host__ __device__ __forceinline__ void stage_rc(int b, int& R, int& C) { const int st = b / 1024, sb = b % 1024, swz = sb ^ (((sb >> 9) & 1) << 5); R = (st >> 1) * 16 + swz / 64; C = (st & 1) * 32 + (swz % 64) / 2; }
__host__ __device__ __forceinline__ int perm32(int rho) { const int n = rho >> 4, i = rho & 15; return 8 * (i >> 2) + 4 * n + (i & 3); }

struct Unit { int pm, pn; };
struct Gemm { const bf16_t* A; const bf16_t* Bt; int M, N, K; };

struct StaticOrder {
    int nM, nN, nwg, G, c;
    __device__ void init(int M, int N, int G_, int c_) { nM = M / BM; nN = N / BM; nwg = nM * nN; G = G_; c = c_; }
    __device__ bool next(int i, Unit& u) const {
        const long L = (long)i * G + c; if (L >= nwg) return false;
        int wgid = (int)L; { const int q = nwg / NXCD, r = nwg % NXCD, xcd = wgid % NXCD, off = wgid / NXCD; wgid = (xcd < r ? xcd * (q + 1) : r * (q + 1) + (xcd - r) * q) + off; }
        const int nig = WGM * nN, gid = wgid / nig, fm = gid * WGM, gsz = (nM - fm) < WGM ? (nM - fm) : WGM;
        u.pm = fm + ((wgid % nig) % gsz); u.pn = (wgid % nig) / gsz; return true;
    }
};

#define PG8_BARRIER() do { asm volatile("s_waitcnt lgkmcnt(0)" ::: "memory"); __builtin_amdgcn_s_barrier(); asm volatile("" ::: "memory"); } while (0)

struct EpiProj {
    static constexpr bool PERM = true, HOOKS = false; static constexpr int MIDT = 0;
    bf16_t* base;
    size_t tstride;
    const float *qg, *kg, *zg;
    LAS float* xch;
    __device__ __forceinline__ void begin(const Unit&, int, int) const {}
    __device__ __forceinline__ void mid(f32x4 (&)[2][2][4][2], int, int, int) const {}
    __device__ __forceinline__ void operator()(f32x4 (&acc)[2][2][4][2], const Unit& u, int ui, int wr, int wc, int fr, int fq) const {
        const int type = u.pn >> 2, colt = (u.pn & 3) * 256;
        bf16_t* O = base + (size_t)type * tstride;
        const int row0 = u.pm * BM + wr * 64 + fr, col0 = colt + wc * 32 + 8 * fq;
        if (type >= 3) {
#pragma unroll
            for (int ai = 0; ai < 2; ++ai)
#pragma unroll
                for (int bj = 0; bj < 2; ++bj)
#pragma unroll
                    for (int m = 0; m < 4; ++m)
#pragma unroll
                        for (int n = 0; n < 2; ++n) acc[ai][bj][m][n] = gelu4(acc[ai][bj][m][n]);
        }
        if (type == 0 || type == 1 || type == 4) {
#pragma unroll
            for (int ai = 0; ai < 2; ++ai)
#pragma unroll
                for (int m = 0; m < 4; ++m)
#pragma unroll
                    for (int bj = 0; bj < 2; ++bj) {
                        const f32x4 a = acc[ai][bj][m][0], b = acc[ai][bj][m][1];
                        float s = (a[0] * a[0] + a[1] * a[1]) + (a[2] * a[2] + a[3] * a[3]) + (b[0] * b[0] + b[1] * b[1]) + (b[2] * b[2] + b[3] * b[3]);
                        s += __shfl_xor(s, 16); s += __shfl_xor(s, 32);
                        if (fq == 0) xch[((ai * HALF + wr * 64 + m * 16 + fr) * 2 + bj) * 4 + wc] = s;
                    }
            PG8_BARRIER();
            const float* gp = type == 0 ? qg : (type == 1 ? kg : zg + (u.pn & 3) * 256);
            const float sc = type == 0 ? QSCALE : 1.0f;
            f32x4 gv[2][2];
#pragma unroll
            for (int bj = 0; bj < 2; ++bj)
#pragma unroll
                for (int n = 0; n < 2; ++n) gv[bj][n] = *(const f32x4*)(gp + (type == 4 ? bj * 128 : 0) + wc * 32 + 8 * fq + 4 * n) * sc;
#pragma unroll
            for (int ai = 0; ai < 2; ++ai)
#pragma unroll
                for (int m = 0; m < 4; ++m)
#pragma unroll
                    for (int bj = 0; bj < 2; ++bj) {
                        const f32x4 p = *(const LAS f32x4*)(xch + ((ai * HALF + wr * 64 + m * 16 + fr) * 2 + bj) * 4);
                        const float rinv = 1.0f / sqrtf(((p[0] + p[1]) + (p[2] + p[3])) * (1.0f / 128.0f) + EPS);
                        acc[ai][bj][m][0] = acc[ai][bj][m][0] * rinv * gv[bj][0]; acc[ai][bj][m][1] = acc[ai][bj][m][1] * rinv * gv[bj][1];
                    }
        }
#pragma unroll
        for (int ai = 0; ai < 2; ++ai)
#pragma unroll
            for (int m = 0; m < 4; ++m) { bf16_t* rowp = O + (size_t)(row0 + ai * HALF + m * 16) * AW + col0;
#pragma unroll
                for (int bj = 0; bj < 2; ++bj) { const f32x4 v0 = acc[ai][bj][m][0], v1 = acc[ai][bj][m][1];
                    u32x4 w; w.x = cvtpk(v0[0], v0[1]); w.y = cvtpk(v0[2], v0[3]); w.z = cvtpk(v1[0], v1[1]); w.w = cvtpk(v1[2], v1[3]);
                    *(u32x4*)(rowp + bj * HALF) = w; } }
    }
};

struct EpiRes1 {
    static constexpr bool PERM = false, HOOKS = true; static constexpr int MIDT = 16;
    const float* x; float* out; const float* mod;
    const float *ssa, *ssg;
    LAS float* rt;
    __device__ __forceinline__ void begin(const Unit&, int, int) const {}
    __device__ __forceinline__ void fill(const Unit& u, int ui, int row) const {
        const size_t gr = (size_t)u.pm * BM + row;
        const f32x4 a0 = *(const f32x4*)(ssa + gr * 8), a1 = *(const f32x4*)(ssa + gr * 8 + 4);
        const float sa = ((a0[0] + a0[1]) + (a0[2] + a0[3])) + ((a1[0] + a1[1]) + (a1[2] + a1[3]));
        const f32x4 a = *(const f32x4*)(ssg + gr * 16), b = *(const f32x4*)(ssg + gr * 16 + 4), c = *(const f32x4*)(ssg + gr * 16 + 8), d = *(const f32x4*)(ssg + gr * 16 + 12);
        const float sg = (((a[0] + a[1]) + (a[2] + a[3])) + ((b[0] + b[1]) + (b[2] + b[3]))) + (((c[0] + c[1]) + (c[2] + c[3])) + ((d[0] + d[1]) + (d[2] + d[3])));
        const float ra = 1.0f / sqrtf(sa * (1.0f / 1024.0f) + EPS), rg = 1.0f / sqrtf(sg * (1.0f / 1024.0f) + EPS);
        *(LAS f32x2*)(rt + ((ui & 3) * 256 + row) * 2) = (f32x2){ra / rg, rg};
    }
    __device__ __forceinline__ void mid(f32x4 (&acc)[2][2][4][2], int ui, int wr, int fr) const {
#pragma unroll
        for (int ai = 0; ai < 2; ++ai)
#pragma unroll
            for (int m = 0; m < 4; ++m) { const float f = rt[((ui & 3) * 256 + ai * HALF + wr * 64 + m * 16 + fr) * 2];
#pragma unroll
                for (int bj = 0; bj < 2; ++bj)
#pragma unroll
                    for (int n = 0; n < 2; ++n) acc[ai][bj][m][n] = acc[ai][bj][m][n] * f; }
    }
    __device__ __forceinline__ void operator()(f32x4 (&acc)[2][2][4][2], const Unit& u, int ui, int wr, int wc, int fr, int fq) const {
        const int row0 = u.pm * BM + wr * 64 + fr, col0 = u.pn * BM + wc * 32 + 4 * fq;
        const float* gp = mod + (size_t)(u.pm >> 3) * NMOD + 2 * DM + col0;
        f32x4 gv[2][2];
#pragma unroll
        for (int bj = 0; bj < 2; ++bj)
#pragma unroll
            for (int n = 0; n < 2; ++n) gv[bj][n] = *(const f32x4*)(gp + bj * HALF + n * 16);
#pragma unroll
        for (int ai = 0; ai < 2; ++ai)
#pragma unroll
            for (int m = 0; m < 4; ++m) { const size_t off = (size_t)(row0 + ai * HALF + m * 16) * DM + col0;
                const float rg = rt[((ui & 3) * 256 + ai * HALF + wr * 64 + m * 16 + fr) * 2 + 1];
#pragma unroll
                for (int bj = 0; bj < 2; ++bj)
#pragma unroll
                    for (int n = 0; n < 2; ++n) { const f32x4 xv = *(const f32x4*)(x + off + bj * HALF + n * 16);
                        *(f32x4*)(out + off + bj * HALF + n * 16) = xv + gv[bj][n] * (acc[ai][bj][m][n] * rg); } }
    }
};

struct EpiRelu2 {
    static constexpr bool PERM = true, HOOKS = false; static constexpr int MIDT = 0;
    bf16_t* O; int ldc;
    __device__ __forceinline__ void begin(const Unit&, int, int) const {}
    __device__ __forceinline__ void mid(f32x4 (&)[2][2][4][2], int, int, int) const {}
    __device__ __forceinline__ void operator()(f32x4 (&acc)[2][2][4][2], const Unit& u, int ui, int wr, int wc, int fr, int fq) const {
        const int row0 = u.pm * BM + wr * 64 + fr, col0 = u.pn * BM + wc * 32 + 8 * fq;
#pragma unroll
        for (int ai = 0; ai < 2; ++ai)
#pragma unroll
            for (int m = 0; m < 4; ++m) { bf16_t* rowp = O + blk_off((size_t)(row0 + ai * HALF + m * 16), col0, ldc);
#pragma unroll
                for (int bj = 0; bj < 2; ++bj) { f32x4 v0 = acc[ai][bj][m][0], v1 = acc[ai][bj][m][1];
                    v0 = __builtin_elementwise_max(v0, (f32x4){0.f, 0.f, 0.f, 0.f}); v1 = __builtin_elementwise_max(v1, (f32x4){0.f, 0.f, 0.f, 0.f}); v0 = v0 * v0; v1 = v1 * v1;
                    u32x4 w; w.x = cvtpk(v0[0], v0[1]); w.y = cvtpk(v0[2], v0[3]); w.z = cvtpk(v1[0], v1[1]); w.w = cvtpk(v1[2], v1[3]);
                    *(u32x4*)(rowp + bj * 2 * 16384) = w; } }
    }
};

struct EpiRes2 {
    static constexpr bool PERM = false, HOOKS = false; static constexpr int MIDT = 0;
    float* out; const float* mod;
    __device__ __forceinline__ void begin(const Unit&, int, int) const {}
    __device__ __forceinline__ void mid(f32x4 (&)[2][2][4][2], int, int, int) const {}
    __device__ __forceinline__ void operator()(f32x4 (&acc)[2][2][4][2], const Unit& u, int ui, int wr, int wc, int fr, int fq) const {
        const int row0 = u.pm * BM + wr * 64 + fr, col0 = u.pn * BM + wc * 32 + 4 * fq;
        const float* gp = mod + (size_t)(u.pm >> 3) * NMOD + 5 * DM + col0;
        f32x4 gv[2][2];
#pragma unroll
        for (int bj = 0; bj < 2; ++bj)
#pragma unroll
            for (int n = 0; n < 2; ++n) gv[bj][n] = *(const f32x4*)(gp + bj * HALF + n * 16);
#pragma unroll
        for (int ai = 0; ai < 2; ++ai)
#pragma unroll
            for (int m = 0; m < 4; ++m) { const size_t off = (size_t)(row0 + ai * HALF + m * 16) * DM + col0;
#pragma unroll
                for (int bj = 0; bj < 2; ++bj)
#pragma unroll
                    for (int n = 0; n < 2; ++n) { const f32x4 xv = *(const f32x4*)(out + off + bj * HALF + n * 16);
                        *(f32x4*)(out + off + bj * HALF + n * 16) = xv + gv[bj][n] * acc[ai][bj][m][n]; } }
    }
};

template <class Epi, class Sched>
__device__ __forceinline__ void gemm_phase(LAS unsigned char* lds, const Gemm g, const Sched& S, const Epi& E) {
    const int tid = threadIdx.x, wid = __builtin_amdgcn_readfirstlane(tid >> 6), lane = tid & 63, wr = wid >> 2, wc = wid & 3, fr = lane & 15, fq = lane >> 4;
    const int K = g.K, nt = K / BK;
    unsigned voffA[2], voffB[2];
#pragma unroll
    for (int i = 0; i < 2; ++i) { int R, C; stage_rc(tid * 16 + i * 8192, R, C); const int Rb = Epi::PERM ? ((R & ~31) + perm32(R & 31)) : R;
        voffA[i] = (unsigned)(R * 64 + C) * 2u; voffB[i] = (unsigned)(Rb * 64 + C) * 2u; }
    const size_t kstep = (size_t)(256 * BK * 2);
    const size_t hstep = (size_t)HALF * BK * 2;
    const size_t tstep = (size_t)256 * K * 2;
    const unsigned ldsw = (unsigned)wid * 1024u;
    const int aoff = lds_byte(wr * 64 + fr, fq * 8), boff = lds_byte(wc * 32 + fr, fq * 8);
#define PG8_SA(b, h) (((b) * 2 + (h)) * HTB)
#define PG8_SB(b, h) ((4 + (b) * 2 + (h)) * HTB)
#define PG8_STAGE(bufoff, gbase, voff) do { _Pragma("unroll") for (int _i = 0; _i < 2; ++_i) \
        __builtin_amdgcn_global_load_lds((const unsigned*)((const char*)(gbase) + (voff)[_i]), (LAS unsigned*)(lds + (bufoff) + ldsw + _i * 8192), 16, 0, 0); } while (0)
#define PG8_LDA(dst, b, h) do { _Pragma("unroll") for (int m = 0; m < 4; ++m) _Pragma("unroll") for (int k = 0; k < 2; ++k) dst[m][k] = *(const LAS bf16x8*)(lds + PG8_SA(b, h) + aoff + m * 2048 + k * 1024); } while (0)
#define PG8_LDB(dst, b, h) do { _Pragma("unroll") for (int n = 0; n < 2; ++n) _Pragma("unroll") for (int k = 0; k < 2; ++k) dst[n][k] = *(const LAS bf16x8*)(lds + PG8_SB(b, h) + boff + n * 2048 + k * 1024); } while (0)
#define PG8_MMA(ai, bj, At, Bt) do { __builtin_amdgcn_s_setprio(1); _Pragma("unroll") for (int m = 0; m < 4; ++m) _Pragma("unroll") for (int n = 0; n < 2; ++n) _Pragma("unroll") for (int k = 0; k < 2; ++k) \
        acc[ai][bj][m][n] = __builtin_amdgcn_mfma_f32_16x16x32_bf16(Bt[n][k], At[m][k], acc[ai][bj][m][n], 0, 0, 0); __builtin_amdgcn_s_setprio(0); } while (0)
#define PG8_WAIT_V(n) asm volatile("s_waitcnt vmcnt(" #n ")" ::: "memory")
#define PG8_WAIT_L(n) asm volatile("s_waitcnt lgkmcnt(" #n ")" ::: "memory")
#define PG8_BAR __builtin_amdgcn_s_barrier()
#define PG8_SCHED __builtin_amdgcn_sched_barrier(0)
    Unit cur, nxt; int ui = 0;
    if (!S.next(0, cur)) return;
    f32x4 acc[2][2][4][2];
#pragma unroll
    for (int a = 0; a < 2; ++a)
#pragma unroll
        for (int b = 0; b < 2; ++b)
#pragma unroll
            for (int m = 0; m < 4; ++m)
#pragma unroll
                for (int n = 0; n < 2; ++n) acc[a][b][m][n] = (f32x4){0.f, 0.f, 0.f, 0.f};
    bf16x8 At[4][2], B0[2][2], B1[2][2];
    const char* cA = (const char*)g.A + (size_t)cur.pm * tstep; const char* cB = (const char*)g.Bt + (size_t)cur.pn * tstep;
    PG8_STAGE(PG8_SB(0, 0), cB, voffB); PG8_STAGE(PG8_SB(0, 1), cB + hstep, voffB); PG8_STAGE(PG8_SA(0, 0), cA, voffA); PG8_STAGE(PG8_SA(0, 1), cA + hstep, voffA);
    if (wr == 1) PG8_BAR;
    PG8_WAIT_V(2); PG8_BAR;
    PG8_STAGE(PG8_SB(1, 0), cB + kstep, voffB); PG8_STAGE(PG8_SA(1, 0), cA + kstep, voffA); PG8_STAGE(PG8_SB(1, 1), cB + hstep + kstep, voffB);
    PG8_WAIT_V(6); PG8_BAR;
    for (;;) {
        const bool has_next = S.next(ui + 1, nxt);
        const char* nA = has_next ? (const char*)g.A + (size_t)nxt.pm * tstep : cA; const char* nB = has_next ? (const char*)g.Bt + (size_t)nxt.pn * tstep : cB;
        for (int t = 0; t < nt; t += 2) {
            const bool last = (t == nt - 2);
            const char* a1 = cA + (size_t)(t + 1) * kstep;
            const char* a2 = last ? nA : cA + (size_t)(t + 2) * kstep; const char* b2 = last ? nB : cB + (size_t)(t + 2) * kstep;
            const char* a3 = a2 + kstep; const char* b3 = b2 + kstep;
            if constexpr (Epi::HOOKS) { if (t == Epi::MIDT) E.mid(acc, ui, wr, fr); }
            PG8_LDB(B0, 0, 0); PG8_LDB(B1, 0, 1); PG8_SCHED; PG8_LDA(At, 0, 0); PG8_STAGE(PG8_SA(1, 1), a1 + hstep, voffA);
            PG8_WAIT_V(8); PG8_WAIT_L(0); PG8_BAR; PG8_MMA(0, 0, At, B0); PG8_MMA(0, 1, At, B1); PG8_BAR; PG8_SCHED;
            PG8_LDA(At, 0, 1); PG8_STAGE(PG8_SB(0, 0), b2, voffB); PG8_STAGE(PG8_SB(0, 1), b2 + hstep, voffB); PG8_STAGE(PG8_SA(0, 0), a2, voffA);
            PG8_WAIT_V(8); PG8_WAIT_L(0); PG8_BAR; PG8_MMA(1, 0, At, B0); PG8_MMA(1, 1, At, B1); PG8_BAR; PG8_SCHED;
            PG8_LDB(B0, 1, 0); PG8_LDB(B1, 1, 1); PG8_SCHED; PG8_LDA(At, 1, 0); PG8_STAGE(PG8_SA(0, 1), a2 + hstep, voffA);
            PG8_WAIT_V(8); PG8_WAIT_L(0); PG8_BAR; PG8_MMA(0, 0, At, B0); PG8_MMA(0, 1, At, B1); PG8_BAR; PG8_SCHED;
            PG8_LDA(At, 1, 1); PG8_STAGE(PG8_SB(1, 0), b3, voffB); PG8_STAGE(PG8_SB(1, 1), b3 + hstep, voffB); PG8_STAGE(PG8_SA(1, 0), a3, voffA);
            PG8_WAIT_V(8); PG8_WAIT_L(0); PG8_BAR; PG8_MMA(1, 0, At, B0); PG8_MMA(1, 1, At, B1); PG8_BAR; PG8_SCHED;
        }
        if (wr == 0) PG8_BAR;
        E(acc, cur, ui, wr, wc, fr, fq);
        if (!has_next) break;
#pragma unroll
        for (int a = 0; a < 2; ++a)
#pragma unroll
            for (int b = 0; b < 2; ++b)
#pragma unroll
                for (int m = 0; m < 4; ++m)
#pragma unroll
                    for (int n = 0; n < 2; ++n) acc[a][b][m][n] = (f32x4){0.f, 0.f, 0.f, 0.f};
        cur = nxt; cA = nA; cB = nB; ++ui;
        if (wr == 1) PG8_BAR;
    }
    PG8_WAIT_V(0);
    PG8_BAR;
#undef PG8_SA
#undef PG8_SB
#undef PG8_STAGE
#undef PG8_LDA
#undef PG8_LDB
#undef PG8_MMA
#undef PG8_WAIT_V
#undef PG8_WAIT_L
#undef PG8_BAR
#undef PG8_SCHED
}
}

typedef GAS unsigned gu32;
#define RLX_AGENT __ATOMIC_RELAXED, __HIP_MEMORY_SCOPE_AGENT
#define XB_TMO      128
#define XB_XCNT(j)  (256  + 64 * (j))
#define XB_XSUB(j)  (1280 + 64 * (j))
#define XB_XGEN(j)  (2304 + 64 * (j))
#define XB_TOP      3328
#define XB_TOPGEN   3392
#define XCD_BAR_WORDS 3456
#define XB_SPIN_CAP (1u << 20)
__device__ __forceinline__ unsigned xb_ld(unsigned* p)              { return __hip_atomic_load(p, __ATOMIC_RELAXED, __HIP_MEMORY_SCOPE_AGENT); }
__device__ __forceinline__ unsigned xb_add(unsigned* p, unsigned v) { return __hip_atomic_fetch_add(p, v, __ATOMIC_RELAXED, __HIP_MEMORY_SCOPE_AGENT); }
__device__ __forceinline__ unsigned xb_xcc_id() { return (unsigned)__builtin_amdgcn_s_getreg((3 << 11) | 20) & 0xFu; }
#define XB_SPIN(cond, bar) do { unsigned _sp = 0; while (cond) { __builtin_amdgcn_s_sleep(1); \
    if ((++_sp & 255u) == 0u) { if (xb_ld(&(bar)[XB_TMO])) break; if (_sp > XB_SPIN_CAP) { atomicAdd(&(bar)[XB_TMO], 1u); break; } } } } while (0)
struct XcdBarrier { unsigned* bar; unsigned x; volatile LAS unsigned* st; };
__device__ __forceinline__ XcdBarrier xcd_barrier_post(unsigned* bar, volatile LAS unsigned* st) {
    XcdBarrier b; b.bar = bar; b.x = xb_xcc_id(); b.st = st;
    if (threadIdx.x == 0) (void)xb_add(&bar[XB_XCNT(b.x)], 1u);
    return b;
}
__device__ __forceinline__ void xcd_barrier_complete(unsigned* bar, unsigned x, unsigned& nloc, unsigned& nx) {
    const unsigned G = gridDim.x * gridDim.y * gridDim.z;
    unsigned sum, cnt, mine, sp = 0u;
    for (;;) {
        sum = 0u; cnt = 0u; mine = 0u;
#pragma unroll
        for (unsigned j = 0; j < 16; ++j) { const unsigned c = xb_ld(&bar[XB_XCNT(j)]); sum += c; cnt += (c > 0u) ? 1u : 0u; mine = (j == x) ? c : mine; }
        if (sum == G) break;
        __builtin_amdgcn_s_sleep(1);
        if ((++sp & 255u) == 0u) { if (xb_ld(&bar[XB_TMO])) break; if (sp > XB_SPIN_CAP) { atomicAdd(&bar[XB_TMO], 1u); break; } }
    }
    nloc = mine > 0u ? mine : 1u; nx = cnt > 0u ? cnt : 1u;
}
__device__ __forceinline__ void xcd_barrier(const XcdBarrier& b) {
    asm volatile("s_waitcnt vmcnt(0)" ::: "memory");
    __syncthreads();
    if (threadIdx.x == 0) {
        unsigned* bar = b.bar;
        __builtin_amdgcn_s_waitcnt(0);
        unsigned nloc = b.st[0], nx = b.st[1];
        if (nloc == 0u) { xcd_barrier_complete(bar, b.x, nloc, nx); b.st[0] = nloc; b.st[1] = nx; }
        const unsigned old = xb_add(&bar[XB_XSUB(b.x)], 1u);
        const unsigned gen = old / nloc;
        if (old + 1u == (gen + 1u) * nloc) {
            __builtin_amdgcn_fence(__ATOMIC_RELEASE, "agent");
            asm volatile("s_waitcnt vmcnt(0)" ::: "memory");
            const unsigned og = xb_add(&bar[XB_TOP], 1u);
            const unsigned tg = og / nx;
            if (og + 1u == (tg + 1u) * nx) xb_add(&bar[XB_TOPGEN], 1u);
            else XB_SPIN(xb_ld(&bar[XB_TOPGEN]) == tg, bar);
            __builtin_amdgcn_fence(__ATOMIC_ACQUIRE, "agent");
            xb_add(&bar[XB_XGEN(b.x)], 1u);
            asm volatile("s_waitcnt vmcnt(0)" ::: "memory");
        } else {
            XB_SPIN(xb_ld(&bar[XB_XGEN(b.x)]) == gen, bar);
            __builtin_amdgcn_fence(__ATOMIC_ACQUIRE, "agent");
            asm volatile("s_waitcnt vmcnt(0)" ::: "memory");
        }
    }
    __syncthreads();
}

struct Args { const float* in[18]; float* out; unsigned char* ws; int ph_lo, ph_hi, li, pad; };
struct Frame {
    LAS unsigned char* lds;
    int tid, lane, wave, vcu, G;
};
#define LDS_WAIT() asm volatile("s_waitcnt lgkmcnt(0)" ::: "memory")

__device__ __forceinline__ void p0_ada(const Frame& F, const float* c, const float* w_ada, const float* b_ada, float* mod) {
    LAS float* sc = (LAS float*)F.lds;
    LAS float* part = (LAS float*)(F.lds + 65536);
    for (int i = F.tid; i < NBATCH * DM; i += 512) { const int b = i >> 11, k = i & 2047; const float v = c[i]; sc[k * 8 + b] = v / (1.0f + __expf(-v)); }
    __syncthreads();
    const int kk = F.lane / 12, c4 = F.lane % 12;
    for (int item = blockIdx.x; item < 256; item += F.G) {
        const int n0 = 48 * item, kb = 256 * F.wave;
        f32x4 acc[8];
#pragma unroll
        for (int b = 0; b < 8; ++b) acc[b] = (f32x4){0.f, 0.f, 0.f, 0.f};
        if (F.lane < 60) {
            const float* wp = w_ada + (size_t)(kb + kk) * NMOD + n0 + 4 * c4;
#pragma unroll 3
            for (int i = 0; i < 51; ++i) {
                const int k = kb + kk + 5 * i;
                const f32x4 w = *(const f32x4*)(wp + (size_t)(5 * i) * NMOD);
                const f32x4 s0 = *(const LAS f32x4*)(sc + k * 8), s1 = *(const LAS f32x4*)(sc + k * 8 + 4);
                acc[0] += w * s0[0]; acc[1] += w * s0[1]; acc[2] += w * s0[2]; acc[3] += w * s0[3];
                acc[4] += w * s1[0]; acc[5] += w * s1[1]; acc[6] += w * s1[2]; acc[7] += w * s1[3];
            }
            if (kk == 0) {
                const int k = kb + 255;
                const f32x4 w = *(const f32x4*)(w_ada + (size_t)k * NMOD + n0 + 4 * c4);
                const f32x4 s0 = *(const LAS f32x4*)(sc + k * 8), s1 = *(const LAS f32x4*)(sc + k * 8 + 4);
                acc[0] += w * s0[0]; acc[1] += w * s0[1]; acc[2] += w * s0[2]; acc[3] += w * s0[3];
                acc[4] += w * s1[0]; acc[5] += w * s1[1]; acc[6] += w * s1[2]; acc[7] += w * s1[3];
            }
#pragma unroll
            for (int b = 0; b < 8; ++b) *(LAS f32x4*)(part + (F.wave * 5 + kk) * 384 + b * 48 + 4 * c4) = acc[b];
        }
        __syncthreads();
        if (F.tid < 384) { float s = 0.f;
#pragma unroll 8
            for (int j = 0; j < 40; ++j) s += part[j * 384 + F.tid];
            const int b = F.tid / 48, n = F.tid % 48; mod[(size_t)b * NMOD + n0 + n] = s + b_ada[n0 + n]; }
        __syncthreads();
    }
}

__device__ __forceinline__ void p1_transpose_item(const float* W, int K, int N, bf16_t* WT, LAS float* scr, int item, int lane, const float* ks0, const float* ks1) {
    const int nblk = N / 32, kb = item / nblk, nb = item % nblk, k0 = 64 * kb, n0 = 32 * nb;
#pragma unroll 8
    for (int i = 0; i < 32; ++i) { const int kk = 2 * i + (lane >> 5); float v = W[(size_t)(k0 + kk) * N + n0 + (lane & 31)];
        if (ks0) { const int k = k0 + kk; v *= (k < 1024 ? ks0[k] : ks1[k - 1024]); }
        scr[kk * 33 + (lane & 31)] = v; }
    LDS_WAIT(); asm volatile("" ::: "memory");
    const int c = lane & 7;
#pragma unroll
    for (int j = 0; j < 4; ++j) { const int n = (lane >> 3) + 8 * j; const LAS float* s = scr + (8 * c) * 33 + n;
        u32x4 o; o.x = cvtpk(s[0 * 33], s[1 * 33]); o.y = cvtpk(s[2 * 33], s[3 * 33]); o.z = cvtpk(s[4 * 33], s[5 * 33]); o.w = cvtpk(s[6 * 33], s[7 * 33]);
        *(u32x4*)(WT + blk_off((size_t)(n0 + n), k0 + 8 * c, K)) = o; }
    LDS_WAIT(); asm volatile("" ::: "memory");
}
__device__ __forceinline__ void norm_mod_row(const float* xrow, const float* g, const float* shift, const float* scale, bf16_t* Hb, int m, int lane) {
    const f32x4* xr = (const f32x4*)xrow + lane;
    f32x4 v[8]; float s = 0.f;
#pragma unroll
    for (int j = 0; j < 8; ++j) { v[j] = xr[64 * j]; s += (v[j][0] * v[j][0] + v[j][1] * v[j][1]) + (v[j][2] * v[j][2] + v[j][3] * v[j][3]); }
    const float rinv = 1.0f / sqrtf(wave_sum(s) * (1.0f / DM) + EPS);
    bf16_t* ob = Hb + blk_off((size_t)m, 4 * lane, DM);
#pragma unroll
    for (int j = 0; j < 8; ++j) { const f32x4 gg = ((const f32x4*)g)[lane + 64 * j], sc = ((const f32x4*)scale)[lane + 64 * j], sh = ((const f32x4*)shift)[lane + 64 * j];
        const f32x4 o = (v[j] * rinv) * gg * (sc + 1.0f) + sh; u32x2 w; w.x = cvtpk(o[0], o[1]); w.y = cvtpk(o[2], o[3]); *(u32x2*)(ob + (size_t)j * 4 * 16384) = w; }
}

__device__ __forceinline__ unsigned off_b(unsigned row, unsigned ch) { return 256u * row + 16u * (ch ^ (((row & 3) << 2) | ((row >> 2) & 3))); }
__device__ __forceinline__ v4i16_t vtr(LAS unsigned char* p) { return __builtin_amdgcn_ds_read_tr16_b64_v4i16((LAS v4i16_t*)p); }
__device__ __forceinline__ int crow(int r, int hi) { return (r & 3) + 8 * (r >> 2) + 4 * hi; }

constexpr int AT_BT = 0;
constexpr int AT_K = 2048, AT_V = AT_K + 2 * 16384;
constexpr float ATT_THR = 6.0f;

__device__ __forceinline__ void attn_unit(const Frame& F, const bf16_t* Q, const bf16_t* Kg, const bf16_t* Vg, bf16_t* MIX, float* SSA, const float* relb, int b, int h, int g4) {
    LAS unsigned char* lds = F.lds;
    const int tid = F.tid, lane = F.lane, wid = F.wave, r32 = lane & 31, hi = lane >> 5;
    LAS float* bt = (LAS float*)(lds + AT_BT);
    if (tid < NREL) bt[tid] = relb[h * NREL + tid] * LOG2E;
    const int c = 4 * g4 + (wid >> 1);
    const size_t qrow = (size_t)b * SEQ + 64 * c + 32 * (wid & 1) + r32;
    bf16x8 qf[8];
#pragma unroll
    for (int ks = 0; ks < 8; ++ks) qf[ks] = *(const bf16x8*)(Q + qrow * AW + h * HD + 16 * ks + 8 * hi);
    const int kc_lo = (4 * g4 - LEFT) > 0 ? (4 * g4 - LEFT) : 0, kc_hi = 4 * g4 + 3, nsteps = kc_hi - kc_lo + 1;
    const int srow = tid >> 4, sch = tid & 15;
    const bf16_t* kp = Kg + ((size_t)b * SEQ + (size_t)kc_lo * CHUNK + srow) * AW + h * HD + sch * 8;
    const bf16_t* vp = Vg + ((size_t)b * SEQ + (size_t)kc_lo * CHUNK + srow) * AW + h * HD + sch * 8;
    const unsigned so0 = off_b(srow, sch), so1 = off_b(srow + 32, sch);
    u32x4 sk0, sk1, sv0, sv1;
    sk0 = *(const u32x4*)kp; sk1 = *(const u32x4*)(kp + 32 * AW); sv0 = *(const u32x4*)vp; sv1 = *(const u32x4*)(vp + 32 * AW);
    unsigned ka[8];
#pragma unroll
    for (int ks = 0; ks < 8; ++ks) ka[ks] = off_b(r32, 2 * ks + hi);
    const unsigned blk = (lane >> 4) & 1, q4 = (lane & 15) >> 2, p4 = lane & 3;
    unsigned va[4][2];
#pragma unroll
    for (int dt = 0; dt < 4; ++dt)
#pragma unroll
        for (int tp = 0; tp < 2; ++tp) va[dt][tp] = off_b(4 * hi + q4 + 8 * tp, 4 * dt + 2 * blk + (p4 >> 1)) + 8 * (p4 & 1);
    float m_run = -1e30f, l_run = 0.f;
    f32x16 o[4];
#pragma unroll
    for (int dt = 0; dt < 4; ++dt) o[dt] = (f32x16){};
    const int qin = 32 * (wid & 1) + r32;
    for (int s = 0; s < nsteps; ++s) {
        const int kc = kc_lo + s, buf = s & 1;
        LAS unsigned char* Kb = lds + AT_K + buf * 16384; LAS unsigned char* Vb = lds + AT_V + buf * 16384;
        *(LAS u32x4*)(Kb + so0) = sk0; *(LAS u32x4*)(Kb + so1) = sk1; *(LAS u32x4*)(Vb + so0) = sv0; *(LAS u32x4*)(Vb + so1) = sv1;
        if (s + 1 < nsteps) { kp += (size_t)CHUNK * AW; vp += (size_t)CHUNK * AW;
            sk0 = *(const u32x4*)kp; sk1 = *(const u32x4*)(kp + 32 * AW); sv0 = *(const u32x4*)vp; sv1 = *(const u32x4*)(vp + 32 * AW); }
        LDS_WAIT(); __builtin_amdgcn_s_barrier(); asm volatile("" ::: "memory");
        const int delta = c - kc;
        if (delta >= 0 && delta <= LEFT) {
#pragma unroll
            for (int t = 0; t < 2; ++t) {
                f32x16 sc = (f32x16){};
#pragma unroll
                for (int ks = 0; ks < 8; ++ks) { const bf16x8 kf = *(const LAS bf16x8*)(Kb + ka[ks] + t * 8192); sc = __builtin_amdgcn_mfma_f32_32x32x16_bf16(kf, qf[ks], sc, 0, 0, 0); }
                if (delta >= 3) { const float bc = bt[2 * MAXREL];
#pragma unroll
                    for (int r = 0; r < 16; ++r) sc[r] += bc;
                } else { const int lb = 64 * delta + qin - 32 * t - 4 * hi + MAXREL;
#pragma unroll
                    for (int r = 0; r < 16; ++r) { int idx = lb - ((r & 3) + 8 * (r >> 2)); idx = idx > 2 * MAXREL ? 2 * MAXREL : idx; sc[r] += bt[idx]; } }
                float tm = sc[0];
#pragma unroll
                for (int r = 1; r < 16; ++r) tm = fmaxf(tm, sc[r]);
                tm = fmaxf(tm, __shfl_xor(tm, 32));
                if (!__all(tm <= m_run + ATT_THR)) {
                    const float mn = fmaxf(m_run, tm), al = __builtin_amdgcn_exp2f(m_run - mn); m_run = mn; l_run *= al;
#pragma unroll
                    for (int dt = 0; dt < 4; ++dt) o[dt] = o[dt] * al;
                }
                float ps = 0.f;
#pragma unroll
                for (int r = 0; r < 16; ++r) { sc[r] = __builtin_amdgcn_exp2f(sc[r] - m_run); ps += sc[r]; }
                l_run += ps;
                bf16x8 pb[2];
#pragma unroll
                for (int s2 = 0; s2 < 2; ++s2) { u32x4 w; w.x = cvtpk(sc[8 * s2 + 0], sc[8 * s2 + 1]); w.y = cvtpk(sc[8 * s2 + 2], sc[8 * s2 + 3]); w.z = cvtpk(sc[8 * s2 + 4], sc[8 * s2 + 5]); w.w = cvtpk(sc[8 * s2 + 6], sc[8 * s2 + 7]); pb[s2] = __builtin_bit_cast(bf16x8, w); }
#pragma unroll
                for (int dt = 0; dt < 4; ++dt)
#pragma unroll
                    for (int s2 = 0; s2 < 2; ++s2) {
                        const v4i16_t lo = vtr(Vb + va[dt][0] + (32 * t + 16 * s2) * 256), hh = vtr(Vb + va[dt][1] + (32 * t + 16 * s2) * 256);
                        const bf16x8 vf = (bf16x8){lo[0], lo[1], lo[2], lo[3], hh[0], hh[1], hh[2], hh[3]};
                        o[dt] = __builtin_amdgcn_mfma_f32_32x32x16_bf16(vf, pb[s2], o[dt], 0, 0, 0);
                    }
            }
        }
    }
    const float lt = l_run + __shfl_xor(l_run, 32), inv = 1.0f / lt;
    float ss = 0.f;
    bf16_t* orow = MIX + blk_off(qrow, h * HD, DM);
#pragma unroll
    for (int dt = 0; dt < 4; ++dt)
#pragma unroll
        for (int rg = 0; rg < 4; ++rg) {
            const float a0 = o[dt][4 * rg] * inv, a1 = o[dt][4 * rg + 1] * inv, a2 = o[dt][4 * rg + 2] * inv, a3 = o[dt][4 * rg + 3] * inv;
            ss += (a0 * a0 + a1 * a1) + (a2 * a2 + a3 * a3);
            u32x2 w; w.x = cvtpk(a0, a1); w.y = cvtpk(a2, a3);
            *(u32x2*)(orow + (dt >> 1) * 16384 + 32 * (dt & 1) + 8 * rg + 4 * hi) = w;
        }
    ss += __shfl_xor(ss, 32);
    if (hi == 0) SSA[qrow * 8 + h] = ss;
    LDS_WAIT(); __builtin_amdgcn_s_barrier(); asm volatile("" ::: "memory");
}

__device__ __forceinline__ void gmlp_unit(const Frame& F, const bf16_t* U, const bf16_t* ZN, const bf16_t* WSP, const float* bsp, bf16_t* MIX, float* SSG, int b, int nb, int g) {
    LAS unsigned char* lds = F.lds + AT_K;
    const int tid = F.tid, lane = F.lane, wid = F.wave, r32 = lane & 31, hi = lane >> 5;
    const size_t row0 = (size_t)b * SEQ + 128 * nb;
#pragma unroll
    for (int i = 0; i < 4; ++i) { const int n = tid + 512 * i, row = n >> 4, ch = n & 15;
        const u32x4 v = *(const u32x4*)(ZN + (row0 + row) * AW + g * HD + ch * 8); *(LAS u32x4*)(lds + off_b(row, ch)) = v; }
    const int tt = wid & 3, chh = wid >> 2;
    const int trow = 32 * tt + r32;
    const bf16_t* wrow = WSP + ((size_t)g * 128 + trow) * 128 + 8 * hi;
    const int nks = tt < 2 ? 4 : 8;
    LDS_WAIT(); __builtin_amdgcn_s_barrier(); asm volatile("" ::: "memory");
    const unsigned blk = (lane >> 4) & 1, q4 = (lane & 15) >> 2, p4 = lane & 3;
    f32x16 acc[2]; acc[0] = (f32x16){}; acc[1] = (f32x16){};
    for (int ks = 0; ks < nks; ++ks) {
        const bf16x8 wf = *(const bf16x8*)(wrow + 16 * ks);
#pragma unroll
        for (int c2 = 0; c2 < 2; ++c2) { const int ct = 2 * chh + c2;
            const v4i16_t lo = vtr(lds + off_b(16 * ks + 8 * hi + q4, 4 * ct + 2 * blk + (p4 >> 1)) + 8 * (p4 & 1));
            const v4i16_t hh = vtr(lds + off_b(16 * ks + 8 * hi + 4 + q4, 4 * ct + 2 * blk + (p4 >> 1)) + 8 * (p4 & 1));
            const bf16x8 zf = (bf16x8){lo[0], lo[1], lo[2], lo[3], hh[0], hh[1], hh[2], hh[3]};
            acc[c2] = __builtin_amdgcn_mfma_f32_32x32x16_bf16(zf, wf, acc[c2], 0, 0, 0); }
    }
    const float bs = bsp[g * 128 + trow];
    const size_t grow = row0 + trow;
    float ss = 0.f;
#pragma unroll
    for (int c2 = 0; c2 < 2; ++c2)
#pragma unroll
        for (int rg = 0; rg < 4; ++rg) { const int c0 = 32 * (2 * chh + c2) + 8 * rg + 4 * hi;
            const u32x2 uu = *(const u32x2*)(U + grow * AW + g * HD + c0);
            const float o0 = bf2f((unsigned short)(uu.x & 0xffff)) * (acc[c2][4 * rg] + bs), o1 = bf2f((unsigned short)(uu.x >> 16)) * (acc[c2][4 * rg + 1] + bs);
            const float o2 = bf2f((unsigned short)(uu.y & 0xffff)) * (acc[c2][4 * rg + 2] + bs), o3 = bf2f((unsigned short)(uu.y >> 16)) * (acc[c2][4 * rg + 3] + bs);
            ss += (o0 * o0 + o1 * o1) + (o2 * o2 + o3 * o3);
            u32x2 w; w.x = cvtpk(o0, o1); w.y = cvtpk(o2, o3);
            *(u32x2*)(MIX + blk_off(grow, AW + g * HD + c0, DM)) = w; }
    ss += __shfl_xor(ss, 32);
    if (hi == 0) SSG[grow * 16 + g * 2 + chh] = ss;
    LDS_WAIT(); __builtin_amdgcn_s_barrier(); asm volatile("" ::: "memory");
}

constexpr int NPH = 8;
__global__ void __launch_bounds__(512, 2) mk_fwd(Args args) {
    extern __shared__ __attribute__((aligned(16))) unsigned char lds_raw[];
    Frame F;
    F.lds = (LAS unsigned char*)lds_raw;
    F.tid = threadIdx.x; F.lane = F.tid & 63; F.wave = __builtin_amdgcn_readfirstlane(F.tid >> 6);
    F.G = gridDim.x; { const int bx = blockIdx.x; F.vcu = (F.G % 8 == 0) ? (bx % 8) * (F.G / 8) + bx / 8 : bx; }
    unsigned char* ws = args.ws;
    unsigned* ctl = (unsigned*)(ws + WS_CTL);
    for (int u = F.tid; u < (LDS_BYTES - LDSCTL_OFF) / 4; u += 512) ((LAS unsigned*)(F.lds + LDSCTL_OFF))[u] = 0u;
    __syncthreads();
    XcdBarrier bar; bar.bar = ctl + 4096; bar.x = 0; bar.st = nullptr;
    if (MK_N_LAUNCHES == 1) bar = xcd_barrier_post(ctl + 4096, (volatile LAS unsigned*)(F.lds + MISC_OFF) + 8);
    const int lo = args.ph_lo, hi = args.ph_hi;
#ifndef MK_PHASE_MASK
#define MK_PHASE_MASK 255
#endif
#define IN(k) (((MK_PHASE_MASK >> (k)) & 1) && lo <= (k) && (k) < hi)
#ifndef MK_REP_MASK
#define MK_REP_MASK 0
#endif
#define REP(k) for (int rep_ = 0; rep_ < 1 + ((MK_REP_MASK >> (k)) & 1); ++rep_)
#define SEAM(k) do { if (IN(k) && IN((k) + 1)) xcd_barrier(bar); } while (0)

    const float* x = args.in[0]; const float* cnd = args.in[1]; const float* w_ada = args.in[2]; const float* b_ada = args.in[3]; const float* mix_g = args.in[4];
    const float* w_in = args.in[5]; const float* q_g = args.in[6]; const float* k_g = args.in[7]; const float* relb = args.in[8]; const float* gm_g = args.in[9];
    const float* w_sp = args.in[10]; const float* b_sp = args.in[11]; const float* ao_g = args.in[12]; const float* go_g = args.in[13]; const float* w_out = args.in[14];
    const float* ff_g = args.in[15]; const float* w_f1 = args.in[16]; const float* w_f2 = args.in[17];
    float* out = args.out;
    float* MOD = (float*)(ws + WS_MOD); float* SSA = (float*)(ws + WS_SSA); float* SSG = (float*)(ws + WS_SSG);
    bf16_t* WSP = (bf16_t*)(ws + WS_WSP); bf16_t* WIN = (bf16_t*)(ws + WS_WIN); bf16_t* WOUT = (bf16_t*)(ws + WS_WOUT); bf16_t* WF1 = (bf16_t*)(ws + WS_WF1); bf16_t* WF2 = (bf16_t*)(ws + WS_WF2);
    bf16_t* H = (bf16_t*)(ws + WS_H); bf16_t* QB = (bf16_t*)(ws + WS_Q); bf16_t* KB = (bf16_t*)(ws + WS_K); bf16_t* VB = (bf16_t*)(ws + WS_V); bf16_t* UB = (bf16_t*)(ws + WS_U); bf16_t* ZB = (bf16_t*)(ws + WS_ZN);
    bf16_t* MIX = (bf16_t*)(ws + WS_MIX); bf16_t* ACT = (bf16_t*)(ws + WS_ACT);
    const int gw = F.vcu * 8 + F.wave, NGW = F.G * 8;

    if (IN(0)) REP(0) { p0_ada(F, cnd, w_ada, b_ada, MOD); }
    SEAM(0);

    if (IN(1)) REP(1) {
        LAS float* scr = (LAS float*)(F.lds + F.wave * 16384);
        constexpr int I_IN = (DM / 64) * (INW / 32), I_OUT = (DM / 64) * (DM / 32), I_F1 = (DM / 64) * (DFF / 32), I_F2 = (DFF / 64) * (DM / 32), I_SP = 64;
        constexpr int NITEMS = I_IN + I_OUT + I_F1 + I_F2 + I_SP;
        for (int it = gw; it < NITEMS; it += NGW) {
            int r = it;
            if (r < I_IN) { p1_transpose_item(w_in, DM, INW, WIN, scr, r, F.lane, nullptr, nullptr); continue; } r -= I_IN;
            if (r < I_OUT) { p1_transpose_item(w_out, DM, DM, WOUT, scr, r, F.lane, ao_g, go_g); continue; } r -= I_OUT;
            if (r < I_F1) { p1_transpose_item(w_f1, DM, DFF, WF1, scr, r, F.lane, nullptr, nullptr); continue; } r -= I_F1;
            if (r < I_F2) { p1_transpose_item(w_f2, DFF, DM, WF2, scr, r, F.lane, nullptr, nullptr); continue; } r -= I_F2;
#pragma unroll
            for (int i = 0; i < 8; ++i) { const int e = r * 2048 + (i * 64 + F.lane) * 4, t = (e >> 7) & 127, s = e & 127;
                f32x4 v = *(const f32x4*)(w_sp + e); if ((t >> 6) < (s >> 6)) v = (f32x4){0.f, 0.f, 0.f, 0.f};
                u32x2 w; w.x = cvtpk(v[0], v[1]); w.y = cvtpk(v[2], v[3]); *(u32x2*)(WSP + e) = w; }
        }
        for (int m = gw; m < MROWS; m += NGW) { const float* mb = MOD + (size_t)(m >> 11) * NMOD;
            norm_mod_row(x + (size_t)m * DM, mix_g, mb, mb + DM, H, m, F.lane); }
    }
    SEAM(1);

    if (IN(2)) REP(2) {
        pg8::Gemm g{H, WIN, MROWS, INW, DM}; pg8::StaticOrder S; S.init(MROWS, INW, F.G, (int)blockIdx.x);
        pg8::EpiProj E{QB, (size_t)(WS_K - WS_Q) / 2, q_g, k_g, gm_g, (LAS float*)(F.lds + XCH_OFF)};
        pg8::gemm_phase<pg8::EpiProj, pg8::StaticOrder>(F.lds, g, S, E);
    }
    SEAM(2);

    if (IN(3)) REP(3) {
        for (int u = F.vcu; u < NBATCH * NH * 8; u += F.G) { const int g4 = u & 7, h = (u >> 3) & 7, b = u >> 6;
            attn_unit(F, QB, KB, VB, MIX, SSA, relb, b, h, g4); }
        for (int u = F.vcu; u < NBATCH * 16 * 8; u += F.G) { const int g = u & 7, nb = (u >> 3) & 15, b = u >> 7;
            gmlp_unit(F, UB, ZB, WSP, b_sp, MIX, SSG, b, nb, g); }
    }
    SEAM(3);

    if (IN(4)) REP(4) {
        pg8::Gemm g{MIX, WOUT, MROWS, DM, DM}; pg8::StaticOrder S; S.init(MROWS, DM, F.G, (int)blockIdx.x);
        pg8::EpiRes1 E{x, out, MOD, SSA, SSG, (LAS float*)(F.lds + XCH_OFF)};
        { pg8::Unit uu; for (int i = F.tid >> 8; i < 4 && S.next(i, uu); i += 2) E.fill(uu, i, F.tid & 255); }
        __syncthreads();
        pg8::gemm_phase<pg8::EpiRes1, pg8::StaticOrder>(F.lds, g, S, E);
    }
    SEAM(4);

    if (IN(5)) REP(5) {
        for (int m = gw; m < MROWS; m += NGW) { const float* mb = MOD + (size_t)(m >> 11) * NMOD;
            norm_mod_row(out + (size_t)m * DM, ff_g, mb + 3 * DM, mb + 4 * DM, H, m, F.lane); }
    }
    SEAM(5);

    if (IN(6)) REP(6) {
        pg8::Gemm g{H, WF1, MROWS, DFF, DM}; pg8::StaticOrder S; S.init(MROWS, DFF, F.G, (int)blockIdx.x);
        pg8::EpiRelu2 E{ACT, DFF};
        pg8::gemm_phase<pg8::EpiRelu2, pg8::StaticOrder>(F.lds, g, S, E);
    }
    SEAM(6);

    if (IN(7)) {
        pg8::Gemm g{ACT, WF2, MROWS, DM, DFF}; pg8::StaticOrder S; S.init(MROWS, DM, F.G, (int)blockIdx.x);
        pg8::EpiRes2 E{out, MOD};
        pg8::gemm_phase<pg8::EpiRes2, pg8::StaticOrder>(F.lds, g, S, E);
    }
#undef IN
#undef SEAM
}

extern "C" void kernel_launch(void* const* d_in, const int* in_sizes, int n_in, void* d_out, int out_size, void* d_ws, size_t ws_size, hipStream_t stream) {
    static int grid = 0;
    if (grid == 0) {
        if (n_in != 18 || in_sizes[0] != MROWS * DM || out_size != MROWS * DM || ws_size < WS_END) {
            fprintf(stderr, "kernel_launch: unexpected shapes (n_in %d, in0 %d, out %d, ws %zu); nothing launched\n", n_in, n_in > 0 ? in_sizes[0] : -1, out_size, ws_size); grid = -1; return; }
        int dev = 0, cus = 0, per_cu = 0;
        if (hipGetDevice(&dev) != hipSuccess || hipDeviceGetAttribute(&cus, hipDeviceAttributeMultiprocessorCount, dev) != hipSuccess) { fprintf(stderr, "kernel_launch: device query failed\n"); grid = -1; return; }
        if (hipFuncSetAttribute((const void*)mk_fwd, hipFuncAttributeMaxDynamicSharedMemorySize, LDS_BYTES) != hipSuccess) { fprintf(stderr, "kernel_launch: hipFuncSetAttribute failed\n"); grid = -1; return; }
        if (hipOccupancyMaxActiveBlocksPerMultiprocessor(&per_cu, (const void*)mk_fwd, 512, LDS_BYTES) != hipSuccess || per_cu < 1) {
            fprintf(stderr, "kernel_launch: occupancy query reports %d workgroups per CU\n", per_cu); per_cu = 1; }
        (void)hipGetLastError();
        grid = cus;
    }
    if (grid < 0) return;
    (void)hipMemsetAsync((char*)d_ws + WS_CTL, 0, CTL_ZERO_BYTES, stream);
    Args a{};
    for (int i = 0; i < 18; ++i) a.in[i] = (const float*)d_in[i];
    a.out = (float*)d_out; a.ws = (unsigned char*)d_ws;
#ifndef MK_PROG
#define MK_PROG {0, 1, 2, 3, 4, 5, 6, 7}
#endif
    static const int prog[] = MK_PROG; const int nprog = (MK_N_LAUNCHES == 1) ? 1 : (int)(sizeof(prog) / sizeof(prog[0]));
    for (int li = 0; li < nprog; ++li) {
        if (MK_N_LAUNCHES == 1) { a.ph_lo = 0; a.ph_hi = NPH; } else { a.ph_lo = prog[li]; a.ph_hi = prog[li] + 1; }
        a.li = li;
        hipLaunchKernelGGL(mk_fwd, dim3(grid), dim3(512), LDS_BYTES, stream, a);
        const hipError_t le = hipPeekAtLastError();
        if (le != hipSuccess) { fprintf(stderr, "kernel_launch: launch %d failed: %s\n", li, hipGetErrorName(le)); break; }
    }
}
```

```cpp
#include <hip/hip_runtime.h>
#include <cstdio>
#include <cstdint>

#ifndef MK_N_LAUNCHES
#define MK_N_LAUNCHES 1
#endif

#define LAS __attribute__((address_space(3)))
#define GAS __attribute__((address_space(1)))
typedef unsigned short bf16_t;
typedef short bf16x8 __attribute__((ext_vector_type(8)));
typedef short v4i16_t __attribute__((ext_vector_type(4)));
typedef float f32x4 __attribute__((ext_vector_type(4)));
typedef float f32x2 __attribute__((ext_vector_type(2)));
typedef float f32x16 __attribute__((ext_vector_type(16)));
typedef unsigned u32x4 __attribute__((ext_vector_type(4)));
typedef unsigned u32x2 __attribute__((ext_vector_type(2)));
typedef __bf16 bf16x2_t __attribute__((ext_vector_type(2)));

constexpr int DM = 2048, NBATCH = 8, SEQ = 2048, MROWS = NBATCH * SEQ;
constexpr int AW = 1024, NH = 8, HD = 128, INW = 5120, DFF = 8192, NMOD = 6 * DM;
constexpr int CHUNK = 64, LEFT = 8, MAXREL = 128, NREL = 2 * MAXREL + 1;
constexpr float EPS = 1e-6f;
constexpr float LOG2E = 1.4426950408889634f;
constexpr float QSCALE = 0.08838834764831845f * LOG2E;

constexpr size_t MiB = 1u << 20;
constexpr size_t WS_CTL = 0, CTL_ZERO_BYTES = 64 * 1024;
constexpr size_t WS_MOD = 1 * MiB;
constexpr size_t WS_SSA = 2 * MiB;
constexpr size_t WS_SSG = 3 * MiB;
constexpr size_t WS_WSP = 6 * MiB;
constexpr size_t WS_WIN = 8 * MiB, WS_WOUT = 28 * MiB, WS_WF1 = 36 * MiB, WS_WF2 = 68 * MiB;
constexpr size_t WS_H = 100 * MiB;
constexpr size_t WS_Q = 164 * MiB, WS_K = 196 * MiB, WS_V = 228 * MiB, WS_U = 260 * MiB, WS_ZN = 292 * MiB;
constexpr size_t WS_MIX = 324 * MiB;
constexpr size_t WS_ACT = 164 * MiB;
constexpr size_t WS_X1 = 420 * MiB;
constexpr size_t WS_END = 484 * MiB;

constexpr int RING_BYTES = 131072;
constexpr int XCH_OFF = RING_BYTES;
constexpr int LDSCTL_OFF = RING_BYTES + 8192, MISC_OFF = LDSCTL_OFF + 320;
constexpr int LDS_BYTES = 147456;

__device__ __forceinline__ unsigned cvtpk(float lo, float hi) { f32x2 v = {lo, hi}; bf16x2_t b = __builtin_convertvector(v, bf16x2_t); return __builtin_bit_cast(unsigned, b); }
__device__ __forceinline__ float bf2f(unsigned short h) { return __uint_as_float((unsigned)h << 16); }
__device__ __forceinline__ float wave_sum(float v) {
#pragma unroll
    for (int o = 1; o < 64; o <<= 1) v += __shfl_xor(v, o);
    return v;
}
__device__ __forceinline__ f32x2 gelu_pk(f32x2 v) {
    const f32x2 av = __builtin_elementwise_abs(v), d = av * 0.2316418882f + 1.0f;
    f32x2 t; t.x = __builtin_amdgcn_rcpf(d.x); t.y = __builtin_amdgcn_rcpf(d.y);
    f32x2 q = t * 0.5307027145f + (-0.7265760135f); q = q * t + 0.7107068705f; q = q * t + (-0.142248368f); q = q * t + 0.127414796f; q = q * t;
    const f32x2 s = (v * v) * (-0.72134752044f);
    f32x2 e; e.x = __builtin_amdgcn_exp2f(s.x); e.y = __builtin_amdgcn_exp2f(s.y);
    const f32x2 m = v * (q * e), r = v - m;
    f32x2 o; o.x = v.x < 0.f ? m.x : r.x; o.y = v.y < 0.f ? m.y : r.y; return o;
}
__device__ __forceinline__ f32x4 gelu4(f32x4 v) { const f32x2 a = gelu_pk((f32x2){v[0], v[1]}), b = gelu_pk((f32x2){v[2], v[3]}); return (f32x4){a.x, a.y, b.x, b.y}; }

__host__ __device__ __forceinline__ size_t blk_off(size_t row, int k, int K) { return (row >> 8) * ((size_t)256 * K) + (size_t)(k >> 6) * 16384 + (row & 255) * 64 + (k & 63); }

namespace pg8 {
constexpr int BM = 256, BK = 64, HALF = 128, HTB = HALF * BK * 2, STAGE_BYTES = 8 * HTB, NXCD = 8;
__host__ __device__ __forceinline__ int lds_byte(int r, int c) { const int st = (r >> 4) * 2 + (c >> 5), rr = r & 15, cc = c & 31, ob = rr * 64 + cc * 2; return st * 1024 + (ob ^ (((ob >> 9) & 1) << 5)); }
__host__ __device__ __forceinline__ void stage_rc(int b, int& R, int& C) { const int st = b / 1024, sb = b % 1024, swz = sb ^ (((sb >> 9) & 1) << 5); R = (st >> 1) * 16 + swz / 64; C = (st & 1) * 32 + (swz % 64) / 2; }
__host__ __device__ __forceinline__ int perm32(int rho) { const int n = rho >> 4, i = rho & 15; return 8 * (i >> 2) + 4 * n + (i & 3); }

struct Unit { int pm, pn; };
struct Gemm { const bf16_t* A; const bf16_t* Bt; int M, N, K; };

struct StaticOrder {
    int nM, nN, nwg, G, c, WGM;
    __device__ void init(int M, int N, int G_, int c_, int wgm) { nM = M / BM; nN = N / BM; nwg = nM * nN; G = G_; c = c_; WGM = wgm; }
    __device__ bool next(int i, Unit& u) const {
        const long L = (long)i * G + c; if (L >= nwg) return false;
        int wgid = (int)L; { const int q = nwg / NXCD, r = nwg % NXCD, xcd = wgid % NXCD, off = wgid / NXCD; wgid = (xcd < r ? xcd * (q + 1) : r * (q + 1) + (xcd - r) * q) + off; }
        const int nig = WGM * nN, gid = wgid / nig, fm = gid * WGM, gsz = (nM - fm) < WGM ? (nM - fm) : WGM;
        u.pm = fm + ((wgid % nig) % gsz); u.pn = (wgid % nig) / gsz; return true;
    }
};

#define PG8_BARRIER() do { asm volatile("s_waitcnt lgkmcnt(0)" ::: "memory"); __builtin_amdgcn_s_barrier(); asm volatile("" ::: "memory"); } while (0)

struct EpiProj {
    static constexpr bool PERM = true, HOOKS = false; static constexpr int MIDT = 0;
    bf16_t* base;
    size_t tstride;
    const float *qg, *kg, *zg;
    LAS float* xch;
    __device__ __forceinline__ void begin(const Unit&, int, int) const {}
    __device__ __forceinline__ void mid(f32x4 (&)[2][2][4][2], int, int, int) const {}
    __device__ __forceinline__ void operator()(f32x4 (&acc)[2][2][4][2], const Unit& u, int ui, int wr, int wc, int fr, int fq) const {
        const int type = u.pn >> 2, colt = (u.pn & 3) * 256;
        bf16_t* O = base + (size_t)type * tstride;
        const int row0 = u.pm * BM + wr * 64 + fr, col0 = colt + wc * 32 + 8 * fq;
        if (type >= 3) {
#pragma unroll
            for (int ai = 0; ai < 2; ++ai)
#pragma unroll
                for (int bj = 0; bj < 2; ++bj)
#pragma unroll
                    for (int m = 0; m < 4; ++m)
#pragma unroll
                        for (int n = 0; n < 2; ++n) acc[ai][bj][m][n] = gelu4(acc[ai][bj][m][n]);
        }
        if (type == 0 || type == 1 || type == 4) {
#pragma unroll
            for (int ai = 0; ai < 2; ++ai)
#pragma unroll
                for (int m = 0; m < 4; ++m)
#pragma unroll
                    for (int bj = 0; bj < 2; ++bj) {
                        const f32x4 a = acc[ai][bj][m][0], b = acc[ai][bj][m][1];
                        float s = (a[0] * a[0] + a[1] * a[1]) + (a[2] * a[2] + a[3] * a[3]) + (b[0] * b[0] + b[1] * b[1]) + (b[2] * b[2] + b[3] * b[3]);
                        s += __shfl_xor(s, 16); s += __shfl_xor(s, 32);
                        if (fq == 0) xch[((ai * HALF + wr * 64 + m * 16 + fr) * 2 + bj) * 4 + wc] = s;
                    }
            PG8_BARRIER();
            const float* gp = type == 0 ? qg : (type == 1 ? kg : zg + (u.pn & 3) * 256);
            const float sc = type == 0 ? QSCALE : 1.0f;
            f32x4 gv[2][2];
#pragma unroll
            for (int bj = 0; bj < 2; ++bj)
#pragma unroll
                for (int n = 0; n < 2; ++n) gv[bj][n] = *(const f32x4*)(gp + (type == 4 ? bj * 128 : 0) + wc * 32 + 8 * fq + 4 * n) * sc;
#pragma unroll
            for (int ai = 0; ai < 2; ++ai)
#pragma unroll
                for (int m = 0; m < 4; ++m)
#pragma unroll
                    for (int bj = 0; bj < 2; ++bj) {
                        const f32x4 p = *(const LAS f32x4*)(xch + ((ai * HALF + wr * 64 + m * 16 + fr) * 2 + bj) * 4);
                        const float rinv = 1.0f / sqrtf(((p[0] + p[1]) + (p[2] + p[3])) * (1.0f / 128.0f) + EPS);
                        acc[ai][bj][m][0] = acc[ai][bj][m][0] * rinv * gv[bj][0]; acc[ai][bj][m][1] = acc[ai][bj][m][1] * rinv * gv[bj][1];
                    }
        }
#pragma unroll
        for (int ai = 0; ai < 2; ++ai)
#pragma unroll
            for (int m = 0; m < 4; ++m) { bf16_t* rowp = O + (size_t)(row0 + ai * HALF + m * 16) * AW + col0;
#pragma unroll
                for (int bj = 0; bj < 2; ++bj) { const f32x4 v0 = acc[ai][bj][m][0], v1 = acc[ai][bj][m][1];
                    u32x4 w; w.x = cvtpk(v0[0], v0[1]); w.y = cvtpk(v0[2], v0[3]); w.z = cvtpk(v1[0], v1[1]); w.w = cvtpk(v1[2], v1[3]);
                    *(u32x4*)(rowp + bj * HALF) = w; } }
    }
};

struct EpiRes1 {
    static constexpr bool PERM = true, HOOKS = true; static constexpr int MIDT = 16;
    const float* x; bf16_t* x1; const float* mod;
    const float *ssa, *ssg;
    LAS float* rt;
    __device__ __forceinline__ void begin(const Unit&, int, int) const {}
    __device__ __forceinline__ void fill(const Unit& u, int ui, int row) const {
        const size_t gr = (size_t)u.pm * BM + row;
        const f32x4 a0 = *(const f32x4*)(ssa + gr * 8), a1 = *(const f32x4*)(ssa + gr * 8 + 4);
        const float sa = ((a0[0] + a0[1]) + (a0[2] + a0[3])) + ((a1[0] + a1[1]) + (a1[2] + a1[3]));
        const f32x4 a = *(const f32x4*)(ssg + gr * 16), b = *(const f32x4*)(ssg + gr * 16 + 4), c = *(const f32x4*)(ssg + gr * 16 + 8), d = *(const f32x4*)(ssg + gr * 16 + 12);
        const float sg = (((a[0] + a[1]) + (a[2] + a[3])) + ((b[0] + b[1]) + (b[2] + b[3]))) + (((c[0] + c[1]) + (c[2] + c[3])) + ((d[0] + d[1]) + (d[2] + d[3])));
        const float ra = 1.0f / sqrtf(sa * (1.0f / 1024.0f) + EPS), rg = 1.0f / sqrtf(sg * (1.0f / 1024.0f) + EPS);
        *(LAS f32x2*)(rt + ((ui & 3) * 256 + row) * 2) = (f32x2){ra / rg, rg};
    }
    __device__ __forceinline__ void mid(f32x4 (&acc)[2][2][4][2], int ui, int wr, int fr) const {
#pragma unroll
        for (int ai = 0; ai < 2; ++ai)
#pragma unroll
            for (int m = 0; m < 4; ++m) { const float f = rt[((ui & 3) * 256 + ai * HALF + wr * 64 + m * 16 + fr) * 2];
#pragma unroll
                for (int bj = 0; bj < 2; ++bj)
#pragma unroll
                    for (int n = 0; n < 2; ++n) acc[ai][bj][m][n] = acc[ai][bj][m][n] * f; }
    }
    __device__ __forceinline__ void operator()(f32x4 (&acc)[2][2][4][2], const Unit& u, int ui, int wr, int wc, int fr, int fq) const {
        const int row0 = u.pm * BM + wr * 64 + fr, col0 = u.pn * BM + wc * 32 + 8 * fq;
        const float* gp = mod + (size_t)(u.pm >> 3) * NMOD + 2 * DM + col0;
        f32x4 gv[2][2];
#pragma unroll
        for (int bj = 0; bj < 2; ++bj)
#pragma unroll
            for (int n = 0; n < 2; ++n) gv[bj][n] = *(const f32x4*)(gp + bj * HALF + n * 4);
#pragma unroll
        for (int ai = 0; ai < 2; ++ai)
#pragma unroll
            for (int m = 0; m < 4; ++m) { const size_t off = (size_t)(row0 + ai * HALF + m * 16) * DM + col0;
                const float rg = rt[((ui & 3) * 256 + ai * HALF + wr * 64 + m * 16 + fr) * 2 + 1];
#pragma unroll
                for (int bj = 0; bj < 2; ++bj) {
                    const f32x4 x0 = *(const f32x4*)(x + off + bj * HALF), xb = *(const f32x4*)(x + off + bj * HALF + 4);
                    const f32x4 v0 = x0 + gv[bj][0] * (acc[ai][bj][m][0] * rg), v1 = xb + gv[bj][1] * (acc[ai][bj][m][1] * rg);
                    u32x4 w; w.x = cvtpk(v0[0], v0[1]); w.y = cvtpk(v0[2], v0[3]); w.z = cvtpk(v1[0], v1[1]); w.w = cvtpk(v1[2], v1[3]);
                    *(u32x4*)(x1 + off + bj * HALF) = w; } }
    }
};

struct EpiRelu2 {
    static constexpr bool PERM = true, HOOKS = false; static constexpr int MIDT = 0;
    bf16_t* O; int ldc;
    __device__ __forceinline__ void begin(const Unit&, int, int) const {}
    __device__ __forceinline__ void mid(f32x4 (&)[2][2][4][2], int, int, int) const {}
    __device__ __forceinline__ void operator()(f32x4 (&acc)[2][2][4][2], const Unit& u, int ui, int wr, int wc, int fr, int fq) const {
        const int row0 = u.pm * BM + wr * 64 + fr, col0 = u.pn * BM + wc * 32 + 8 * fq;
#pragma unroll
        for (int ai = 0; ai < 2; ++ai)
#pragma unroll
            for (int m = 0; m < 4; ++m) { bf16_t* rowp = O + blk_off((size_t)(row0 + ai * HALF + m * 16), col0, ldc);
#pragma unroll
                for (int bj = 0; bj < 2; ++bj) { f32x4 v0 = acc[ai][bj][m][0], v1 = acc[ai][bj][m][1];
                    v0 = __builtin_elementwise_max(v0, (f32x4){0.f, 0.f, 0.f, 0.f}); v1 = __builtin_elementwise_max(v1, (f32x4){0.f, 0.f, 0.f, 0.f}); v0 = v0 * v0; v1 = v1 * v1;
                    u32x4 w; w.x = cvtpk(v0[0], v0[1]); w.y = cvtpk(v0[2], v0[3]); w.z = cvtpk(v1[0], v1[1]); w.w = cvtpk(v1[2], v1[3]);
                    *(u32x4*)(rowp + bj * 2 * 16384) = w; } }
    }
};

struct EpiRes2 {
    static constexpr bool PERM = false, HOOKS = false; static constexpr int MIDT = 0;
    const bf16_t* x1; float* out; const float* mod;
    __device__ __forceinline__ void begin(const Unit&, int, int) const {}
    __device__ __forceinline__ void mid(f32x4 (&)[2][2][4][2], int, int, int) const {}
    __device__ __forceinline__ void operator()(f32x4 (&acc)[2][2][4][2], const Unit& u, int ui, int wr, int wc, int fr, int fq) const {
        const int row0 = u.pm * BM + wr * 64 + fr, col0 = u.pn * BM + wc * 32 + 4 * fq;
        const float* gp = mod + (size_t)(u.pm >> 3) * NMOD + 5 * DM + col0;
        f32x4 gv[2][2];
#pragma unroll
        for (int bj = 0; bj < 2; ++bj)
#pragma unroll
            for (int n = 0; n < 2; ++n) gv[bj][n] = *(const f32x4*)(gp + bj * HALF + n * 16);
#pragma unroll
        for (int ai = 0; ai < 2; ++ai)
#pragma unroll
            for (int m = 0; m < 4; ++m) { const size_t off = (size_t)(row0 + ai * HALF + m * 16) * DM + col0;
#pragma unroll
                for (int bj = 0; bj < 2; ++bj)
#pragma unroll
                    for (int n = 0; n < 2; ++n) { const u32x2 xr = *(const u32x2*)(x1 + off + bj * HALF + n * 16);
                        const f32x4 xv = (f32x4){__uint_as_float(xr.x << 16), __uint_as_float(xr.x & 0xffff0000u), __uint_as_float(xr.y << 16), __uint_as_float(xr.y & 0xffff0000u)};
                        *(f32x4*)(out + off + bj * HALF + n * 16) = xv + gv[bj][n] * acc[ai][bj][m][n]; } }
    }
};

template <class Epi, class Sched>
__device__ __forceinline__ void gemm_phase(LAS unsigned char* lds, const Gemm g, const Sched& S, const Epi& E) {
    const int tid = threadIdx.x, wid = __builtin_amdgcn_readfirstlane(tid >> 6), lane = tid & 63, wr = wid >> 2, wc = wid & 3, fr = lane & 15, fq = lane >> 4;
    const int K = g.K, nt = K / BK;
    unsigned voffA[2], voffB[2];
#pragma unroll
    for (int i = 0; i < 2; ++i) { int R, C; stage_rc(tid * 16 + i * 8192, R, C); const int Rb = Epi::PERM ? ((R & ~31) + perm32(R & 31)) : R;
        voffA[i] = (unsigned)(R * 64 + C) * 2u; voffB[i] = (unsigned)(Rb * 64 + C) * 2u; }
    const size_t kstep = (size_t)(256 * BK * 2);
    const size_t hstep = (size_t)HALF * BK * 2;
    const size_t tstep = (size_t)256 * K * 2;
    const unsigned ldsw = (unsigned)wid * 1024u;
    const int aoff = lds_byte(wr * 64 + fr, fq * 8), boff = lds_byte(wc * 32 + fr, fq * 8);
#define PG8_SA(b, h) (((b) * 2 + (h)) * HTB)
#define PG8_SB(b, h) ((4 + (b) * 2 + (h)) * HTB)
#define PG8_STAGE(bufoff, gbase, voff) do { _Pragma("unroll") for (int _i = 0; _i < 2; ++_i) \
        __builtin_amdgcn_global_load_lds((const unsigned*)((const char*)(gbase) + (voff)[_i]), (LAS unsigned*)(lds + (bufoff) + ldsw + _i * 8192), 16, 0, 0); } while (0)
#define PG8_LDA(dst, b, h) do { _Pragma("unroll") for (int m = 0; m < 4; ++m) _Pragma("unroll") for (int k = 0; k < 2; ++k) dst[m][k] = *(const LAS bf16x8*)(lds + PG8_SA(b, h) + aoff + m * 2048 + k * 1024); } while (0)
#define PG8_LDB(dst, b, h) do { _Pragma("unroll") for (int n = 0; n < 2; ++n) _Pragma("unroll") for (int k = 0; k < 2; ++k) dst[n][k] = *(const LAS bf16x8*)(lds + PG8_SB(b, h) + boff + n * 2048 + k * 1024); } while (0)
#define PG8_MMA(ai, bj, At, Bt) do { __builtin_amdgcn_s_setprio(1); _Pragma("unroll") for (int m = 0; m < 4; ++m) _Pragma("unroll") for (int n = 0; n < 2; ++n) _Pragma("unroll") for (int k = 0; k < 2; ++k) \
        acc[ai][bj][m][n] = __builtin_amdgcn_mfma_f32_16x16x32_bf16(Bt[n][k], At[m][k], acc[ai][bj][m][n], 0, 0, 0); __builtin_amdgcn_s_setprio(0); } while (0)
#define PG8_WAIT_V(n) asm volatile("s_waitcnt vmcnt(" #n ")" ::: "memory")
#define PG8_WAIT_L(n) asm volatile("s_waitcnt lgkmcnt(" #n ")" ::: "memory")
#define PG8_BAR __builtin_amdgcn_s_barrier()
#define PG8_SCHED __builtin_amdgcn_sched_barrier(0)
    Unit cur, nxt; int ui = 0;
    if (!S.next(0, cur)) return;
    f32x4 acc[2][2][4][2];
#pragma unroll
    for (int a = 0; a < 2; ++a)
#pragma unroll
        for (int b = 0; b < 2; ++b)
#pragma unroll
            for (int m = 0; m < 4; ++m)
#pragma unroll
                for (int n = 0; n < 2; ++n) acc[a][b][m][n] = (f32x4){0.f, 0.f, 0.f, 0.f};
    bf16x8 At[4][2], B0[2][2], B1[2][2];
    const char* cA = (const char*)g.A + (size_t)cur.pm * tstep; const char* cB = (const char*)g.Bt + (size_t)cur.pn * tstep;
    PG8_STAGE(PG8_SB(0, 0), cB, voffB); PG8_STAGE(PG8_SB(0, 1), cB + hstep, voffB); PG8_STAGE(PG8_SA(0, 0), cA, voffA); PG8_STAGE(PG8_SA(0, 1), cA + hstep, voffA);
    if (wr == 1) PG8_BAR;
    PG8_WAIT_V(2); PG8_BAR;
    PG8_STAGE(PG8_SB(1, 0), cB + kstep, voffB); PG8_STAGE(PG8_SA(1, 0), cA + kstep, voffA); PG8_STAGE(PG8_SB(1, 1), cB + hstep + kstep, voffB);
    PG8_WAIT_V(6); PG8_BAR;
    for (;;) {
        const bool has_next = S.next(ui + 1, nxt);
        const char* nA = has_next ? (const char*)g.A + (size_t)nxt.pm * tstep : cA; const char* nB = has_next ? (const char*)g.Bt + (size_t)nxt.pn * tstep : cB;
        for (int t = 0; t < nt; t += 2) {
            const bool last = (t == nt - 2);
            const char* a1 = cA + (size_t)(t + 1) * kstep;
            const char* a2 = last ? nA : cA + (size_t)(t + 2) * kstep; const char* b2 = last ? nB : cB + (size_t)(t + 2) * kstep;
            const char* a3 = a2 + kstep; const char* b3 = b2 + kstep;
            if constexpr (Epi::HOOKS) { if (t == Epi::MIDT) E.mid(acc, ui, wr, fr); }
            PG8_LDB(B0, 0, 0); PG8_LDB(B1, 0, 1); PG8_SCHED; PG8_LDA(At, 0, 0); PG8_STAGE(PG8_SA(1, 1), a1 + hstep, voffA);
            PG8_WAIT_V(8); PG8_WAIT_L(0); PG8_BAR; PG8_MMA(0, 0, At, B0); PG8_MMA(0, 1, At, B1); PG8_BAR; PG8_SCHED;
            PG8_LDA(At, 0, 1); PG8_STAGE(PG8_SB(0, 0), b2, voffB); PG8_STAGE(PG8_SB(0, 1), b2 + hstep, voffB); PG8_STAGE(PG8_SA(0, 0), a2, voffA);
            PG8_WAIT_V(8); PG8_WAIT_L(0); PG8_BAR; PG8_MMA(1, 0, At, B0); PG8_MMA(1, 1, At, B1); PG8_BAR; PG8_SCHED;
            PG8_LDB(B0, 1, 0); PG8_LDB(B1, 1, 1); PG8_SCHED; PG8_LDA(At, 1, 0); PG8_STAGE(PG8_SA(0, 1), a2 + hstep, voffA);
            PG8_WAIT_V(8); PG8_WAIT_L(0); PG8_BAR; PG8_MMA(0, 0, At, B0); PG8_MMA(0, 1, At, B1); PG8_BAR; PG8_SCHED;
            PG8_LDA(At, 1, 1); PG8_STAGE(PG8_SB(1, 0), b3, voffB); PG8_STAGE(PG8_SB(1, 1), b3 + hstep, voffB); PG8_STAGE(PG8_SA(1, 0), a3, voffA);
            PG8_WAIT_V(8); PG8_WAIT_L(0); PG8_BAR; PG8_MMA(1, 0, At, B0); PG8_MMA(1, 1, At, B1); PG8_BAR; PG8_SCHED;
        }
        if (wr == 0) PG8_BAR;
        E(acc, cur, ui, wr, wc, fr, fq);
        if (!has_next) break;
#pragma unroll
        for (int a = 0; a < 2; ++a)
#pragma unroll
            for (int b = 0; b < 2; ++b)
#pragma unroll
                for (int m = 0; m < 4; ++m)
#pragma unroll
                    for (int n = 0; n < 2; ++n) acc[a][b][m][n] = (f32x4){0.f, 0.f, 0.f, 0.f};
        cur = nxt; cA = nA; cB = nB; ++ui;
        if (wr == 1) PG8_BAR;
    }
    PG8_WAIT_V(0);
    PG8_BAR;
#undef PG8_SA
#undef PG8_SB
#undef PG8_STAGE
#undef PG8_LDA
#undef PG8_LDB
#undef PG8_MMA
#undef PG8_WAIT_V
#undef PG8_WAIT_L
#undef PG8_BAR
#undef PG8_SCHED
}
}

typedef GAS unsigned gu32;
#define RLX_AGENT __ATOMIC_RELAXED, __HIP_MEMORY_SCOPE_AGENT
#define XB_TMO      128
#define XB_XCNT(j)  (256  + 64 * (j))
#define XB_XSUB(j)  (1280 + 64 * (j))
#define XB_XGEN(j)  (2304 + 64 * (j))
#define XB_TOP      3328
#define XB_TOPGEN   3392
#define XCD_BAR_WORDS 3456
#define XB_SPIN_CAP (1u << 20)
__device__ __forceinline__ unsigned xb_ld(unsigned* p)              { return __hip_atomic_load(p, __ATOMIC_RELAXED, __HIP_MEMORY_SCOPE_AGENT); }
__device__ __forceinline__ unsigned xb_add(unsigned* p, unsigned v) { return __hip_atomic_fetch_add(p, v, __ATOMIC_RELAXED, __HIP_MEMORY_SCOPE_AGENT); }
__device__ __forceinline__ unsigned xb_xcc_id() { return (unsigned)__builtin_amdgcn_s_getreg((3 << 11) | 20) & 0xFu; }
#define XB_SPIN(cond, bar) do { unsigned _sp = 0; while (cond) { __builtin_amdgcn_s_sleep(1); \
    if ((++_sp & 255u) == 0u) { if (xb_ld(&(bar)[XB_TMO])) break; if (_sp > XB_SPIN_CAP) { atomicAdd(&(bar)[XB_TMO], 1u); break; } } } } while (0)
struct XcdBarrier { unsigned* bar; unsigned x; volatile LAS unsigned* st; };
__device__ __forceinline__ XcdBarrier xcd_barrier_post(unsigned* bar, volatile LAS unsigned* st) {
    XcdBarrier b; b.bar = bar; b.x = xb_xcc_id(); b.st = st;
    if (threadIdx.x == 0) (void)xb_add(&bar[XB_XCNT(b.x)], 1u);
    return b;
}
__device__ __forceinline__ void xcd_barrier_complete(unsigned* bar, unsigned x, unsigned& nloc, unsigned& nx) {
    const unsigned G = gridDim.x * gridDim.y * gridDim.z;
    unsigned sum, cnt, mine, sp = 0u;
    for (;;) {
        sum = 0u; cnt = 0u; mine = 0u;
#pragma unroll
        for (unsigned j = 0; j < 16; ++j) { const unsigned c = xb_ld(&bar[XB_XCNT(j)]); sum += c; cnt += (c > 0u) ? 1u : 0u; mine = (j == x) ? c : mine; }
        if (sum == G) break;
        __builtin_amdgcn_s_sleep(1);
        if ((++sp & 255u) == 0u) { if (xb_ld(&bar[XB_TMO])) break; if (sp > XB_SPIN_CAP) { atomicAdd(&bar[XB_TMO], 1u); break; } }
    }
    nloc = mine > 0u ? mine : 1u; nx = cnt > 0u ? cnt : 1u;
}
__device__ __forceinline__ void xcd_barrier(const XcdBarrier& b) {
    asm volatile("s_waitcnt vmcnt(0)" ::: "memory");
    __syncthreads();
    if (threadIdx.x == 0) {
        unsigned* bar = b.bar;
        __builtin_amdgcn_s_waitcnt(0);
        unsigned nloc = b.st[0], nx = b.st[1];
        if (nloc == 0u) { xcd_barrier_complete(bar, b.x, nloc, nx); b.st[0] = nloc; b.st[1] = nx; }
        const unsigned old = xb_add(&bar[XB_XSUB(b.x)], 1u);
        const unsigned gen = old / nloc;
        if (old + 1u == (gen + 1u) * nloc) {
            __builtin_amdgcn_fence(__ATOMIC_RELEASE, "agent");
            asm volatile("s_waitcnt vmcnt(0)" ::: "memory");
            const unsigned og = xb_add(&bar[XB_TOP], 1u);
            const unsigned tg = og / nx;
            if (og + 1u == (tg + 1u) * nx) xb_add(&bar[XB_TOPGEN], 1u);
            else XB_SPIN(xb_ld(&bar[XB_TOPGEN]) == tg, bar);
            __builtin_amdgcn_fence(__ATOMIC_ACQUIRE, "agent");
            xb_add(&bar[XB_XGEN(b.x)], 1u);
            asm volatile("s_waitcnt vmcnt(0)" ::: "memory");
        } else {
            XB_SPIN(xb_ld(&bar[XB_XGEN(b.x)]) == gen, bar);
            __builtin_amdgcn_fence(__ATOMIC_ACQUIRE, "agent");
            asm volatile("s_waitcnt vmcnt(0)" ::: "memory");
        }
    }
    __syncthreads();
}

struct Args { const float* in[18]; float* out; unsigned char* ws; int ph_lo, ph_hi, li, pad; };
struct Frame {
    LAS unsigned char* lds;
    int tid, lane, wave, vcu, G;
};
#define LDS_WAIT() asm volatile("s_waitcnt lgkmcnt(0)" ::: "memory")

__device__ __forceinline__ void p0_ada(const Frame& F, const float* c, const float* w_ada, const float* b_ada, float* mod) {
    LAS float* sc = (LAS float*)F.lds;
    LAS float* part = (LAS float*)(F.lds + 65536);
    for (int i = F.tid; i < NBATCH * DM; i += 512) { const int b = i >> 11, k = i & 2047; const float v = c[i]; sc[k * 8 + b] = v / (1.0f + __expf(-v)); }
    __syncthreads();
    const int kk = F.lane / 12, c4 = F.lane % 12;
    for (int item = blockIdx.x; item < 256; item += F.G) {
        const int n0 = 48 * item, kb = 256 * F.wave;
        f32x4 acc[8];
#pragma unroll
        for (int b = 0; b < 8; ++b) acc[b] = (f32x4){0.f, 0.f, 0.f, 0.f};
        if (F.lane < 60) {
            const float* wp = w_ada + (size_t)(kb + kk) * NMOD + n0 + 4 * c4;
#pragma unroll 3
            for (int i = 0; i < 51; ++i) {
                const int k = kb + kk + 5 * i;
                const f32x4 w = *(const f32x4*)(wp + (size_t)(5 * i) * NMOD);
                const f32x4 s0 = *(const LAS f32x4*)(sc + k * 8), s1 = *(const LAS f32x4*)(sc + k * 8 + 4);
                acc[0] += w * s0[0]; acc[1] += w * s0[1]; acc[2] += w * s0[2]; acc[3] += w * s0[3];
                acc[4] += w * s1[0]; acc[5] += w * s1[1]; acc[6] += w * s1[2]; acc[7] += w * s1[3];
            }
            if (kk == 0) {
                const int k = kb + 255;
                const f32x4 w = *(const f32x4*)(w_ada + (size_t)k * NMOD + n0 + 4 * c4);
                const f32x4 s0 = *(const LAS f32x4*)(sc + k * 8), s1 = *(const LAS f32x4*)(sc + k * 8 + 4);
                acc[0] += w * s0[0]; acc[1] += w * s0[1]; acc[2] += w * s0[2]; acc[3] += w * s0[3];
                acc[4] += w * s1[0]; acc[5] += w * s1[1]; acc[6] += w * s1[2]; acc[7] += w * s1[3];
            }
#pragma unroll
            for (int b = 0; b < 8; ++b) *(LAS f32x4*)(part + (F.wave * 5 + kk) * 384 + b * 48 + 4 * c4) = acc[b];
        }
        __syncthreads();
        if (F.tid < 384) { float s = 0.f;
#pragma unroll 8
            for (int j = 0; j < 40; ++j) s += part[j * 384 + F.tid];
            const int b = F.tid / 48, n = F.tid % 48; mod[(size_t)b * NMOD + n0 + n] = s + b_ada[n0 + n]; }
        __syncthreads();
    }
}

__device__ __forceinline__ void p1_transpose_item(const float* W, int K, int N, bf16_t* WT, LAS float* scr, int item, int lane, const float* ks0, const float* ks1) {
    const int nblk = N / 32, kb = item / nblk, nb = item % nblk, k0 = 64 * kb, n0 = 32 * nb;
#pragma unroll 8
    for (int i = 0; i < 32; ++i) { const int kk = 2 * i + (lane >> 5); float v = W[(size_t)(k0 + kk) * N + n0 + (lane & 31)];
        if (ks0) { const int k = k0 + kk; v *= (k < 1024 ? ks0[k] : ks1[k - 1024]); }
        scr[kk * 33 + (lane & 31)] = v; }
    LDS_WAIT(); asm volatile("" ::: "memory");
    const int c = lane & 7;
#pragma unroll
    for (int j = 0; j < 4; ++j) { const int n = (lane >> 3) + 8 * j; const LAS float* s = scr + (8 * c) * 33 + n;
        u32x4 o; o.x = cvtpk(s[0 * 33], s[1 * 33]); o.y = cvtpk(s[2 * 33], s[3 * 33]); o.z = cvtpk(s[4 * 33], s[5 * 33]); o.w = cvtpk(s[6 * 33], s[7 * 33]);
        *(u32x4*)(WT + blk_off((size_t)(n0 + n), k0 + 8 * c, K)) = o; }
    LDS_WAIT(); asm volatile("" ::: "memory");
}
__device__ __forceinline__ void norm_mod_row(const float* xrow, const float* g, const float* shift, const float* scale, bf16_t* Hb, int m, int lane) {
    const f32x4* xr = (const f32x4*)xrow + lane;
    f32x4 v[8]; float s = 0.f;
#pragma unroll
    for (int j = 0; j < 8; ++j) { v[j] = xr[64 * j]; s += (v[j][0] * v[j][0] + v[j][1] * v[j][1]) + (v[j][2] * v[j][2] + v[j][3] * v[j][3]); }
    const float rinv = 1.0f / sqrtf(wave_sum(s) * (1.0f / DM) + EPS);
    bf16_t* ob = Hb + blk_off((size_t)m, 4 * lane, DM);
#pragma unroll
    for (int j = 0; j < 8; ++j) { const f32x4 gg = ((const f32x4*)g)[lane + 64 * j], sc = ((const f32x4*)scale)[lane + 64 * j], sh = ((const f32x4*)shift)[lane + 64 * j];
        const f32x4 o = (v[j] * rinv) * gg * (sc + 1.0f) + sh; u32x2 w; w.x = cvtpk(o[0], o[1]); w.y = cvtpk(o[2], o[3]); *(u32x2*)(ob + (size_t)j * 4 * 16384) = w; }
}
__device__ __forceinline__ void norm_mod_row_bf(const bf16_t* xrow, const float* g, const float* shift, const float* scale, bf16_t* Hb, int m, int lane) {
    const u32x4* xr = (const u32x4*)xrow + lane;
    f32x4 v[4][2]; float s = 0.f;
#pragma unroll
    for (int j = 0; j < 4; ++j) { const u32x4 r = xr[64 * j];
        v[j][0] = (f32x4){__uint_as_float(r.x << 16), __uint_as_float(r.x & 0xffff0000u), __uint_as_float(r.y << 16), __uint_as_float(r.y & 0xffff0000u)};
        v[j][1] = (f32x4){__uint_as_float(r.z << 16), __uint_as_float(r.z & 0xffff0000u), __uint_as_float(r.w << 16), __uint_as_float(r.w & 0xffff0000u)};
#pragma unroll
        for (int e = 0; e < 2; ++e) s += (v[j][e][0] * v[j][e][0] + v[j][e][1] * v[j][e][1]) + (v[j][e][2] * v[j][e][2] + v[j][e][3] * v[j][e][3]); }
    const float rinv = 1.0f / sqrtf(wave_sum(s) * (1.0f / DM) + EPS);
    bf16_t* ob = Hb + blk_off((size_t)m, 8 * lane, DM);
#pragma unroll
    for (int j = 0; j < 4; ++j) { u32x4 w;
#pragma unroll
        for (int e = 0; e < 2; ++e) { const int ci = 2 * lane + 128 * j + e;
            const f32x4 gg = ((const f32x4*)g)[ci], sc = ((const f32x4*)scale)[ci], sh = ((const f32x4*)shift)[ci];
            const f32x4 o = (v[j][e] * rinv) * gg * (sc + 1.0f) + sh; if (e == 0) { w.x = cvtpk(o[0], o[1]); w.y = cvtpk(o[2], o[3]); } else { w.z = cvtpk(o[0], o[1]); w.w = cvtpk(o[2], o[3]); } }
        *(u32x4*)(ob + (size_t)j * 8 * 16384) = w; }
}

__device__ __forceinline__ unsigned off_b(unsigned row, unsigned ch) { return 256u * row + 16u * (ch ^ (((row & 3) << 2) | ((row >> 2) & 3))); }
__device__ __forceinline__ v4i16_t vtr(LAS unsigned char* p) { return __builtin_amdgcn_ds_read_tr16_b64_v4i16((LAS v4i16_t*)p); }
__device__ __forceinline__ int crow(int r, int hi) { return (r & 3) + 8 * (r >> 2) + 4 * hi; }

constexpr int AT_BT = 0;
constexpr int AT_K = 2048, AT_V = AT_K + 2 * 16384;
constexpr float ATT_THR = 6.0f;

__device__ __forceinline__ void attn_unit(const Frame& F, const bf16_t* Q, const bf16_t* Kg, const bf16_t* Vg, bf16_t* MIX, float* SSA, const float* relb, int b, int h, int g4) {
    LAS unsigned char* lds = F.lds;
    const int tid = F.tid, lane = F.lane, wid = F.wave, r32 = lane & 31, hi = lane >> 5;
    LAS float* bt = (LAS float*)(lds + AT_BT);
    if (tid < NREL) bt[tid] = relb[h * NREL + tid] * LOG2E;
    const int c = 4 * g4 + (wid >> 1);
    const size_t qrow = (size_t)b * SEQ + 64 * c + 32 * (wid & 1) + r32;
    bf16x8 qf[8];
#pragma unroll
    for (int ks = 0; ks < 8; ++ks) qf[ks] = *(const bf16x8*)(Q + qrow * AW + h * HD + 16 * ks + 8 * hi);
    const int kc_lo = (4 * g4 - LEFT) > 0 ? (4 * g4 - LEFT) : 0, kc_hi = 4 * g4 + 3, nsteps = kc_hi - kc_lo + 1;
    const int srow = tid >> 4, sch = tid & 15;
    const bf16_t* kp = Kg + ((size_t)b * SEQ + (size_t)kc_lo * CHUNK + srow) * AW + h * HD + sch * 8;
    const bf16_t* vp = Vg + ((size_t)b * SEQ + (size_t)kc_lo * CHUNK + srow) * AW + h * HD + sch * 8;
    const unsigned so0 = off_b(srow, sch), so1 = off_b(srow + 32, sch);
    u32x4 sk0, sk1, sv0, sv1;
    sk0 = *(const u32x4*)kp; sk1 = *(const u32x4*)(kp + 32 * AW); sv0 = *(const u32x4*)vp; sv1 = *(const u32x4*)(vp + 32 * AW);
    unsigned ka[8];
#pragma unroll
    for (int ks = 0; ks < 8; ++ks) ka[ks] = off_b(r32, 2 * ks + hi);
    const unsigned blk = (lane >> 4) & 1, q4 = (lane & 15) >> 2, p4 = lane & 3;
    unsigned va[4][2];
#pragma unroll
    for (int dt = 0; dt < 4; ++dt)
#pragma unroll
        for (int tp = 0; tp < 2; ++tp) va[dt][tp] = off_b(4 * hi + q4 + 8 * tp, 4 * dt + 2 * blk + (p4 >> 1)) + 8 * (p4 & 1);
    float m_run = -1e30f, l_run = 0.f;
    f32x16 o[4];
#pragma unroll
    for (int dt = 0; dt < 4; ++dt) o[dt] = (f32x16){};
    const int qin = 32 * (wid & 1) + r32;
    for (int s = 0; s < nsteps; ++s) {
        const int kc = kc_lo + s, buf = s & 1;
        LAS unsigned char* Kb = lds + AT_K + buf * 16384; LAS unsigned char* Vb = lds + AT_V + buf * 16384;
        *(LAS u32x4*)(Kb + so0) = sk0; *(LAS u32x4*)(Kb + so1) = sk1; *(LAS u32x4*)(Vb + so0) = sv0; *(LAS u32x4*)(Vb + so1) = sv1;
        if (s + 1 < nsteps) { kp += (size_t)CHUNK * AW; vp += (size_t)CHUNK * AW;
            sk0 = *(const u32x4*)kp; sk1 = *(const u32x4*)(kp + 32 * AW); sv0 = *(const u32x4*)vp; sv1 = *(const u32x4*)(vp + 32 * AW); }
        LDS_WAIT(); __builtin_amdgcn_s_barrier(); asm volatile("" ::: "memory");
        const int delta = c - kc;
        if (delta >= 0 && delta <= LEFT) {
#pragma unroll
            for (int t = 0; t < 2; ++t) {
                f32x16 sc = (f32x16){};
#pragma unroll
                for (int ks = 0; ks < 8; ++ks) { const bf16x8 kf = *(const LAS bf16x8*)(Kb + ka[ks] + t * 8192); sc = __builtin_amdgcn_mfma_f32_32x32x16_bf16(kf, qf[ks], sc, 0, 0, 0); }
                if (delta >= 3) { const float bc = bt[2 * MAXREL];
#pragma unroll
                    for (int r = 0; r < 16; ++r) sc[r] += bc;
                } else { const int lb = 64 * delta + qin - 32 * t - 4 * hi + MAXREL;
#pragma unroll
                    for (int r = 0; r < 16; ++r) { int idx = lb - ((r & 3) + 8 * (r >> 2)); idx = idx > 2 * MAXREL ? 2 * MAXREL : idx; sc[r] += bt[idx]; } }
                float tm = sc[0];
#pragma unroll
                for (int r = 1; r < 16; ++r) tm = fmaxf(tm, sc[r]);
                tm = fmaxf(tm, __shfl_xor(tm, 32));
                if (!__all(tm <= m_run + ATT_THR)) {
                    const float mn = fmaxf(m_run, tm), al = __builtin_amdgcn_exp2f(m_run - mn); m_run = mn; l_run *= al;
#pragma unroll
                    for (int dt = 0; dt < 4; ++dt) o[dt] = o[dt] * al;
                }
                float ps = 0.f;
#pragma unroll
                for (int r = 0; r < 16; ++r) { sc[r] = __builtin_amdgcn_exp2f(sc[r] - m_run); ps += sc[r]; }
                l_run += ps;
                bf16x8 pb[2];
#pragma unroll
                for (int s2 = 0; s2 < 2; ++s2) { u32x4 w; w.x = cvtpk(sc[8 * s2 + 0], sc[8 * s2 + 1]); w.y = cvtpk(sc[8 * s2 + 2], sc[8 * s2 + 3]); w.z = cvtpk(sc[8 * s2 + 4], sc[8 * s2 + 5]); w.w = cvtpk(sc[8 * s2 + 6], sc[8 * s2 + 7]); pb[s2] = __builtin_bit_cast(bf16x8, w); }
#pragma unroll
                for (int dt = 0; dt < 4; ++dt)
#pragma unroll
                    for (int s2 = 0; s2 < 2; ++s2) {
                        const v4i16_t lo = vtr(Vb + va[dt][0] + (32 * t + 16 * s2) * 256), hh = vtr(Vb + va[dt][1] + (32 * t + 16 * s2) * 256);
                        const bf16x8 vf = (bf16x8){lo[0], lo[1], lo[2], lo[3], hh[0], hh[1], hh[2], hh[3]};
                        o[dt] = __builtin_amdgcn_mfma_f32_32x32x16_bf16(vf, pb[s2], o[dt], 0, 0, 0);
                    }
            }
        }
    }
    const float lt = l_run + __shfl_xor(l_run, 32), inv = 1.0f / lt;
    float ss = 0.f;
    bf16_t* orow = MIX + blk_off(qrow, h * HD, DM);
#pragma unroll
    for (int dt = 0; dt < 4; ++dt)
#pragma unroll
        for (int rg = 0; rg < 4; ++rg) {
            const float a0 = o[dt][4 * rg] * inv, a1 = o[dt][4 * rg + 1] * inv, a2 = o[dt][4 * rg + 2] * inv, a3 = o[dt][4 * rg + 3] * inv;
            ss += (a0 * a0 + a1 * a1) + (a2 * a2 + a3 * a3);
            u32x2 w; w.x = cvtpk(a0, a1); w.y = cvtpk(a2, a3);
            *(u32x2*)(orow + (dt >> 1) * 16384 + 32 * (dt & 1) + 8 * rg + 4 * hi) = w;
        }
    ss += __shfl_xor(ss, 32);
    if (hi == 0) SSA[qrow * 8 + h] = ss;
    LDS_WAIT(); __builtin_amdgcn_s_barrier(); asm volatile("" ::: "memory");
}

__device__ __forceinline__ void gmlp_unit(const Frame& F, const bf16_t* U, const bf16_t* ZN, const bf16_t* WSP, const float* bsp, bf16_t* MIX, float* SSG, int b, int nb, int g) {
    LAS unsigned char* lds = F.lds + AT_K;
    const int tid = F.tid, lane = F.lane, wid = F.wave, r32 = lane & 31, hi = lane >> 5;
    const size_t row0 = (size_t)b * SEQ + 128 * nb;
#pragma unroll
    for (int i = 0; i < 4; ++i) { const int n = tid + 512 * i, row = n >> 4, ch = n & 15;
        const u32x4 v = *(const u32x4*)(ZN + (row0 + row) * AW + g * HD + ch * 8); *(LAS u32x4*)(lds + off_b(row, ch)) = v; }
    const int tt = wid & 3, chh = wid >> 2;
    const int trow = 32 * tt + r32;
    const bf16_t* wrow = WSP + ((size_t)g * 128 + trow) * 128 + 8 * hi;
    const int nks = tt < 2 ? 4 : 8;
    LDS_WAIT(); __builtin_amdgcn_s_barrier(); asm volatile("" ::: "memory");
    const unsigned blk = (lane >> 4) & 1, q4 = (lane & 15) >> 2, p4 = lane & 3;
    f32x16 acc[2]; acc[0] = (f32x16){}; acc[1] = (f32x16){};
    for (int ks = 0; ks < nks; ++ks) {
        const bf16x8 wf = *(const bf16x8*)(wrow + 16 * ks);
#pragma unroll
        for (int c2 = 0; c2 < 2; ++c2) { const int ct = 2 * chh + c2;
            const v4i16_t lo = vtr(lds + off_b(16 * ks + 8 * hi + q4, 4 * ct + 2 * blk + (p4 >> 1)) + 8 * (p4 & 1));
            const v4i16_t hh = vtr(lds + off_b(16 * ks + 8 * hi + 4 + q4, 4 * ct + 2 * blk + (p4 >> 1)) + 8 * (p4 & 1));
            const bf16x8 zf = (bf16x8){lo[0], lo[1], lo[2], lo[3], hh[0], hh[1], hh[2], hh[3]};
            acc[c2] = __builtin_amdgcn_mfma_f32_32x32x16_bf16(zf, wf, acc[c2], 0, 0, 0); }
    }
    const float bs = bsp[g * 128 + trow];
    const size_t grow = row0 + trow;
    float ss = 0.f;
#pragma unroll
    for (int c2 = 0; c2 < 2; ++c2)
#pragma unroll
        for (int rg = 0; rg < 4; ++rg) { const int c0 = 32 * (2 * chh + c2) + 8 * rg + 4 * hi;
            const u32x2 uu = *(const u32x2*)(U + grow * AW + g * HD + c0);
            const float o0 = bf2f((unsigned short)(uu.x & 0xffff)) * (acc[c2][4 * rg] + bs), o1 = bf2f((unsigned short)(uu.x >> 16)) * (acc[c2][4 * rg + 1] + bs);
            const float o2 = bf2f((unsigned short)(uu.y & 0xffff)) * (acc[c2][4 * rg + 2] + bs), o3 = bf2f((unsigned short)(uu.y >> 16)) * (acc[c2][4 * rg + 3] + bs);
            ss += (o0 * o0 + o1 * o1) + (o2 * o2 + o3 * o3);
            u32x2 w; w.x = cvtpk(o0, o1); w.y = cvtpk(o2, o3);
            *(u32x2*)(MIX + blk_off(grow, AW + g * HD + c0, DM)) = w; }
    ss += __shfl_xor(ss, 32);
    if (hi == 0) SSG[grow * 16 + g * 2 + chh] = ss;
    LDS_WAIT(); __builtin_amdgcn_s_barrier(); asm volatile("" ::: "memory");
}

constexpr int NPH = 8;
__global__ void __launch_bounds__(512, 2) mk_fwd(Args args) {
    extern __shared__ __attribute__((aligned(16))) unsigned char lds_raw[];
    Frame F;
    F.lds = (LAS unsigned char*)lds_raw;
    F.tid = threadIdx.x; F.lane = F.tid & 63; F.wave = __builtin_amdgcn_readfirstlane(F.tid >> 6);
    F.G = gridDim.x; { const int bx = blockIdx.x; F.vcu = (F.G % 8 == 0) ? (bx % 8) * (F.G / 8) + bx / 8 : bx; }
    unsigned char* ws = args.ws;
    unsigned* ctl = (unsigned*)(ws + WS_CTL);
    for (int u = F.tid; u < (LDS_BYTES - LDSCTL_OFF) / 4; u += 512) ((LAS unsigned*)(F.lds + LDSCTL_OFF))[u] = 0u;
    __syncthreads();
    XcdBarrier bar; bar.bar = ctl + 4096; bar.x = 0; bar.st = nullptr;
    if (MK_N_LAUNCHES == 1) bar = xcd_barrier_post(ctl + 4096, (volatile LAS unsigned*)(F.lds + MISC_OFF) + 8);
    const int lo = args.ph_lo, hi = args.ph_hi;
#ifndef MK_PHASE_MASK
#define MK_PHASE_MASK 255
#endif
#define IN(k) (((MK_PHASE_MASK >> (k)) & 1) && lo <= (k) && (k) < hi)
#ifndef MK_REP_MASK
#define MK_REP_MASK 0
#endif
#define REP(k) for (int rep_ = 0; rep_ < 1 + ((MK_REP_MASK >> (k)) & 1); ++rep_)
#define SEAM(k) do { if (IN(k) && IN((k) + 1)) xcd_barrier(bar); } while (0)

    const float* x = args.in[0]; const float* cnd = args.in[1]; const float* w_ada = args.in[2]; const float* b_ada = args.in[3]; const float* mix_g = args.in[4];
    const float* w_in = args.in[5]; const float* q_g = args.in[6]; const float* k_g = args.in[7]; const float* relb = args.in[8]; const float* gm_g = args.in[9];
    const float* w_sp = args.in[10]; const float* b_sp = args.in[11]; const float* ao_g = args.in[12]; const float* go_g = args.in[13]; const float* w_out = args.in[14];
    const float* ff_g = args.in[15]; const float* w_f1 = args.in[16]; const float* w_f2 = args.in[17];
    float* out = args.out;
    float* MOD = (float*)(ws + WS_MOD); float* SSA = (float*)(ws + WS_SSA); float* SSG = (float*)(ws + WS_SSG);
    bf16_t* WSP = (bf16_t*)(ws + WS_WSP); bf16_t* WIN = (bf16_t*)(ws + WS_WIN); bf16_t* WOUT = (bf16_t*)(ws + WS_WOUT); bf16_t* WF1 = (bf16_t*)(ws + WS_WF1); bf16_t* WF2 = (bf16_t*)(ws + WS_WF2);
    bf16_t* H = (bf16_t*)(ws + WS_H); bf16_t* QB = (bf16_t*)(ws + WS_Q); bf16_t* KB = (bf16_t*)(ws + WS_K); bf16_t* VB = (bf16_t*)(ws + WS_V); bf16_t* UB = (bf16_t*)(ws + WS_U); bf16_t* ZB = (bf16_t*)(ws + WS_ZN);
    bf16_t* MIX = (bf16_t*)(ws + WS_MIX); bf16_t* ACT = (bf16_t*)(ws + WS_ACT); bf16_t* X1 = (bf16_t*)(ws + WS_X1);
    const int gw = F.vcu * 8 + F.wave, NGW = F.G * 8;

    if (IN(0)) REP(0) { p0_ada(F, cnd, w_ada, b_ada, MOD); }
    SEAM(0);

    if (IN(1)) REP(1) {
        LAS float* scr = (LAS float*)(F.lds + F.wave * 16384);
        constexpr int I_IN = (DM / 64) * (INW / 32), I_OUT = (DM / 64) * (DM / 32), I_F1 = (DM / 64) * (DFF / 32), I_F2 = (DFF / 64) * (DM / 32), I_SP = 64;
        constexpr int NITEMS = I_IN + I_OUT + I_F1 + I_F2 + I_SP;
        for (int it = gw; it < NITEMS; it += NGW) {
            int r = it;
            if (r < I_IN) { p1_transpose_item(w_in, DM, INW, WIN, scr, r, F.lane, nullptr, nullptr); continue; } r -= I_IN;
            if (r < I_OUT) { p1_transpose_item(w_out, DM, DM, WOUT, scr, r, F.lane, ao_g, go_g); continue; } r -= I_OUT;
            if (r < I_F1) { p1_transpose_item(w_f1, DM, DFF, WF1, scr, r, F.lane, nullptr, nullptr); continue; } r -= I_F1;
            if (r < I_F2) { p1_transpose_item(w_f2, DFF, DM, WF2, scr, r, F.lane, nullptr, nullptr); continue; } r -= I_F2;
#pragma unroll
            for (int i = 0; i < 8; ++i) { const int e = r * 2048 + (i * 64 + F.lane) * 4, t = (e >> 7) & 127, s = e & 127;
                f32x4 v = *(const f32x4*)(w_sp + e); if ((t >> 6) < (s >> 6)) v = (f32x4){0.f, 0.f, 0.f, 0.f};
                u32x2 w; w.x = cvtpk(v[0], v[1]); w.y = cvtpk(v[2], v[3]); *(u32x2*)(WSP + e) = w; }
        }
        for (int m = gw; m < MROWS; m += NGW) { const float* mb = MOD + (size_t)(m >> 11) * NMOD;
            norm_mod_row(x + (size_t)m * DM, mix_g, mb, mb + DM, H, m, F.lane); }
    }
    SEAM(1);

    if (IN(2)) REP(2) {
        pg8::Gemm g{H, WIN, MROWS, INW, DM}; pg8::StaticOrder S; S.init(MROWS, INW, F.G, (int)blockIdx.x, 8);
        pg8::EpiProj E{QB, (size_t)(WS_K - WS_Q) / 2, q_g, k_g, gm_g, (LAS float*)(F.lds + XCH_OFF)};
        pg8::gemm_phase<pg8::EpiProj, pg8::StaticOrder>(F.lds, g, S, E);
    }
    SEAM(2);

    if (IN(3)) REP(3) {
        for (int u = F.vcu; u < NBATCH * NH * 8; u += F.G) { const int g4 = u & 7, h = (u >> 3) & 7, b = u >> 6;
            attn_unit(F, QB, KB, VB, MIX, SSA, relb, b, h, g4); }
        for (int u = F.vcu; u < NBATCH * 16 * 8; u += F.G) { const int g = u & 7, nb = (u >> 3) & 15, b = u >> 7;
            gmlp_unit(F, UB, ZB, WSP, b_sp, MIX, SSG, b, nb, g); }
    }
    SEAM(3);

    if (IN(4)) REP(4) {
        pg8::Gemm g{MIX, WOUT, MROWS, DM, DM}; pg8::StaticOrder S; S.init(MROWS, DM, F.G, (int)blockIdx.x, 4);
        pg8::EpiRes1 E{x, X1, MOD, SSA, SSG, (LAS float*)(F.lds + XCH_OFF)};
        { pg8::Unit uu; for (int i = F.tid >> 8; i < 4 && S.next(i, uu); i += 2) E.fill(uu, i, F.tid & 255); }
        __syncthreads();
        pg8::gemm_phase<pg8::EpiRes1, pg8::StaticOrder>(F.lds, g, S, E);
    }
    SEAM(4);

    if (IN(5)) REP(5) {
        for (int m = gw; m < MROWS; m += NGW) { const float* mb = MOD + (size_t)(m >> 11) * NMOD;
            norm_mod_row_bf(X1 + (size_t)m * DM, ff_g, mb + 3 * DM, mb + 4 * DM, H, m, F.lane); }
    }
    SEAM(5);

    if (IN(6)) REP(6) {
        pg8::Gemm g{H, WF1, MROWS, DFF, DM}; pg8::StaticOrder S; S.init(MROWS, DFF, F.G, (int)blockIdx.x, 8);
        pg8::EpiRelu2 E{ACT, DFF};
        pg8::gemm_phase<pg8::EpiRelu2, pg8::StaticOrder>(F.lds, g, S, E);
    }
    SEAM(6);

    if (IN(7)) REP(7) {
        pg8::Gemm g{ACT, WF2, MROWS, DM, DFF}; pg8::StaticOrder S; S.init(MROWS, DM, F.G, (int)blockIdx.x, 4);
        pg8::EpiRes2 E{X1, out, MOD};
        pg8::gemm_phase<pg8::EpiRes2, pg8::StaticOrder>(F.lds, g, S, E);
    }
#undef IN
#undef SEAM
}

extern "C" void kernel_launch(void* const* d_in, const int* in_sizes, int n_in, void* d_out, int out_size, void* d_ws, size_t ws_size, hipStream_t stream) {
    static int grid = 0;
    if (grid == 0) {
        if (n_in != 18 || in_sizes[0] != MROWS * DM || out_size != MROWS * DM || ws_size < WS_END) {
            fprintf(stderr, "kernel_launch: unexpected shapes (n_in %d, in0 %d, out %d, ws %zu); nothing launched\n", n_in, n_in > 0 ? in_sizes[0] : -1, out_size, ws_size); grid = -1; return; }
        int dev = 0, cus = 0, per_cu = 0;
        if (hipGetDevice(&dev) != hipSuccess || hipDeviceGetAttribute(&cus, hipDeviceAttributeMultiprocessorCount, dev) != hipSuccess) { fprintf(stderr, "kernel_launch: device query failed\n"); grid = -1; return; }
        if (hipFuncSetAttribute((const void*)mk_fwd, hipFuncAttributeMaxDynamicSharedMemorySize, LDS_BYTES) != hipSuccess) { fprintf(stderr, "kernel_launch: hipFuncSetAttribute failed\n"); grid = -1; return; }
        if (hipOccupancyMaxActiveBlocksPerMultiprocessor(&per_cu, (const void*)mk_fwd, 512, LDS_BYTES) != hipSuccess || per_cu < 1) {
            fprintf(stderr, "kernel_launch: occupancy query reports %d workgroups per CU\n", per_cu); per_cu = 1; }
        (void)hipGetLastError();
        grid = cus;
    }
    if (grid < 0) return;
    (void)hipMemsetAsync((char*)d_ws + WS_CTL, 0, CTL_ZERO_BYTES, stream);
    Args a{};
    for (int i = 0; i < 18; ++i) a.in[i] = (const float*)d_in[i];
    a.out = (float*)d_out; a.ws = (unsigned char*)d_ws;
#ifndef MK_PROG
#define MK_PROG {0, 1, 2, 3, 4, 5, 6, 7}
#endif
    static const int prog[] = MK_PROG; const int nprog = (MK_N_LAUNCHES == 1) ? 1 : (int)(sizeof(prog) / sizeof(prog[0]));
    for (int li = 0; li < nprog; ++li) {
        if (MK_N_LAUNCHES == 1) { a.ph_lo = 0; a.ph_hi = NPH; } else { a.ph_lo = prog[li]; a.ph_hi = prog[li] + 1; }
        a.li = li;
        hipLaunchKernelGGL(mk_fwd, dim3(grid), dim3(512), LDS_BYTES, stream, a);
        const hipError_t le = hipPeekAtLastError();
        if (le != hipSuccess) { fprintf(stderr, "kernel_launch: launch %d failed: %s\n", li, hipGetErrorName(le)); break; }
    }
}
```

```cpp
#include <hip/hip_runtime.h>
#include <cstdio>
#include <cstdint>

#ifndef MK_N_LAUNCHES
#define MK_N_LAUNCHES 1
#endif

#ifndef MK_SP2
#define MK_SP2 1
#endif
#ifndef MK_ALIGN
#define MK_ALIGN true
#endif
#define LAS __attribute__((address_space(3)))
#define GAS __attribute__((address_space(1)))
typedef unsigned short bf16_t;
typedef short bf16x8 __attribute__((ext_vector_type(8)));
typedef short v4i16_t __attribute__((ext_vector_type(4)));
typedef float f32x4 __attribute__((ext_vector_type(4)));
typedef float f32x2 __attribute__((ext_vector_type(2)));
typedef float f32x16 __attribute__((ext_vector_type(16)));
typedef unsigned u32x4 __attribute__((ext_vector_type(4)));
typedef unsigned u32x2 __attribute__((ext_vector_type(2)));
typedef __bf16 bf16x2_t __attribute__((ext_vector_type(2)));

constexpr int DM = 2048, NBATCH = 8, SEQ = 2048, MROWS = NBATCH * SEQ;
constexpr int AW = 1024, NH = 8, HD = 128, INW = 5120, DFF = 8192, NMOD = 6 * DM;
constexpr int CHUNK = 64, LEFT = 8, MAXREL = 128, NREL = 2 * MAXREL + 1;
constexpr float EPS = 1e-6f;
constexpr float LOG2E = 1.4426950408889634f;
constexpr float QSCALE = 0.08838834764831845f * LOG2E;

constexpr size_t MiB = 1u << 20;
constexpr size_t WS_CTL = 0, CTL_ZERO_BYTES = 64 * 1024;
constexpr size_t WS_MOD = 1 * MiB;
constexpr size_t WS_SSA = 2 * MiB;
constexpr size_t WS_SSG = 3 * MiB;
constexpr size_t WS_WSP = 6 * MiB;
constexpr size_t WS_WIN = 8 * MiB, WS_WOUT = 28 * MiB, WS_WF1 = 36 * MiB, WS_WF2 = 68 * MiB;
constexpr size_t WS_H = 100 * MiB;
constexpr size_t WS_Q = 164 * MiB, WS_K = 196 * MiB, WS_V = 228 * MiB, WS_U = 260 * MiB, WS_ZN = 292 * MiB;
constexpr size_t WS_MIX = 324 * MiB;
constexpr size_t WS_ACT = 164 * MiB;
constexpr size_t WS_X1 = 420 * MiB;
constexpr size_t WS_END = 484 * MiB;

constexpr int RING_BYTES = 131072;
constexpr int XCH_OFF = RING_BYTES;
constexpr int LDSCTL_OFF = RING_BYTES + 8192, MISC_OFF = LDSCTL_OFF + 320;
constexpr int LDS_BYTES = 147456;

__device__ __forceinline__ unsigned cvtpk(float lo, float hi) { f32x2 v = {lo, hi}; bf16x2_t b = __builtin_convertvector(v, bf16x2_t); return __builtin_bit_cast(unsigned, b); }
__device__ __forceinline__ float bf2f(unsigned short h) { return __uint_as_float((unsigned)h << 16); }
__device__ __forceinline__ float wave_sum(float v) {
#pragma unroll
    for (int o = 1; o < 64; o <<= 1) v += __shfl_xor(v, o);
    return v;
}
__device__ __forceinline__ f32x2 gelu_pk(f32x2 v) {
    const f32x2 av = __builtin_elementwise_abs(v), d = av * 0.2316418882f + 1.0f;
    f32x2 t; t.x = __builtin_amdgcn_rcpf(d.x); t.y = __builtin_amdgcn_rcpf(d.y);
    f32x2 q = t * 0.5307027145f + (-0.7265760135f); q = q * t + 0.7107068705f; q = q * t + (-0.142248368f); q = q * t + 0.127414796f; q = q * t;
    const f32x2 s = (v * v) * (-0.72134752044f);
    f32x2 e; e.x = __builtin_amdgcn_exp2f(s.x); e.y = __builtin_amdgcn_exp2f(s.y);
    const f32x2 m = v * (q * e), r = v - m;
    f32x2 o; o.x = v.x < 0.f ? m.x : r.x; o.y = v.y < 0.f ? m.y : r.y; return o;
}
__device__ __forceinline__ f32x4 gelu4(f32x4 v) { const f32x2 a = gelu_pk((f32x2){v[0], v[1]}), b = gelu_pk((f32x2){v[2], v[3]}); return (f32x4){a.x, a.y, b.x, b.y}; }

__host__ __device__ __forceinline__ size_t blk_off(size_t row, int k, int K) { return (row >> 8) * ((size_t)256 * K) + (size_t)(k >> 6) * 16384 + (row & 255) * 64 + (k & 63); }

namespace pg8 {
constexpr int BM = 256, BK = 64, HALF = 128, HTB = HALF * BK * 2, STAGE_BYTES = 8 * HTB, NXCD = 8;
__host__ __device__ __forceinline__ int lds_byte(int r, int c) { return r * 128 + ((((c >> 3) ^ (r >> 1)) & 7) << 4) + (c & 7) * 2; }
__host__ __device__ __forceinline__ void stage_rc(int b, int& R, int& C) { R = b >> 7; C = ((((b >> 4) & 7) ^ (R >> 1)) & 7) * 8; }
__host__ __device__ __forceinline__ int perm32(int rho) { const int n = rho >> 4, i = rho & 15; return 8 * (i >> 2) + 4 * n + (i & 3); }

struct Unit { int pm, pn; };
struct Gemm { const bf16_t* A; const bf16_t* Bt; int M, N, K; };

struct StaticOrder {
    int nM, nN, nwg, G, c, WGM;
    __device__ void init(int M, int N, int G_, int c_, int wgm) { nM = M / BM; nN = N / BM; nwg = nM * nN; G = G_; c = c_; WGM = wgm; }
    __device__ bool next(int i, Unit& u) const {
        const long L = (long)i * G + c; if (L >= nwg) return false;
        int wgid = (int)L; { const int q = nwg / NXCD, r = nwg % NXCD, xcd = wgid % NXCD, off = wgid / NXCD; wgid = (xcd < r ? xcd * (q + 1) : r * (q + 1) + (xcd - r) * q) + off; }
        const int nig = WGM * nN, gid = wgid / nig, fm = gid * WGM, gsz = (nM - fm) < WGM ? (nM - fm) : WGM;
        u.pm = fm + ((wgid % nig) % gsz); u.pn = (wgid % nig) / gsz; return true;
    }
};

#define PG8_BARRIER() do { asm volatile("s_waitcnt lgkmcnt(0)" ::: "memory"); __builtin_amdgcn_s_barrier(); asm volatile("" ::: "memory"); } while (0)

struct EpiProj {
    static constexpr bool PERM = true, HOOKS = false, ALIGN = true; static constexpr int MIDT = 0;
    bf16_t* base;
    size_t tstride;
    const float *qg, *kg, *zg;
    LAS float* xch;
    __device__ __forceinline__ void begin(const Unit&, int, int) const {}
    __device__ __forceinline__ void mid(f32x4 (&)[2][2][4][2], int, int, int) const {}
    __device__ __forceinline__ void operator()(f32x4 (&acc)[2][2][4][2], const Unit& u, int ui, int wr, int wc, int fr, int fq) const {
        const int type = u.pn >> 2, colt = (u.pn & 3) * 256;
        bf16_t* O = base + (size_t)type * tstride;
        const int row0 = u.pm * BM + wr * 64 + fr, col0 = colt + wc * 32 + 8 * fq;
        if (type >= 3) {
#pragma unroll
            for (int ai = 0; ai < 2; ++ai)
#pragma unroll
                for (int bj = 0; bj < 2; ++bj)
#pragma unroll
                    for (int m = 0; m < 4; ++m)
#pragma unroll
                        for (int n = 0; n < 2; ++n) acc[ai][bj][m][n] = gelu4(acc[ai][bj][m][n]);
        }
        if (type == 0 || type == 1 || type == 4) {
#pragma unroll
            for (int ai = 0; ai < 2; ++ai)
#pragma unroll
                for (int m = 0; m < 4; ++m)
#pragma unroll
                    for (int bj = 0; bj < 2; ++bj) {
                        const f32x4 a = acc[ai][bj][m][0], b = acc[ai][bj][m][1];
                        float s = (a[0] * a[0] + a[1] * a[1]) + (a[2] * a[2] + a[3] * a[3]) + (b[0] * b[0] + b[1] * b[1]) + (b[2] * b[2] + b[3] * b[3]);
                        s += __shfl_xor(s, 16); s += __shfl_xor(s, 32);
                        if (fq == 0) xch[((ai * HALF + wr * 64 + m * 16 + fr) * 2 + bj) * 4 + wc] = s;
                    }
            PG8_BARRIER();
            const float* gp = type == 0 ? qg : (type == 1 ? kg : zg + (u.pn & 3) * 256);
            const float sc = type == 0 ? QSCALE : 1.0f;
            f32x4 gv[2][2];
#pragma unroll
            for (int bj = 0; bj < 2; ++bj)
#pragma unroll
                for (int n = 0; n < 2; ++n) gv[bj][n] = *(const f32x4*)(gp + (type == 4 ? bj * 128 : 0) + wc * 32 + 8 * fq + 4 * n) * sc;
#pragma unroll
            for (int ai = 0; ai < 2; ++ai)
#pragma unroll
                for (int m = 0; m < 4; ++m)
#pragma unroll
                    for (int bj = 0; bj < 2; ++bj) {
                        const f32x4 p = *(const LAS f32x4*)(xch + ((ai * HALF + wr * 64 + m * 16 + fr) * 2 + bj) * 4);
                        const float rinv = 1.0f / sqrtf(((p[0] + p[1]) + (p[2] + p[3])) * (1.0f / 128.0f) + EPS);
                        acc[ai][bj][m][0] = acc[ai][bj][m][0] * rinv * gv[bj][0]; acc[ai][bj][m][1] = acc[ai][bj][m][1] * rinv * gv[bj][1];
                    }
        }
#pragma unroll
        for (int ai = 0; ai < 2; ++ai)
#pragma unroll
            for (int m = 0; m < 4; ++m) { bf16_t* rowp = O + (size_t)(row0 + ai * HALF + m * 16) * AW + col0;
#pragma unroll
                for (int bj = 0; bj < 2; ++bj) { const f32x4 v0 = acc[ai][bj][m][0], v1 = acc[ai][bj][m][1];
                    u32x4 w; w.x = cvtpk(v0[0], v0[1]); w.y = cvtpk(v0[2], v0[3]); w.z = cvtpk(v1[0], v1[1]); w.w = cvtpk(v1[2], v1[3]);
                    *(u32x4*)(rowp + bj * HALF) = w; } }
    }
};

struct EpiRes1 {
    static constexpr bool PERM = true, HOOKS = true, ALIGN = MK_ALIGN; static constexpr int MIDT = 16;
    const float* x; bf16_t* x1; const float* mod;
    const float *ssa, *ssg;
    LAS float* rt;
    __device__ __forceinline__ void begin(const Unit&, int, int) const {}
    __device__ __forceinline__ void fill(const Unit& u, int ui, int row) const {
        const size_t gr = (size_t)u.pm * BM + row;
        const f32x4 a0 = *(const f32x4*)(ssa + gr * 8), a1 = *(const f32x4*)(ssa + gr * 8 + 4);
        const float sa = ((a0[0] + a0[1]) + (a0[2] + a0[3])) + ((a1[0] + a1[1]) + (a1[2] + a1[3]));
        const f32x4 a = *(const f32x4*)(ssg + gr * 16), b = *(const f32x4*)(ssg + gr * 16 + 4), c = *(const f32x4*)(ssg + gr * 16 + 8), d = *(const f32x4*)(ssg + gr * 16 + 12);
        const float sg = (((a[0] + a[1]) + (a[2] + a[3])) + ((b[0] + b[1]) + (b[2] + b[3]))) + (((c[0] + c[1]) + (c[2] + c[3])) + ((d[0] + d[1]) + (d[2] + d[3])));
        const float ra = 1.0f / sqrtf(sa * (1.0f / 1024.0f) + EPS), rg = 1.0f / sqrtf(sg * (1.0f / 1024.0f) + EPS);
        *(LAS f32x2*)(rt + ((ui & 3) * 256 + row) * 2) = (f32x2){ra / rg, rg};
    }
    __device__ __forceinline__ void mid(f32x4 (&acc)[2][2][4][2], int ui, int wr, int fr) const {
#pragma unroll
        for (int ai = 0; ai < 2; ++ai)
#pragma unroll
            for (int m = 0; m < 4; ++m) { const float f = rt[((ui & 3) * 256 + ai * HALF + wr * 64 + m * 16 + fr) * 2];
#pragma unroll
                for (int bj = 0; bj < 2; ++bj)
#pragma unroll
                    for (int n = 0; n < 2; ++n) acc[ai][bj][m][n] = acc[ai][bj][m][n] * f; }
    }
    __device__ __forceinline__ void operator()(f32x4 (&acc)[2][2][4][2], const Unit& u, int ui, int wr, int wc, int fr, int fq) const {
        const int row0 = u.pm * BM + wr * 64 + fr, col0 = u.pn * BM + wc * 32 + 8 * fq;
        const float* gp = mod + (size_t)(u.pm >> 3) * NMOD + 2 * DM + col0;
        f32x4 gv[2][2];
#pragma unroll
        for (int bj = 0; bj < 2; ++bj)
#pragma unroll
            for (int n = 0; n < 2; ++n) gv[bj][n] = *(const f32x4*)(gp + bj * HALF + n * 4);
#pragma unroll
        for (int ai = 0; ai < 2; ++ai)
#pragma unroll
            for (int m = 0; m < 4; ++m) { const size_t off = (size_t)(row0 + ai * HALF + m * 16) * DM + col0;
                const float rg = rt[((ui & 3) * 256 + ai * HALF + wr * 64 + m * 16 + fr) * 2 + 1];
#pragma unroll
                for (int bj = 0; bj < 2; ++bj) {
                    const f32x4 x0 = *(const f32x4*)(x + off + bj * HALF), xb = *(const f32x4*)(x + off + bj * HALF + 4);
                    const f32x4 v0 = x0 + gv[bj][0] * (acc[ai][bj][m][0] * rg), v1 = xb + gv[bj][1] * (acc[ai][bj][m][1] * rg);
                    u32x4 w; w.x = cvtpk(v0[0], v0[1]); w.y = cvtpk(v0[2], v0[3]); w.z = cvtpk(v1[0], v1[1]); w.w = cvtpk(v1[2], v1[3]);
                    *(u32x4*)(x1 + off + bj * HALF) = w; } }
    }
};

struct EpiRelu2 {
    static constexpr bool PERM = true, HOOKS = false, ALIGN = MK_ALIGN; static constexpr int MIDT = 0;
    bf16_t* O; int ldc;
    __device__ __forceinline__ void begin(const Unit&, int, int) const {}
    __device__ __forceinline__ void mid(f32x4 (&)[2][2][4][2], int, int, int) const {}
    __device__ __forceinline__ void operator()(f32x4 (&acc)[2][2][4][2], const Unit& u, int ui, int wr, int wc, int fr, int fq) const {
        const int row0 = u.pm * BM + wr * 64 + fr, col0 = u.pn * BM + wc * 32 + 8 * fq;
#pragma unroll
        for (int ai = 0; ai < 2; ++ai)
#pragma unroll
            for (int m = 0; m < 4; ++m) { bf16_t* rowp = O + blk_off((size_t)(row0 + ai * HALF + m * 16), col0, ldc);
#pragma unroll
                for (int bj = 0; bj < 2; ++bj) { f32x4 v0 = acc[ai][bj][m][0], v1 = acc[ai][bj][m][1];
                    v0 = __builtin_elementwise_max(v0, (f32x4){0.f, 0.f, 0.f, 0.f}); v1 = __builtin_elementwise_max(v1, (f32x4){0.f, 0.f, 0.f, 0.f}); v0 = v0 * v0; v1 = v1 * v1;
                    u32x4 w; w.x = cvtpk(v0[0], v0[1]); w.y = cvtpk(v0[2], v0[3]); w.z = cvtpk(v1[0], v1[1]); w.w = cvtpk(v1[2], v1[3]);
                    *(u32x4*)(rowp + bj * 2 * 16384) = w; } }
    }
};

struct EpiRes2 {
    static constexpr bool PERM = false, HOOKS = false, ALIGN = MK_ALIGN; static constexpr int MIDT = 0;
    const bf16_t* x1; float* out; const float* mod;
    __device__ __forceinline__ void begin(const Unit&, int, int) const {}
    __device__ __forceinline__ void mid(f32x4 (&)[2][2][4][2], int, int, int) const {}
    __device__ __forceinline__ void operator()(f32x4 (&acc)[2][2][4][2], const Unit& u, int ui, int wr, int wc, int fr, int fq) const {
        const int row0 = u.pm * BM + wr * 64 + fr, col0 = u.pn * BM + wc * 32 + 4 * fq;
        const float* gp = mod + (size_t)(u.pm >> 3) * NMOD + 5 * DM + col0;
        f32x4 gv[2][2];
#pragma unroll
        for (int bj = 0; bj < 2; ++bj)
#pragma unroll
            for (int n = 0; n < 2; ++n) gv[bj][n] = *(const f32x4*)(gp + bj * HALF + n * 16);
#pragma unroll
        for (int ai = 0; ai < 2; ++ai)
#pragma unroll
            for (int m = 0; m < 4; ++m) { const size_t off = (size_t)(row0 + ai * HALF + m * 16) * DM + col0;
#pragma unroll
                for (int bj = 0; bj < 2; ++bj)
#pragma unroll
                    for (int n = 0; n < 2; ++n) { const u32x2 xr = *(const u32x2*)(x1 + off + bj * HALF + n * 16);
                        const f32x4 xv = (f32x4){__uint_as_float(xr.x << 16), __uint_as_float(xr.x & 0xffff0000u), __uint_as_float(xr.y << 16), __uint_as_float(xr.y & 0xffff0000u)};
                        *(f32x4*)(out + off + bj * HALF + n * 16) = xv + gv[bj][n] * acc[ai][bj][m][n]; } }
    }
};

template <class Epi, class Sched>
__device__ __forceinline__ void gemm_phase(LAS unsigned char* lds, const Gemm g, const Sched& S, const Epi& E) {
    const int tid = threadIdx.x, wid = __builtin_amdgcn_readfirstlane(tid >> 6), lane = tid & 63, wr = wid >> 2, wc = wid & 3, fr = lane & 15, fq = lane >> 4;
    const int K = g.K, nt = K / BK;
    unsigned voffA[2], voffB[2];
#pragma unroll
    for (int i = 0; i < 2; ++i) { int R, C; stage_rc(tid * 16 + i * 8192, R, C); const int Rb = Epi::PERM ? ((R & ~31) + perm32(R & 31)) : R;
        voffA[i] = (unsigned)(R * 64 + C) * 2u; voffB[i] = (unsigned)(Rb * 64 + C) * 2u; }
    const size_t kstep = (size_t)(256 * BK * 2);
    const size_t hstep = (size_t)HALF * BK * 2;
    const size_t tstep = (size_t)256 * K * 2;
    const unsigned ldsw = (unsigned)wid * 1024u;
    const int aoff[2] = {lds_byte(wr * 64 + fr, fq * 8), lds_byte(wr * 64 + fr, 32 + fq * 8)}, boff[2] = {lds_byte(wc * 32 + fr, fq * 8), lds_byte(wc * 32 + fr, 32 + fq * 8)};
#define PG8_SA(b, h) (((b) * 2 + (h)) * HTB)
#define PG8_SB(b, h) ((4 + (b) * 2 + (h)) * HTB)
#define PG8_STAGE(bufoff, gbase, voff) do { _Pragma("unroll") for (int _i = 0; _i < 2; ++_i) \
        __builtin_amdgcn_global_load_lds((const unsigned*)((const char*)(gbase) + (voff)[_i]), (LAS unsigned*)(lds + (bufoff) + ldsw + _i * 8192), 16, 0, 0); } while (0)
#define PG8_LDA(dst, b, h) do { _Pragma("unroll") for (int m = 0; m < 4; ++m) _Pragma("unroll") for (int k = 0; k < 2; ++k) dst[m][k] = *(const LAS bf16x8*)(lds + PG8_SA(b, h) + aoff[k] + m * 2048); } while (0)
#define PG8_LDB(dst, b, h) do { _Pragma("unroll") for (int n = 0; n < 2; ++n) _Pragma("unroll") for (int k = 0; k < 2; ++k) dst[n][k] = *(const LAS bf16x8*)(lds + PG8_SB(b, h) + boff[k] + n * 2048); } while (0)
#define PG8_MMA(ai, bj, At, Bt) do { __builtin_amdgcn_s_setprio(1); _Pragma("unroll") for (int m = 0; m < 4; ++m) _Pragma("unroll") for (int n = 0; n < 2; ++n) _Pragma("unroll") for (int k = 0; k < 2; ++k) \
        acc[ai][bj][m][n] = __builtin_amdgcn_mfma_f32_16x16x32_bf16(Bt[n][k], At[m][k], acc[ai][bj][m][n], 0, 0, 0); __builtin_amdgcn_s_setprio(0); } while (0)
#define PG8_WAIT_V(n) asm volatile("s_waitcnt vmcnt(" #n ")" ::: "memory")
#define PG8_WAIT_L(n) asm volatile("s_waitcnt lgkmcnt(" #n ")" ::: "memory")
#define PG8_BAR __builtin_amdgcn_s_barrier()
#define PG8_SCHED __builtin_amdgcn_sched_barrier(0)
    Unit cur, nxt; int ui = 0;
    if (!S.next(0, cur)) return;
    f32x4 acc[2][2][4][2];
#pragma unroll
    for (int a = 0; a < 2; ++a)
#pragma unroll
        for (int b = 0; b < 2; ++b)
#pragma unroll
            for (int m = 0; m < 4; ++m)
#pragma unroll
                for (int n = 0; n < 2; ++n) acc[a][b][m][n] = (f32x4){0.f, 0.f, 0.f, 0.f};
    bf16x8 At[4][2], B0[2][2], B1[2][2];
    const char* cA = (const char*)g.A + (size_t)cur.pm * tstep; const char* cB = (const char*)g.Bt + (size_t)cur.pn * tstep;
#if MK_SP2
    PG8_STAGE(PG8_SB(0, 0), cB, voffB); PG8_STAGE(PG8_SB(0, 1), cB + hstep, voffB); PG8_STAGE(PG8_SA(0, 0), cA, voffA); PG8_STAGE(PG8_SA(0, 1), cA + hstep, voffA);
    if (wr == 1) PG8_BAR;
    PG8_WAIT_V(2); PG8_BAR;
    PG8_STAGE(PG8_SB(1, 0), cB + kstep, voffB); PG8_STAGE(PG8_SA(1, 0), cA + kstep, voffA); PG8_STAGE(PG8_SB(1, 1), cB + hstep + kstep, voffB);
    PG8_WAIT_V(6); PG8_BAR;
#else
    PG8_STAGE(PG8_SB(0, 0), cB, voffB); PG8_STAGE(PG8_SA(0, 0), cA, voffA); PG8_STAGE(PG8_SB(0, 1), cB + hstep, voffB); PG8_STAGE(PG8_SA(0, 1), cA + hstep, voffA);
    if (wr == 1) PG8_BAR;
    PG8_WAIT_V(4); PG8_BAR;
    PG8_STAGE(PG8_SB(1, 0), cB + kstep, voffB); PG8_STAGE(PG8_SA(1, 0), cA + kstep, voffA); PG8_STAGE(PG8_SB(1, 1), cB + hstep + kstep, voffB);
    PG8_WAIT_V(6); PG8_BAR;
#endif
    for (;;) {
        const bool has_next = S.next(ui + 1, nxt);
        const char* nA = has_next ? (const char*)g.A + (size_t)nxt.pm * tstep : cA; const char* nB = has_next ? (const char*)g.Bt + (size_t)nxt.pn * tstep : cB;
        for (int t = 0; t < nt; t += 2) {
            const bool last = (t == nt - 2);
            const char* a1 = cA + (size_t)(t + 1) * kstep;
            const char* a2 = last ? nA : cA + (size_t)(t + 2) * kstep; const char* b2 = last ? nB : cB + (size_t)(t + 2) * kstep;
            const char* a3 = a2 + kstep; const char* b3 = b2 + kstep;
            if constexpr (Epi::HOOKS) { if (t == Epi::MIDT) E.mid(acc, ui, wr, fr); }
#if MK_SP2
            PG8_LDB(B0, 0, 0); PG8_LDB(B1, 0, 1); PG8_SCHED; PG8_LDA(At, 0, 0); PG8_STAGE(PG8_SA(1, 1), a1 + hstep, voffA);
            PG8_WAIT_V(8); PG8_WAIT_L(0); PG8_BAR; PG8_MMA(0, 0, At, B0); PG8_MMA(0, 1, At, B1); PG8_BAR; PG8_SCHED;
            PG8_LDA(At, 0, 1); PG8_STAGE(PG8_SB(0, 0), b2, voffB); PG8_STAGE(PG8_SB(0, 1), b2 + hstep, voffB); PG8_STAGE(PG8_SA(0, 0), a2, voffA);
            PG8_WAIT_V(8); PG8_WAIT_L(0); PG8_BAR; PG8_MMA(1, 0, At, B0); PG8_MMA(1, 1, At, B1); PG8_BAR; PG8_SCHED;
            PG8_LDB(B0, 1, 0); PG8_LDB(B1, 1, 1); PG8_SCHED; PG8_LDA(At, 1, 0); PG8_STAGE(PG8_SA(0, 1), a2 + hstep, voffA);
            PG8_WAIT_V(8); PG8_WAIT_L(0); PG8_BAR; PG8_MMA(0, 0, At, B0); PG8_MMA(0, 1, At, B1); PG8_BAR; PG8_SCHED;
            PG8_LDA(At, 1, 1); PG8_STAGE(PG8_SB(1, 0), b3, voffB); PG8_STAGE(PG8_SB(1, 1), b3 + hstep, voffB); PG8_STAGE(PG8_SA(1, 0), a3, voffA);
            PG8_WAIT_V(8); PG8_WAIT_L(0); PG8_BAR; PG8_MMA(1, 0, At, B0); PG8_MMA(1, 1, At, B1); PG8_BAR; PG8_SCHED;
#else
            PG8_LDB(B0, 0, 0); PG8_SCHED; PG8_LDA(At, 0, 0); PG8_STAGE(PG8_SA(1, 1), a1 + hstep, voffA);
            PG8_WAIT_L(8); PG8_BAR; PG8_WAIT_L(0); PG8_MMA(0, 0, At, B0); PG8_BAR; PG8_SCHED;
            PG8_LDB(B1, 0, 1); PG8_STAGE(PG8_SB(0, 0), b2, voffB);
            PG8_BAR; PG8_WAIT_L(0); PG8_MMA(0, 1, At, B1); PG8_BAR;
            PG8_LDA(At, 0, 1); PG8_STAGE(PG8_SA(0, 0), a2, voffA);
            PG8_BAR; PG8_WAIT_L(0); PG8_MMA(1, 0, At, B0); PG8_BAR; PG8_SCHED;
            PG8_STAGE(PG8_SB(0, 1), b2 + hstep, voffB);
            PG8_WAIT_V(6); PG8_BAR; PG8_MMA(1, 1, At, B1); PG8_BAR;
            PG8_LDB(B0, 1, 0); PG8_SCHED; PG8_LDA(At, 1, 0); PG8_STAGE(PG8_SA(0, 1), a2 + hstep, voffA);
            PG8_WAIT_L(8); PG8_BAR; PG8_WAIT_L(0); PG8_MMA(0, 0, At, B0); PG8_BAR; PG8_SCHED;
            PG8_LDB(B1, 1, 1); PG8_STAGE(PG8_SB(1, 0), b3, voffB);
            PG8_BAR; PG8_WAIT_L(0); PG8_MMA(0, 1, At, B1); PG8_BAR;
            PG8_LDA(At, 1, 1); PG8_STAGE(PG8_SA(1, 0), a3, voffA);
            PG8_BAR; PG8_WAIT_L(0); PG8_MMA(1, 0, At, B0); PG8_BAR; PG8_SCHED;
            PG8_STAGE(PG8_SB(1, 1), b3 + hstep, voffB);
            PG8_WAIT_V(6); PG8_BAR; PG8_MMA(1, 1, At, B1); PG8_BAR;
#endif
        }
        if constexpr (Epi::ALIGN) { if (wr == 0) PG8_BAR; }
        E(acc, cur, ui, wr, wc, fr, fq);
        if (!has_next) break;
#pragma unroll
        for (int a = 0; a < 2; ++a)
#pragma unroll
            for (int b = 0; b < 2; ++b)
#pragma unroll
                for (int m = 0; m < 4; ++m)
#pragma unroll
                    for (int n = 0; n < 2; ++n) acc[a][b][m][n] = (f32x4){0.f, 0.f, 0.f, 0.f};
        cur = nxt; cA = nA; cB = nB; ++ui;
        if constexpr (Epi::ALIGN) { if (wr == 1) PG8_BAR; }
    }
    PG8_WAIT_V(0);
    if constexpr (!Epi::ALIGN) { if (wr == 0) PG8_BAR; }
    PG8_BAR;
#undef PG8_SA
#undef PG8_SB
#undef PG8_STAGE
#undef PG8_LDA
#undef PG8_LDB
#undef PG8_MMA
#undef PG8_WAIT_V
#undef PG8_WAIT_L
#undef PG8_BAR
#undef PG8_SCHED
}
}

typedef GAS unsigned gu32;
#define RLX_AGENT __ATOMIC_RELAXED, __HIP_MEMORY_SCOPE_AGENT
#define XB_TMO      128
#define XB_XCNT(j)  (256  + 64 * (j))
#define XB_XSUB(j)  (1280 + 64 * (j))
#define XB_XGEN(j)  (2304 + 64 * (j))
#define XB_TOP      3328
#define XB_TOPGEN   3392
#define XCD_BAR_WORDS 3456
#define XB_SPIN_CAP (1u << 20)
__device__ __forceinline__ unsigned xb_ld(unsigned* p)              { return __hip_atomic_load(p, __ATOMIC_RELAXED, __HIP_MEMORY_SCOPE_AGENT); }
__device__ __forceinline__ unsigned xb_add(unsigned* p, unsigned v) { return __hip_atomic_fetch_add(p, v, __ATOMIC_RELAXED, __HIP_MEMORY_SCOPE_AGENT); }
__device__ __forceinline__ unsigned xb_xcc_id() { return (unsigned)__builtin_amdgcn_s_getreg((3 << 11) | 20) & 0xFu; }
#define XB_SPIN(cond, bar) do { unsigned _sp = 0; while (cond) { __builtin_amdgcn_s_sleep(1); \
    if ((++_sp & 255u) == 0u) { if (xb_ld(&(bar)[XB_TMO])) break; if (_sp > XB_SPIN_CAP) { atomicAdd(&(bar)[XB_TMO], 1u); break; } } } } while (0)
struct XcdBarrier { unsigned* bar; unsigned x; volatile LAS unsigned* st; };
__device__ __forceinline__ XcdBarrier xcd_barrier_post(unsigned* bar, volatile LAS unsigned* st) {
    XcdBarrier b; b.bar = bar; b.x = xb_xcc_id(); b.st = st;
    if (threadIdx.x == 0) (void)xb_add(&bar[XB_XCNT(b.x)], 1u);
    return b;
}
__device__ __forceinline__ void xcd_barrier_complete(unsigned* bar, unsigned x, unsigned& nloc, unsigned& nx) {
    const unsigned G = gridDim.x * gridDim.y * gridDim.z;
    unsigned sum, cnt, mine, sp = 0u;
    for (;;) {
        sum = 0u; cnt = 0u; mine = 0u;
#pragma unroll
        for (unsigned j = 0; j < 16; ++j) { const unsigned c = xb_ld(&bar[XB_XCNT(j)]); sum += c; cnt += (c > 0u) ? 1u : 0u; mine = (j == x) ? c : mine; }
        if (sum == G) break;
        __builtin_amdgcn_s_sleep(1);
        if ((++sp & 255u) == 0u) { if (xb_ld(&bar[XB_TMO])) break; if (sp > XB_SPIN_CAP) { atomicAdd(&bar[XB_TMO], 1u); break; } }
    }
    nloc = mine > 0u ? mine : 1u; nx = cnt > 0u ? cnt : 1u;
}
__device__ __forceinline__ void xcd_barrier(const XcdBarrier& b) {
    asm volatile("s_waitcnt vmcnt(0)" ::: "memory");
    __syncthreads();
    if (threadIdx.x == 0) {
        unsigned* bar = b.bar;
        __builtin_amdgcn_s_waitcnt(0);
        unsigned nloc = b.st[0], nx = b.st[1];
        if (nloc == 0u) { xcd_barrier_complete(bar, b.x, nloc, nx); b.st[0] = nloc; b.st[1] = nx; }
        const unsigned old = xb_add(&bar[XB_XSUB(b.x)], 1u);
        const unsigned gen = old / nloc;
        if (old + 1u == (gen + 1u) * nloc) {
            __builtin_amdgcn_fence(__ATOMIC_RELEASE, "agent");
            asm volatile("s_waitcnt vmcnt(0)" ::: "memory");
            const unsigned og = xb_add(&bar[XB_TOP], 1u);
            const unsigned tg = og / nx;
            if (og + 1u == (tg + 1u) * nx) xb_add(&bar[XB_TOPGEN], 1u);
            else XB_SPIN(xb_ld(&bar[XB_TOPGEN]) == tg, bar);
            __builtin_amdgcn_fence(__ATOMIC_ACQUIRE, "agent");
            xb_add(&bar[XB_XGEN(b.x)], 1u);
            asm volatile("s_waitcnt vmcnt(0)" ::: "memory");
        } else {
            XB_SPIN(xb_ld(&bar[XB_XGEN(b.x)]) == gen, bar);
            __builtin_amdgcn_fence(__ATOMIC_ACQUIRE, "agent");
            asm volatile("s_waitcnt vmcnt(0)" ::: "memory");
        }
    }
    __syncthreads();
}

struct Args { const float* in[18]; float* out; unsigned char* ws; int ph_lo, ph_hi, li, pad; };
struct Frame {
    LAS unsigned char* lds;
    int tid, lane, wave, vcu, G;
};
#define LDS_WAIT() asm volatile("s_waitcnt lgkmcnt(0)" ::: "memory")

__device__ __forceinline__ void p0_ada(const Frame& F, const float* c, const float* w_ada, const float* b_ada, float* mod) {
    LAS float* sc = (LAS float*)F.lds;
    LAS float* part = (LAS float*)(F.lds + 65536);
    for (int i = F.tid; i < NBATCH * DM; i += 512) { const int b = i >> 11, k = i & 2047; const float v = c[i]; sc[k * 8 + b] = v / (1.0f + __expf(-v)); }
    __syncthreads();
    const int kk = F.lane / 12, c4 = F.lane % 12;
    for (int item = blockIdx.x; item < 256; item += F.G) {
        const int n0 = 48 * item, kb = 256 * F.wave;
        f32x4 acc[8];
#pragma unroll
        for (int b = 0; b < 8; ++b) acc[b] = (f32x4){0.f, 0.f, 0.f, 0.f};
        if (F.lane < 60) {
            const float* wp = w_ada + (size_t)(kb + kk) * NMOD + n0 + 4 * c4;
#pragma unroll 17
            for (int i = 0; i < 51; ++i) {
                const int k = kb + kk + 5 * i;
                const f32x4 w = *(const f32x4*)(wp + (size_t)(5 * i) * NMOD);
                const f32x4 s0 = *(const LAS f32x4*)(sc + k * 8), s1 = *(const LAS f32x4*)(sc + k * 8 + 4);
                acc[0] += w * s0[0]; acc[1] += w * s0[1]; acc[2] += w * s0[2]; acc[3] += w * s0[3];
                acc[4] += w * s1[0]; acc[5] += w * s1[1]; acc[6] += w * s1[2]; acc[7] += w * s1[3];
            }
            if (kk == 0) {
                const int k = kb + 255;
                const f32x4 w = *(const f32x4*)(w_ada + (size_t)k * NMOD + n0 + 4 * c4);
                const f32x4 s0 = *(const LAS f32x4*)(sc + k * 8), s1 = *(const LAS f32x4*)(sc + k * 8 + 4);
                acc[0] += w * s0[0]; acc[1] += w * s0[1]; acc[2] += w * s0[2]; acc[3] += w * s0[3];
                acc[4] += w * s1[0]; acc[5] += w * s1[1]; acc[6] += w * s1[2]; acc[7] += w * s1[3];
            }
#pragma unroll
            for (int b = 0; b < 8; ++b) *(LAS f32x4*)(part + (F.wave * 5 + kk) * 384 + b * 48 + 4 * c4) = acc[b];
        }
        __syncthreads();
        if (F.tid < 384) { float s = 0.f;
#pragma unroll 8
            for (int j = 0; j < 40; ++j) s += part[j * 384 + F.tid];
            const int b = F.tid / 48, n = F.tid % 48; mod[(size_t)b * NMOD + n0 + n] = s + b_ada[n0 + n]; }
        __syncthreads();
    }
}

__device__ __forceinline__ void p1_transpose_item(const float* W, int K, int N, bf16_t* WT, int item, int lane, const float* ks0, const float* ks1) {
    const int nblk = N / 32, kb = item / nblk, nb = item % nblk, k0 = 64 * kb, n0 = 32 * nb, lc = lane & 7, lr = lane >> 3;
    const float* wp = W + (size_t)(k0 + 8 * lr) * N + n0 + 4 * lc;
    f32x4 v[8];
#pragma unroll
    for (int i = 0; i < 8; ++i) v[i] = *(const f32x4*)(wp + (size_t)i * N);
    if (ks0) { const int k = k0 + 8 * lr; const float* kp = k < 1024 ? ks0 + k : ks1 + (k - 1024); const f32x4 s0 = *(const f32x4*)kp, s1 = *(const f32x4*)(kp + 4);
        v[0] = v[0] * s0[0]; v[1] = v[1] * s0[1]; v[2] = v[2] * s0[2]; v[3] = v[3] * s0[3]; v[4] = v[4] * s1[0]; v[5] = v[5] * s1[1]; v[6] = v[6] * s1[2]; v[7] = v[7] * s1[3]; }
    bf16_t* op = WT + blk_off((size_t)(n0 + 4 * lc), k0 + 8 * lr, K);
#pragma unroll
    for (int e = 0; e < 4; ++e) { u32x4 o; o.x = cvtpk(v[0][e], v[1][e]); o.y = cvtpk(v[2][e], v[3][e]); o.z = cvtpk(v[4][e], v[5][e]); o.w = cvtpk(v[6][e], v[7][e]);
        *(u32x4*)(op + e * 64) = o; }
}
__device__ __forceinline__ void norm_mod_row(const float* xrow, const float* g, const float* shift, const float* scale, bf16_t* Hb, int m, int lane) {
    const f32x4* xr = (const f32x4*)xrow + lane;
    f32x4 v[8]; float s = 0.f;
#pragma unroll
    for (int j = 0; j < 8; ++j) { v[j] = xr[64 * j]; s += (v[j][0] * v[j][0] + v[j][1] * v[j][1]) + (v[j][2] * v[j][2] + v[j][3] * v[j][3]); }
    const float rinv = 1.0f / sqrtf(wave_sum(s) * (1.0f / DM) + EPS);
    bf16_t* ob = Hb + blk_off((size_t)m, 4 * lane, DM);
#pragma unroll
    for (int j = 0; j < 8; ++j) { const f32x4 gg = ((const f32x4*)g)[lane + 64 * j], sc = ((const f32x4*)scale)[lane + 64 * j], sh = ((const f32x4*)shift)[lane + 64 * j];
        const f32x4 o = (v[j] * rinv) * gg * (sc + 1.0f) + sh; u32x2 w; w.x = cvtpk(o[0], o[1]); w.y = cvtpk(o[2], o[3]); *(u32x2*)(ob + (size_t)j * 4 * 16384) = w; }
}
__device__ __forceinline__ void norm_mod_row_bf(const bf16_t* xrow, const float* g, const float* shift, const float* scale, bf16_t* Hb, int m, int lane) {
    const u32x4* xr = (const u32x4*)xrow + lane;
    f32x4 v[4][2]; float s = 0.f;
#pragma unroll
    for (int j = 0; j < 4; ++j) { const u32x4 r = xr[64 * j];
        v[j][0] = (f32x4){__uint_as_float(r.x << 16), __uint_as_float(r.x & 0xffff0000u), __uint_as_float(r.y << 16), __uint_as_float(r.y & 0xffff0000u)};
        v[j][1] = (f32x4){__uint_as_float(r.z << 16), __uint_as_float(r.z & 0xffff0000u), __uint_as_float(r.w << 16), __uint_as_float(r.w & 0xffff0000u)};
#pragma unroll
        for (int e = 0; e < 2; ++e) s += (v[j][e][0] * v[j][e][0] + v[j][e][1] * v[j][e][1]) + (v[j][e][2] * v[j][e][2] + v[j][e][3] * v[j][e][3]); }
    const float rinv = 1.0f / sqrtf(wave_sum(s) * (1.0f / DM) + EPS);
    bf16_t* ob = Hb + blk_off((size_t)m, 8 * lane, DM);
#pragma unroll
    for (int j = 0; j < 4; ++j) { u32x4 w;
#pragma unroll
        for (int e = 0; e < 2; ++e) { const int ci = 2 * lane + 128 * j + e;
            const f32x4 gg = ((const f32x4*)g)[ci], sc = ((const f32x4*)scale)[ci], sh = ((const f32x4*)shift)[ci];
            const f32x4 o = (v[j][e] * rinv) * gg * (sc + 1.0f) + sh; if (e == 0) { w.x = cvtpk(o[0], o[1]); w.y = cvtpk(o[2], o[3]); } else { w.z = cvtpk(o[0], o[1]); w.w = cvtpk(o[2], o[3]); } }
        *(u32x4*)(ob + (size_t)j * 8 * 16384) = w; }
}

__device__ __forceinline__ unsigned off_b(unsigned row, unsigned ch) { return 256u * row + 16u * (ch ^ (((row & 3) << 2) | ((row >> 2) & 3))); }
__device__ __forceinline__ v4i16_t vtr(LAS unsigned char* p) { return __builtin_amdgcn_ds_read_tr16_b64_v4i16((LAS v4i16_t*)p); }
__device__ __forceinline__ int crow(int r, int hi) { return (r & 3) + 8 * (r >> 2) + 4 * hi; }

constexpr int AT_BT = 0;
constexpr int AT_K = 2048, AT_V = AT_K + 2 * 16384;
constexpr float ATT_THR = 6.0f;

__device__ __forceinline__ void attn_unit(const Frame& F, const bf16_t* Q, const bf16_t* Kg, const bf16_t* Vg, bf16_t* MIX, float* SSA, const float* relb, int b, int h, int g4) {
    LAS unsigned char* lds = F.lds;
    const int tid = F.tid, lane = F.lane, wid = F.wave, r32 = lane & 31, hi = lane >> 5;
    LAS float* bt = (LAS float*)(lds + AT_BT);
    if (tid < NREL) bt[tid] = relb[h * NREL + tid] * LOG2E;
    const int c = 4 * g4 + (wid >> 1);
    const size_t qrow = (size_t)b * SEQ + 64 * c + 32 * (wid & 1) + r32;
    bf16x8 qf[8];
#pragma unroll
    for (int ks = 0; ks < 8; ++ks) qf[ks] = *(const bf16x8*)(Q + qrow * AW + h * HD + 16 * ks + 8 * hi);
    const int kc_lo = (4 * g4 - LEFT) > 0 ? (4 * g4 - LEFT) : 0, kc_hi = 4 * g4 + 3, nsteps = kc_hi - kc_lo + 1;
    const int srow = tid >> 4, sch = tid & 15;
    const bf16_t* kp = Kg + ((size_t)b * SEQ + (size_t)kc_lo * CHUNK + srow) * AW + h * HD + sch * 8;
    const bf16_t* vp = Vg + ((size_t)b * SEQ + (size_t)kc_lo * CHUNK + srow) * AW + h * HD + sch * 8;
    const unsigned so0 = off_b(srow, sch), so1 = off_b(srow + 32, sch);
    u32x4 sk0, sk1, sv0, sv1;
    sk0 = *(const u32x4*)kp; sk1 = *(const u32x4*)(kp + 32 * AW); sv0 = *(const u32x4*)vp; sv1 = *(const u32x4*)(vp + 32 * AW);
    unsigned ka[8];
#pragma unroll
    for (int ks = 0; ks < 8; ++ks) ka[ks] = off_b(r32, 2 * ks + hi);
    const unsigned blk = (lane >> 4) & 1, q4 = (lane & 15) >> 2, p4 = lane & 3;
    unsigned va[4][2];
#pragma unroll
    for (int dt = 0; dt < 4; ++dt)
#pragma unroll
        for (int tp = 0; tp < 2; ++tp) va[dt][tp] = off_b(4 * hi + q4 + 8 * tp, 4 * dt + 2 * blk + (p4 >> 1)) + 8 * (p4 & 1);
    float m_run = -1e30f, l_run = 0.f;
    f32x16 o[4];
#pragma unroll
    for (int dt = 0; dt < 4; ++dt) o[dt] = (f32x16){};
    const int qin = 32 * (wid & 1) + r32;
    for (int s = 0; s < nsteps; ++s) {
        const int kc = kc_lo + s, buf = s & 1;
        LAS unsigned char* Kb = lds + AT_K + buf * 16384; LAS unsigned char* Vb = lds + AT_V + buf * 16384;
        *(LAS u32x4*)(Kb + so0) = sk0; *(LAS u32x4*)(Kb + so1) = sk1; *(LAS u32x4*)(Vb + so0) = sv0; *(LAS u32x4*)(Vb + so1) = sv1;
        if (s + 1 < nsteps) { kp += (size_t)CHUNK * AW; vp += (size_t)CHUNK * AW;
            sk0 = *(const u32x4*)kp; sk1 = *(const u32x4*)(kp + 32 * AW); sv0 = *(const u32x4*)vp; sv1 = *(const u32x4*)(vp + 32 * AW); }
        LDS_WAIT(); __builtin_amdgcn_s_barrier(); asm volatile("" ::: "memory");
        const int delta = c - kc;
        if (delta >= 0 && delta <= LEFT) {
#pragma unroll
            for (int t = 0; t < 2; ++t) {
                f32x16 sc = (f32x16){};
#pragma unroll
                for (int ks = 0; ks < 8; ++ks) { const bf16x8 kf = *(const LAS bf16x8*)(Kb + ka[ks] + t * 8192); sc = __builtin_amdgcn_mfma_f32_32x32x16_bf16(kf, qf[ks], sc, 0, 0, 0); }
                if (delta >= 3) { const float bc = bt[2 * MAXREL];
#pragma unroll
                    for (int r = 0; r < 16; ++r) sc[r] += bc;
                } else { const int lb = 64 * delta + qin - 32 * t - 4 * hi + MAXREL;
#pragma unroll
                    for (int r = 0; r < 16; ++r) { int idx = lb - ((r & 3) + 8 * (r >> 2)); idx = idx > 2 * MAXREL ? 2 * MAXREL : idx; sc[r] += bt[idx]; } }
                float tm = sc[0];
#pragma unroll
                for (int r = 1; r < 16; ++r) tm = fmaxf(tm, sc[r]);
                tm = fmaxf(tm, __shfl_xor(tm, 32));
                if (!__all(tm <= m_run + ATT_THR)) {
                    const float mn = fmaxf(m_run, tm), al = __builtin_amdgcn_exp2f(m_run - mn); m_run = mn; l_run *= al;
#pragma unroll
                    for (int dt = 0; dt < 4; ++dt) o[dt] = o[dt] * al;
                }
                float ps = 0.f;
#pragma unroll
                for (int r = 0; r < 16; ++r) { sc[r] = __builtin_amdgcn_exp2f(sc[r] - m_run); ps += sc[r]; }
                l_run += ps;
                bf16x8 pb[2];
#pragma unroll
                for (int s2 = 0; s2 < 2; ++s2) { u32x4 w; w.x = cvtpk(sc[8 * s2 + 0], sc[8 * s2 + 1]); w.y = cvtpk(sc[8 * s2 + 2], sc[8 * s2 + 3]); w.z = cvtpk(sc[8 * s2 + 4], sc[8 * s2 + 5]); w.w = cvtpk(sc[8 * s2 + 6], sc[8 * s2 + 7]); pb[s2] = __builtin_bit_cast(bf16x8, w); }
#pragma unroll
                for (int dt = 0; dt < 4; ++dt)
#pragma unroll
                    for (int s2 = 0; s2 < 2; ++s2) {
                        const v4i16_t lo = vtr(Vb + va[dt][0] + (32 * t + 16 * s2) * 256), hh = vtr(Vb + va[dt][1] + (32 * t + 16 * s2) * 256);
                        const bf16x8 vf = (bf16x8){lo[0], lo[1], lo[2], lo[3], hh[0], hh[1], hh[2], hh[3]};
                        o[dt] = __builtin_amdgcn_mfma_f32_32x32x16_bf16(vf, pb[s2], o[dt], 0, 0, 0);
                    }
            }
        }
    }
    const float lt = l_run + __shfl_xor(l_run, 32), inv = 1.0f / lt;
    float ss = 0.f;
    bf16_t* orow = MIX + blk_off(qrow, h * HD, DM);
#pragma unroll
    for (int dt = 0; dt < 4; ++dt)
#pragma unroll
        for (int rg = 0; rg < 4; ++rg) {
            const float a0 = o[dt][4 * rg] * inv, a1 = o[dt][4 * rg + 1] * inv, a2 = o[dt][4 * rg + 2] * inv, a3 = o[dt][4 * rg + 3] * inv;
            ss += (a0 * a0 + a1 * a1) + (a2 * a2 + a3 * a3);
            u32x2 w; w.x = cvtpk(a0, a1); w.y = cvtpk(a2, a3);
            *(u32x2*)(orow + (dt >> 1) * 16384 + 32 * (dt & 1) + 8 * rg + 4 * hi) = w;
        }
    ss += __shfl_xor(ss, 32);
    if (hi == 0) SSA[qrow * 8 + h] = ss;
    LDS_WAIT(); __builtin_amdgcn_s_barrier(); asm volatile("" ::: "memory");
}

__device__ __forceinline__ void gmlp_unit(const Frame& F, const bf16_t* U, const bf16_t* ZN, const bf16_t* WSP, const float* bsp, bf16_t* MIX, float* SSG, int b, int nb, int g) {
    LAS unsigned char* lds = F.lds + AT_K;
    const int tid = F.tid, lane = F.lane, wid = F.wave, r32 = lane & 31, hi = lane >> 5;
    const size_t row0 = (size_t)b * SEQ + 128 * nb;
#pragma unroll
    for (int i = 0; i < 4; ++i) { const int n = tid + 512 * i, row = n >> 4, ch = n & 15;
        const u32x4 v = *(const u32x4*)(ZN + (row0 + row) * AW + g * HD + ch * 8); *(LAS u32x4*)(lds + off_b(row, ch)) = v; }
    const int tt = wid & 3, chh = wid >> 2;
    const int trow = 32 * tt + r32;
    const bf16_t* wrow = WSP + ((size_t)g * 128 + trow) * 128 + 8 * hi;
    const int nks = tt < 2 ? 4 : 8;
    LDS_WAIT(); __builtin_amdgcn_s_barrier(); asm volatile("" ::: "memory");
    const unsigned blk = (lane >> 4) & 1, q4 = (lane & 15) >> 2, p4 = lane & 3;
    f32x16 acc[2]; acc[0] = (f32x16){}; acc[1] = (f32x16){};
    for (int ks = 0; ks < nks; ++ks) {
        const bf16x8 wf = *(const bf16x8*)(wrow + 16 * ks);
#pragma unroll
        for (int c2 = 0; c2 < 2; ++c2) { const int ct = 2 * chh + c2;
            const v4i16_t lo = vtr(lds + off_b(16 * ks + 8 * hi + q4, 4 * ct + 2 * blk + (p4 >> 1)) + 8 * (p4 & 1));
            const v4i16_t hh = vtr(lds + off_b(16 * ks + 8 * hi + 4 + q4, 4 * ct + 2 * blk + (p4 >> 1)) + 8 * (p4 & 1));
            const bf16x8 zf = (bf16x8){lo[0], lo[1], lo[2], lo[3], hh[0], hh[1], hh[2], hh[3]};
            acc[c2] = __builtin_amdgcn_mfma_f32_32x32x16_bf16(zf, wf, acc[c2], 0, 0, 0); }
    }
    const float bs = bsp[g * 128 + trow];
    const size_t grow = row0 + trow;
    float ss = 0.f;
#pragma unroll
    for (int c2 = 0; c2 < 2; ++c2)
#pragma unroll
        for (int rg = 0; rg < 4; ++rg) { const int c0 = 32 * (2 * chh + c2) + 8 * rg + 4 * hi;
            const u32x2 uu = *(const u32x2*)(U + grow * AW + g * HD + c0);
            const float o0 = bf2f((unsigned short)(uu.x & 0xffff)) * (acc[c2][4 * rg] + bs), o1 = bf2f((unsigned short)(uu.x >> 16)) * (acc[c2][4 * rg + 1] + bs);
            const float o2 = bf2f((unsigned short)(uu.y & 0xffff)) * (acc[c2][4 * rg + 2] + bs), o3 = bf2f((unsigned short)(uu.y >> 16)) * (acc[c2][4 * rg + 3] + bs);
            ss += (o0 * o0 + o1 * o1) + (o2 * o2 + o3 * o3);
            u32x2 w; w.x = cvtpk(o0, o1); w.y = cvtpk(o2, o3);
            *(u32x2*)(MIX + blk_off(grow, AW + g * HD + c0, DM)) = w; }
    ss += __shfl_xor(ss, 32);
    if (hi == 0) SSG[grow * 16 + g * 2 + chh] = ss;
    LDS_WAIT(); __builtin_amdgcn_s_barrier(); asm volatile("" ::: "memory");
}

constexpr int NPH = 8;
__global__ void __launch_bounds__(512, 2) mk_fwd(Args args) {
    extern __shared__ __attribute__((aligned(16))) unsigned char lds_raw[];
    Frame F;
    F.lds = (LAS unsigned char*)lds_raw;
    F.tid = threadIdx.x; F.lane = F.tid & 63; F.wave = __builtin_amdgcn_readfirstlane(F.tid >> 6);
    F.G = gridDim.x; { const int bx = blockIdx.x; F.vcu = (F.G % 8 == 0) ? (bx % 8) * (F.G / 8) + bx / 8 : bx; }
    unsigned char* ws = args.ws;
    unsigned* ctl = (unsigned*)(ws + WS_CTL);
    for (int u = F.tid; u < (LDS_BYTES - LDSCTL_OFF) / 4; u += 512) ((LAS unsigned*)(F.lds + LDSCTL_OFF))[u] = 0u;
    __syncthreads();
    XcdBarrier bar; bar.bar = ctl + 4096; bar.x = 0; bar.st = nullptr;
    if (MK_N_LAUNCHES == 1) bar = xcd_barrier_post(ctl + 4096, (volatile LAS unsigned*)(F.lds + MISC_OFF) + 8);
    const int lo = args.ph_lo, hi = args.ph_hi;
#ifndef MK_PHASE_MASK
#define MK_PHASE_MASK 255
#endif
#define IN(k) (((MK_PHASE_MASK >> (k)) & 1) && lo <= (k) && (k) < hi)
#ifndef MK_REP_MASK
#define MK_REP_MASK 0
#endif
#define REP(k) for (int rep_ = 0; rep_ < 1 + ((MK_REP_MASK >> (k)) & 1); ++rep_)
#define SEAM(k) do { if (IN(k) && IN((k) + 1)) xcd_barrier(bar); } while (0)

    const float* x = args.in[0]; const float* cnd = args.in[1]; const float* w_ada = args.in[2]; const float* b_ada = args.in[3]; const float* mix_g = args.in[4];
    const float* w_in = args.in[5]; const float* q_g = args.in[6]; const float* k_g = args.in[7]; const float* relb = args.in[8]; const float* gm_g = args.in[9];
    const float* w_sp = args.in[10]; const float* b_sp = args.in[11]; const float* ao_g = args.in[12]; const float* go_g = args.in[13]; const float* w_out = args.in[14];
    const float* ff_g = args.in[15]; const float* w_f1 = args.in[16]; const float* w_f2 = args.in[17];
    float* out = args.out;
    float* MOD = (float*)(ws + WS_MOD); float* SSA = (float*)(ws + WS_SSA); float* SSG = (float*)(ws + WS_SSG);
    bf16_t* WSP = (bf16_t*)(ws + WS_WSP); bf16_t* WIN = (bf16_t*)(ws + WS_WIN); bf16_t* WOUT = (bf16_t*)(ws + WS_WOUT); bf16_t* WF1 = (bf16_t*)(ws + WS_WF1); bf16_t* WF2 = (bf16_t*)(ws + WS_WF2);
    bf16_t* H = (bf16_t*)(ws + WS_H); bf16_t* QB = (bf16_t*)(ws + WS_Q); bf16_t* KB = (bf16_t*)(ws + WS_K); bf16_t* VB = (bf16_t*)(ws + WS_V); bf16_t* UB = (bf16_t*)(ws + WS_U); bf16_t* ZB = (bf16_t*)(ws + WS_ZN);
    bf16_t* MIX = (bf16_t*)(ws + WS_MIX); bf16_t* ACT = (bf16_t*)(ws + WS_ACT); bf16_t* X1 = (bf16_t*)(ws + WS_X1);
    const int gw = F.vcu * 8 + F.wave, NGW = F.G * 8;

    if (IN(0)) REP(0) { p0_ada(F, cnd, w_ada, b_ada, MOD); }
    SEAM(0);

    if (IN(1)) REP(1) {
        constexpr int I_IN = (DM / 64) * (INW / 32), I_OUT = (DM / 64) * (DM / 32), I_F1 = (DM / 64) * (DFF / 32), I_F2 = (DFF / 64) * (DM / 32), I_SP = 64;
        constexpr int NITEMS = I_IN + I_OUT + I_F1 + I_F2 + I_SP;
        for (int it = gw; it < NITEMS; it += NGW) {
            int r = it;
            if (r < I_IN) { p1_transpose_item(w_in, DM, INW, WIN, r, F.lane, nullptr, nullptr); continue; } r -= I_IN;
            if (r < I_OUT) { p1_transpose_item(w_out, DM, DM, WOUT, r, F.lane, ao_g, go_g); continue; } r -= I_OUT;
            if (r < I_F1) { p1_transpose_item(w_f1, DM, DFF, WF1, r, F.lane, nullptr, nullptr); continue; } r -= I_F1;
            if (r < I_F2) { p1_transpose_item(w_f2, DFF, DM, WF2, r, F.lane, nullptr, nullptr); continue; } r -= I_F2;
#pragma unroll
            for (int i = 0; i < 8; ++i) { const int e = r * 2048 + (i * 64 + F.lane) * 4, t = (e >> 7) & 127, s = e & 127;
                f32x4 v = *(const f32x4*)(w_sp + e); if ((t >> 6) < (s >> 6)) v = (f32x4){0.f, 0.f, 0.f, 0.f};
                u32x2 w; w.x = cvtpk(v[0], v[1]); w.y = cvtpk(v[2], v[3]); *(u32x2*)(WSP + e) = w; }
        }
        for (int m = gw; m < MROWS; m += NGW) { const float* mb = MOD + (size_t)(m >> 11) * NMOD;
            norm_mod_row(x + (size_t)m * DM, mix_g, mb, mb + DM, H, m, F.lane); }
    }
    SEAM(1);

    if (IN(2)) REP(2) {
        pg8::Gemm g{H, WIN, MROWS, INW, DM}; pg8::StaticOrder S; S.init(MROWS, INW, F.G, (int)blockIdx.x, 8);
        pg8::EpiProj E{QB, (size_t)(WS_K - WS_Q) / 2, q_g, k_g, gm_g, (LAS float*)(F.lds + XCH_OFF)};
        pg8::gemm_phase<pg8::EpiProj, pg8::StaticOrder>(F.lds, g, S, E);
    }
    SEAM(2);

    if (IN(3)) REP(3) {
        for (int u = F.vcu; u < NBATCH * NH * 8; u += F.G) { const int g4 = u & 7, h = (u >> 3) & 7, b = u >> 6;
            attn_unit(F, QB, KB, VB, MIX, SSA, relb, b, h, g4); }
        for (int u = F.vcu; u < NBATCH * 16 * 8; u += F.G) { const int g = u & 7, nb = (u >> 3) & 15, b = u >> 7;
            gmlp_unit(F, UB, ZB, WSP, b_sp, MIX, SSG, b, nb, g); }
    }
    SEAM(3);

    if (IN(4)) REP(4) {
        pg8::Gemm g{MIX, WOUT, MROWS, DM, DM}; pg8::StaticOrder S; S.init(MROWS, DM, F.G, (int)blockIdx.x, 4);
        pg8::EpiRes1 E{x, X1, MOD, SSA, SSG, (LAS float*)(F.lds + XCH_OFF)};
        { pg8::Unit uu; for (int i = F.tid >> 8; i < 4 && S.next(i, uu); i += 2) E.fill(uu, i, F.tid & 255); }
        __syncthreads();
        pg8::gemm_phase<pg8::EpiRes1, pg8::StaticOrder>(F.lds, g, S, E);
    }
    SEAM(4);

    if (IN(5)) REP(5) {
        for (int m = gw; m < MROWS; m += NGW) { const float* mb = MOD + (size_t)(m >> 11) * NMOD;
            norm_mod_row_bf(X1 + (size_t)m * DM, ff_g, mb + 3 * DM, mb + 4 * DM, H, m, F.lane); }
    }
    SEAM(5);

    if (IN(6)) REP(6) {
        pg8::Gemm g{H, WF1, MROWS, DFF, DM}; pg8::StaticOrder S; S.init(MROWS, DFF, F.G, (int)blockIdx.x, 8);
        pg8::EpiRelu2 E{ACT, DFF};
        pg8::gemm_phase<pg8::EpiRelu2, pg8::StaticOrder>(F.lds, g, S, E);
    }
    SEAM(6);

    if (IN(7)) REP(7) {
        pg8::Gemm g{ACT, WF2, MROWS, DM, DFF}; pg8::StaticOrder S; S.init(MROWS, DM, F.G, (int)blockIdx.x, 4);
        pg8::EpiRes2 E{X1, out, MOD};
        pg8::gemm_phase<pg8::EpiRes2, pg8::StaticOrder>(F.lds, g, S, E);
    }
#undef IN
#undef SEAM
}

extern "C" void kernel_launch(void* const* d_in, const int* in_sizes, int n_in, void* d_out, int out_size, void* d_ws, size_t ws_size, hipStream_t stream) {
    static int grid = 0;
    if (grid == 0) {
        if (n_in != 18 || in_sizes[0] != MROWS * DM || out_size != MROWS * DM || ws_size < WS_END) {
            fprintf(stderr, "kernel_launch: unexpected shapes (n_in %d, in0 %d, out %d, ws %zu); nothing launched\n", n_in, n_in > 0 ? in_sizes[0] : -1, out_size, ws_size); grid = -1; return; }
        int dev = 0, cus = 0, per_cu = 0;
        if (hipGetDevice(&dev) != hipSuccess || hipDeviceGetAttribute(&cus, hipDeviceAttributeMultiprocessorCount, dev) != hipSuccess) { fprintf(stderr, "kernel_launch: device query failed\n"); grid = -1; return; }
        if (hipFuncSetAttribute((const void*)mk_fwd, hipFuncAttributeMaxDynamicSharedMemorySize, LDS_BYTES) != hipSuccess) { fprintf(stderr, "kernel_launch: hipFuncSetAttribute failed\n"); grid = -1; return; }
        if (hipOccupancyMaxActiveBlocksPerMultiprocessor(&per_cu, (const void*)mk_fwd, 512, LDS_BYTES) != hipSuccess || per_cu < 1) {
            fprintf(stderr, "kernel_launch: occupancy query reports %d workgroups per CU\n", per_cu); per_cu = 1; }
        (void)hipGetLastError();
        grid = cus;
    }
    if (grid < 0) return;
    (void)hipMemsetAsync((char*)d_ws + WS_CTL, 0, CTL_ZERO_BYTES, stream);
    Args a{};
    for (int i = 0; i < 18; ++i) a.in[i] = (const float*)d_in[i];
    a.out = (float*)d_out; a.ws = (unsigned char*)d_ws;
#ifndef MK_PROG
#define MK_PROG {0, 1, 2, 3, 4, 5, 6, 7}
#endif
    static const int prog[] = MK_PROG; const int nprog = (MK_N_LAUNCHES == 1) ? 1 : (int)(sizeof(prog) / sizeof(prog[0]));
    for (int li = 0; li < nprog; ++li) {
        if (MK_N_LAUNCHES == 1) { a.ph_lo = 0; a.ph_hi = NPH; } else { a.ph_lo = prog[li]; a.ph_hi = prog[li] + 1; }
        a.li = li;
        hipLaunchKernelGGL(mk_fwd, dim3(grid), dim3(512), LDS_BYTES, stream, a);
        const hipError_t le = hipPeekAtLastError();
        if (le != hipSuccess) { fprintf(stderr, "kernel_launch: launch %d failed: %s\n", li, hipGetErrorName(le)); break; }
    }
}
```

```cpp
#include <hip/hip_runtime.h>
#include <cstdio>
#include <cstdint>

#ifndef MK_N_LAUNCHES
#define MK_N_LAUNCHES 1
#endif

#ifndef MK_SP2
#define MK_SP2 1
#endif
#ifndef MK_ALIGN
#define MK_ALIGN true
#endif
#define LAS __attribute__((address_space(3)))
#define GAS __attribute__((address_space(1)))
typedef unsigned short bf16_t;
typedef short bf16x8 __attribute__((ext_vector_type(8)));
typedef short v4i16_t __attribute__((ext_vector_type(4)));
typedef float f32x4 __attribute__((ext_vector_type(4)));
typedef float f32x2 __attribute__((ext_vector_type(2)));
typedef float f32x16 __attribute__((ext_vector_type(16)));
typedef unsigned u32x4 __attribute__((ext_vector_type(4)));
typedef unsigned u32x2 __attribute__((ext_vector_type(2)));
typedef __bf16 bf16x2_t __attribute__((ext_vector_type(2)));

constexpr int DM = 2048, NBATCH = 8, SEQ = 2048, MROWS = NBATCH * SEQ;
constexpr int AW = 1024, NH = 8, HD = 128, INW = 5120, DFF = 8192, NMOD = 6 * DM;
constexpr int CHUNK = 64, LEFT = 8, MAXREL = 128, NREL = 2 * MAXREL + 1;
constexpr float EPS = 1e-6f;
constexpr float LOG2E = 1.4426950408889634f;
constexpr float QSCALE = 0.08838834764831845f * LOG2E;

constexpr size_t MiB = 1u << 20;
constexpr size_t WS_CTL = 0, CTL_ZERO_BYTES = 64 * 1024;
constexpr size_t WS_MOD = 1 * MiB;
constexpr size_t WS_SSA = 2 * MiB;
constexpr size_t WS_SSG = 3 * MiB;
constexpr size_t WS_WSP = 6 * MiB;
constexpr size_t WS_WIN = 8 * MiB, WS_WOUT = 28 * MiB, WS_WF1 = 36 * MiB, WS_WF2 = 68 * MiB;
constexpr size_t WS_H = 100 * MiB;
constexpr size_t WS_Q = 164 * MiB, WS_K = 196 * MiB, WS_V = 228 * MiB, WS_U = 260 * MiB, WS_ZN = 292 * MiB;
constexpr size_t WS_MIX = 324 * MiB;
constexpr size_t WS_ACT = 164 * MiB;
constexpr size_t WS_X1 = 420 * MiB;
constexpr size_t WS_END = 484 * MiB;

constexpr int RING_BYTES = 131072;
constexpr int XCH_OFF = RING_BYTES;
constexpr int LDSCTL_OFF = RING_BYTES + 8192, MISC_OFF = LDSCTL_OFF + 320;
constexpr int LDS_BYTES = 147456;

__device__ __forceinline__ unsigned cvtpk(float lo, float hi) { f32x2 v = {lo, hi}; bf16x2_t b = __builtin_convertvector(v, bf16x2_t); return __builtin_bit_cast(unsigned, b); }
__device__ __forceinline__ float bf2f(unsigned short h) { return __uint_as_float((unsigned)h << 16); }
__device__ __forceinline__ float wave_sum(float v) {
#pragma unroll
    for (int o = 1; o < 64; o <<= 1) v += __shfl_xor(v, o);
    return v;
}
__device__ __forceinline__ f32x2 gelu_pk(f32x2 v) {
    const f32x2 av = __builtin_elementwise_abs(v), d = av * 0.2316418882f + 1.0f;
    f32x2 t; t.x = __builtin_amdgcn_rcpf(d.x); t.y = __builtin_amdgcn_rcpf(d.y);
    f32x2 q = t * 0.5307027145f + (-0.7265760135f); q = q * t + 0.7107068705f; q = q * t + (-0.142248368f); q = q * t + 0.127414796f; q = q * t;
    const f32x2 s = (v * v) * (-0.72134752044f);
    f32x2 e; e.x = __builtin_amdgcn_exp2f(s.x); e.y = __builtin_amdgcn_exp2f(s.y);
    const f32x2 m = v * (q * e), r = v - m;
    f32x2 o; o.x = v.x < 0.f ? m.x : r.x; o.y = v.y < 0.f ? m.y : r.y; return o;
}
__device__ __forceinline__ f32x4 gelu4(f32x4 v) { const f32x2 a = gelu_pk((f32x2){v[0], v[1]}), b = gelu_pk((f32x2){v[2], v[3]}); return (f32x4){a.x, a.y, b.x, b.y}; }

__host__ __device__ __forceinline__ size_t blk_off(size_t row, int k, int K) { return (row >> 8) * ((size_t)256 * K) + (size_t)(k >> 6) * 16384 + (row & 255) * 64 + (k & 63); }

namespace pg8 {
constexpr int BM = 256, BK = 64, HALF = 128, HTB = HALF * BK * 2, STAGE_BYTES = 8 * HTB, NXCD = 8;
__host__ __device__ __forceinline__ int lds_byte(int r, int c) { return r * 128 + ((((c >> 3) ^ (r >> 1)) & 7) << 4) + (c & 7) * 2; }
__host__ __device__ __forceinline__ void stage_rc(int b, int& R, int& C) { R = b >> 7; C = ((((b >> 4) & 7) ^ (R >> 1)) & 7) * 8; }
__host__ __device__ __forceinline__ int perm32(int rho) { const int n = rho >> 4, i = rho & 15; return 8 * (i >> 2) + 4 * n + (i & 3); }

struct Unit { int pm, pn; };
struct Gemm { const bf16_t* A; const bf16_t* Bt; int M, N, K; };

struct StaticOrder {
    int nM, nN, nwg, G, c, WGM;
    __device__ void init(int M, int N, int G_, int c_, int wgm) { nM = M / BM; nN = N / BM; nwg = nM * nN; G = G_; c = c_; WGM = wgm; }
    __device__ bool next(int i, Unit& u) const {
        const long L = (long)i * G + c; if (L >= nwg) return false;
        int wgid = (int)L; { const int q = nwg / NXCD, r = nwg % NXCD, xcd = wgid % NXCD, off = wgid / NXCD; wgid = (xcd < r ? xcd * (q + 1) : r * (q + 1) + (xcd - r) * q) + off; }
        const int nig = WGM * nN, gid = wgid / nig, fm = gid * WGM, gsz = (nM - fm) < WGM ? (nM - fm) : WGM;
        u.pm = fm + ((wgid % nig) % gsz); u.pn = (wgid % nig) / gsz; return true;
    }
};

#define PG8_BARRIER() do { asm volatile("s_waitcnt lgkmcnt(0)" ::: "memory"); __builtin_amdgcn_s_barrier(); asm volatile("" ::: "memory"); } while (0)

struct EpiProj {
    static constexpr bool PERM = true, HOOKS = false, ALIGN = true; static constexpr int MIDT = 0;
    bf16_t* base;
    size_t tstride;
    const float *qg, *kg, *zg;
    LAS float* xch;
    __device__ __forceinline__ void begin(const Unit&, int, int) const {}
    __device__ __forceinline__ void mid(f32x4 (&)[2][2][4][2], int, int, int) const {}
    __device__ __forceinline__ void operator()(f32x4 (&acc)[2][2][4][2], const Unit& u, int ui, int wr, int wc, int fr, int fq) const {
        const int type = u.pn >> 2, colt = (u.pn & 3) * 256;
        bf16_t* O = base + (size_t)type * tstride;
        const int row0 = u.pm * BM + wr * 64 + fr, col0 = colt + wc * 32 + 8 * fq;
        if (type >= 3) {
#pragma unroll
            for (int ai = 0; ai < 2; ++ai)
#pragma unroll
                for (int bj = 0; bj < 2; ++bj)
#pragma unroll
                    for (int m = 0; m < 4; ++m)
#pragma unroll
                        for (int n = 0; n < 2; ++n) acc[ai][bj][m][n] = gelu4(acc[ai][bj][m][n]);
        }
        if (type == 0 || type == 1 || type == 4) {
#pragma unroll
            for (int ai = 0; ai < 2; ++ai)
#pragma unroll
                for (int m = 0; m < 4; ++m)
#pragma unroll
                    for (int bj = 0; bj < 2; ++bj) {
                        const f32x4 a = acc[ai][bj][m][0], b = acc[ai][bj][m][1];
                        float s = (a[0] * a[0] + a[1] * a[1]) + (a[2] * a[2] + a[3] * a[3]) + (b[0] * b[0] + b[1] * b[1]) + (b[2] * b[2] + b[3] * b[3]);
                        s += __shfl_xor(s, 16); s += __shfl_xor(s, 32);
                        if (fq == 0) xch[((ai * HALF + wr * 64 + m * 16 + fr) * 2 + bj) * 4 + wc] = s;
                    }
            PG8_BARRIER();
            const float* gp = type == 0 ? qg : (type == 1 ? kg : zg + (u.pn & 3) * 256);
            const float sc = type == 0 ? QSCALE : 1.0f;
            f32x4 gv[2][2];
#pragma unroll
            for (int bj = 0; bj < 2; ++bj)
#pragma unroll
                for (int n = 0; n < 2; ++n) gv[bj][n] = *(const f32x4*)(gp + (type == 4 ? bj * 128 : 0) + wc * 32 + 8 * fq + 4 * n) * sc;
#pragma unroll
            for (int ai = 0; ai < 2; ++ai)
#pragma unroll
                for (int m = 0; m < 4; ++m)
#pragma unroll
                    for (int bj = 0; bj < 2; ++bj) {
                        const f32x4 p = *(const LAS f32x4*)(xch + ((ai * HALF + wr * 64 + m * 16 + fr) * 2 + bj) * 4);
                        const float rinv = 1.0f / sqrtf(((p[0] + p[1]) + (p[2] + p[3])) * (1.0f / 128.0f) + EPS);
                        acc[ai][bj][m][0] = acc[ai][bj][m][0] * rinv * gv[bj][0]; acc[ai][bj][m][1] = acc[ai][bj][m][1] * rinv * gv[bj][1];
                    }
        }
#pragma unroll
        for (int ai = 0; ai < 2; ++ai)
#pragma unroll
            for (int m = 0; m < 4; ++m) { bf16_t* rowp = O + (size_t)(row0 + ai * HALF + m * 16) * AW + col0;
#pragma unroll
                for (int bj = 0; bj < 2; ++bj) { const f32x4 v0 = acc[ai][bj][m][0], v1 = acc[ai][bj][m][1];
                    u32x4 w; w.x = cvtpk(v0[0], v0[1]); w.y = cvtpk(v0[2], v0[3]); w.z = cvtpk(v1[0], v1[1]); w.w = cvtpk(v1[2], v1[3]);
                    *(u32x4*)(rowp + bj * HALF) = w; } }
    }
};

struct EpiRes1 {
    static constexpr bool PERM = true, HOOKS = true, ALIGN = MK_ALIGN; static constexpr int MIDT = 16;
    const float* x; bf16_t* x1; const float* mod;
    const float *ssa, *ssg;
    LAS float* rt;
    __device__ __forceinline__ void begin(const Unit&, int, int) const {}
    __device__ __forceinline__ void fill(const Unit& u, int ui, int row) const {
        const size_t gr = (size_t)u.pm * BM + row;
        const f32x4 a0 = *(const f32x4*)(ssa + gr * 8), a1 = *(const f32x4*)(ssa + gr * 8 + 4);
        const float sa = ((a0[0] + a0[1]) + (a0[2] + a0[3])) + ((a1[0] + a1[1]) + (a1[2] + a1[3]));
        const f32x4 a = *(const f32x4*)(ssg + gr * 16), b = *(const f32x4*)(ssg + gr * 16 + 4), c = *(const f32x4*)(ssg + gr * 16 + 8), d = *(const f32x4*)(ssg + gr * 16 + 12);
        const float sg = (((a[0] + a[1]) + (a[2] + a[3])) + ((b[0] + b[1]) + (b[2] + b[3]))) + (((c[0] + c[1]) + (c[2] + c[3])) + ((d[0] + d[1]) + (d[2] + d[3])));
        const float ra = 1.0f / sqrtf(sa * (1.0f / 1024.0f) + EPS), rg = 1.0f / sqrtf(sg * (1.0f / 1024.0f) + EPS);
        *(LAS f32x2*)(rt + ((ui & 3) * 256 + row) * 2) = (f32x2){ra / rg, rg};
    }
    __device__ __forceinline__ void mid(f32x4 (&acc)[2][2][4][2], int ui, int wr, int fr) const {
#pragma unroll
        for (int ai = 0; ai < 2; ++ai)
#pragma unroll
            for (int m = 0; m < 4; ++m) { const float f = rt[((ui & 3) * 256 + ai * HALF + wr * 64 + m * 16 + fr) * 2];
#pragma unroll
                for (int bj = 0; bj < 2; ++bj)
#pragma unroll
                    for (int n = 0; n < 2; ++n) acc[ai][bj][m][n] = acc[ai][bj][m][n] * f; }
    }
    __device__ __forceinline__ void operator()(f32x4 (&acc)[2][2][4][2], const Unit& u, int ui, int wr, int wc, int fr, int fq) const {
        const int row0 = u.pm * BM + wr * 64 + fr, col0 = u.pn * BM + wc * 32 + 8 * fq;
        const float* gp = mod + (size_t)(u.pm >> 3) * NMOD + 2 * DM + col0;
        f32x4 gv[2][2];
#pragma unroll
        for (int bj = 0; bj < 2; ++bj)
#pragma unroll
            for (int n = 0; n < 2; ++n) gv[bj][n] = *(const f32x4*)(gp + bj * HALF + n * 4);
#pragma unroll
        for (int ai = 0; ai < 2; ++ai)
#pragma unroll
            for (int m = 0; m < 4; ++m) { const size_t off = (size_t)(row0 + ai * HALF + m * 16) * DM + col0;
                const float rg = rt[((ui & 3) * 256 + ai * HALF + wr * 64 + m * 16 + fr) * 2 + 1];
#pragma unroll
                for (int bj = 0; bj < 2; ++bj) {
                    const f32x4 x0 = *(const f32x4*)(x + off + bj * HALF), xb = *(const f32x4*)(x + off + bj * HALF + 4);
                    const f32x4 v0 = x0 + gv[bj][0] * (acc[ai][bj][m][0] * rg), v1 = xb + gv[bj][1] * (acc[ai][bj][m][1] * rg);
                    u32x4 w; w.x = cvtpk(v0[0], v0[1]); w.y = cvtpk(v0[2], v0[3]); w.z = cvtpk(v1[0], v1[1]); w.w = cvtpk(v1[2], v1[3]);
                    *(u32x4*)(x1 + off + bj * HALF) = w; } }
    }
};

struct EpiRelu2 {
    static constexpr bool PERM = true, HOOKS = false, ALIGN = MK_ALIGN; static constexpr int MIDT = 0;
    bf16_t* O; int ldc;
    __device__ __forceinline__ void begin(const Unit&, int, int) const {}
    __device__ __forceinline__ void mid(f32x4 (&)[2][2][4][2], int, int, int) const {}
    __device__ __forceinline__ void operator()(f32x4 (&acc)[2][2][4][2], const Unit& u, int ui, int wr, int wc, int fr, int fq) const {
        const int row0 = u.pm * BM + wr * 64 + fr, col0 = u.pn * BM + wc * 32 + 8 * fq;
#pragma unroll
        for (int ai = 0; ai < 2; ++ai)
#pragma unroll
            for (int m = 0; m < 4; ++m) { bf16_t* rowp = O + blk_off((size_t)(row0 + ai * HALF + m * 16), col0, ldc);
#pragma unroll
                for (int bj = 0; bj < 2; ++bj) { f32x4 v0 = acc[ai][bj][m][0], v1 = acc[ai][bj][m][1];
                    v0 = __builtin_elementwise_max(v0, (f32x4){0.f, 0.f, 0.f, 0.f}); v1 = __builtin_elementwise_max(v1, (f32x4){0.f, 0.f, 0.f, 0.f}); v0 = v0 * v0; v1 = v1 * v1;
                    u32x4 w; w.x = cvtpk(v0[0], v0[1]); w.y = cvtpk(v0[2], v0[3]); w.z = cvtpk(v1[0], v1[1]); w.w = cvtpk(v1[2], v1[3]);
                    *(u32x4*)(rowp + bj * 2 * 16384) = w; } }
    }
};

struct EpiRes2 {
    static constexpr bool PERM = false, HOOKS = false, ALIGN = MK_ALIGN; static constexpr int MIDT = 0;
    const bf16_t* x1; float* out; const float* mod;
    __device__ __forceinline__ void begin(const Unit&, int, int) const {}
    __device__ __forceinline__ void mid(f32x4 (&)[2][2][4][2], int, int, int) const {}
    __device__ __forceinline__ void operator()(f32x4 (&acc)[2][2][4][2], const Unit& u, int ui, int wr, int wc, int fr, int fq) const {
        const int row0 = u.pm * BM + wr * 64 + fr, col0 = u.pn * BM + wc * 32 + 4 * fq;
        const float* gp = mod + (size_t)(u.pm >> 3) * NMOD + 5 * DM + col0;
        f32x4 gv[2][2];
#pragma unroll
        for (int bj = 0; bj < 2; ++bj)
#pragma unroll
            for (int n = 0; n < 2; ++n) gv[bj][n] = *(const f32x4*)(gp + bj * HALF + n * 16);
#pragma unroll
        for (int ai = 0; ai < 2; ++ai)
#pragma unroll
            for (int m = 0; m < 4; ++m) { const size_t off = (size_t)(row0 + ai * HALF + m * 16) * DM + col0;
#pragma unroll
                for (int bj = 0; bj < 2; ++bj)
#pragma unroll
                    for (int n = 0; n < 2; ++n) { const u32x2 xr = *(const u32x2*)(x1 + off + bj * HALF + n * 16);
                        const f32x4 xv = (f32x4){__uint_as_float(xr.x << 16), __uint_as_float(xr.x & 0xffff0000u), __uint_as_float(xr.y << 16), __uint_as_float(xr.y & 0xffff0000u)};
                        *(f32x4*)(out + off + bj * HALF + n * 16) = xv + gv[bj][n] * acc[ai][bj][m][n]; } }
    }
};

template <class Epi, class Sched>
__device__ __forceinline__ void gemm_phase(LAS unsigned char* lds, const Gemm g, const Sched& S, const Epi& E) {
    const int tid = threadIdx.x, wid = __builtin_amdgcn_readfirstlane(tid >> 6), lane = tid & 63, wr = wid >> 2, wc = wid & 3, fr = lane & 15, fq = lane >> 4;
    const int K = g.K, nt = K / BK;
    unsigned voffA[2], voffB[2];
#pragma unroll
    for (int i = 0; i < 2; ++i) { int R, C; stage_rc(tid * 16 + i * 8192, R, C); const int Rb = Epi::PERM ? ((R & ~31) + perm32(R & 31)) : R;
        voffA[i] = (unsigned)(R * 64 + C) * 2u; voffB[i] = (unsigned)(Rb * 64 + C) * 2u; }
    const size_t kstep = (size_t)(256 * BK * 2);
    const size_t hstep = (size_t)HALF * BK * 2;
    const size_t tstep = (size_t)256 * K * 2;
    const unsigned ldsw = (unsigned)wid * 1024u;
    const int aoff[2] = {lds_byte(wr * 64 + fr, fq * 8), lds_byte(wr * 64 + fr, 32 + fq * 8)}, boff[2] = {lds_byte(wc * 32 + fr, fq * 8), lds_byte(wc * 32 + fr, 32 + fq * 8)};
#define PG8_SA(b, h) (((b) * 2 + (h)) * HTB)
#define PG8_SB(b, h) ((4 + (b) * 2 + (h)) * HTB)
#define PG8_STAGE(bufoff, gbase, voff) do { _Pragma("unroll") for (int _i = 0; _i < 2; ++_i) \
        __builtin_amdgcn_global_load_lds((const unsigned*)((const char*)(gbase) + (voff)[_i]), (LAS unsigned*)(lds + (bufoff) + ldsw + _i * 8192), 16, 0, 0); } while (0)
#define PG8_LDA(dst, b, h) do { _Pragma("unroll") for (int m = 0; m < 4; ++m) _Pragma("unroll") for (int k = 0; k < 2; ++k) dst[m][k] = *(const LAS bf16x8*)(lds + PG8_SA(b, h) + aoff[k] + m * 2048); } while (0)
#define PG8_LDB(dst, b, h) do { _Pragma("unroll") for (int n = 0; n < 2; ++n) _Pragma("unroll") for (int k = 0; k < 2; ++k) dst[n][k] = *(const LAS bf16x8*)(lds + PG8_SB(b, h) + boff[k] + n * 2048); } while (0)
#define PG8_MMA(ai, bj, At, Bt) do { __builtin_amdgcn_s_setprio(1); _Pragma("unroll") for (int m = 0; m < 4; ++m) _Pragma("unroll") for (int n = 0; n < 2; ++n) _Pragma("unroll") for (int k = 0; k < 2; ++k) \
        acc[ai][bj][m][n] = __builtin_amdgcn_mfma_f32_16x16x32_bf16(Bt[n][k], At[m][k], acc[ai][bj][m][n], 0, 0, 0); __builtin_amdgcn_s_setprio(0); } while (0)
#define PG8_WAIT_V(n) asm volatile("s_waitcnt vmcnt(" #n ")" ::: "memory")
#define PG8_WAIT_L(n) asm volatile("s_waitcnt lgkmcnt(" #n ")" ::: "memory")
#define PG8_BAR __builtin_amdgcn_s_barrier()
#define PG8_SCHED __builtin_amdgcn_sched_barrier(0)
    Unit cur, nxt; int ui = 0;
    if (!S.next(0, cur)) return;
    f32x4 acc[2][2][4][2];
#pragma unroll
    for (int a = 0; a < 2; ++a)
#pragma unroll
        for (int b = 0; b < 2; ++b)
#pragma unroll
            for (int m = 0; m < 4; ++m)
#pragma unroll
                for (int n = 0; n < 2; ++n) acc[a][b][m][n] = (f32x4){0.f, 0.f, 0.f, 0.f};
    bf16x8 At[4][2], B0[2][2], B1[2][2];
    const char* cA = (const char*)g.A + (size_t)cur.pm * tstep; const char* cB = (const char*)g.Bt + (size_t)cur.pn * tstep;
#if MK_SP2
    PG8_STAGE(PG8_SB(0, 0), cB, voffB); PG8_STAGE(PG8_SB(0, 1), cB + hstep, voffB); PG8_STAGE(PG8_SA(0, 0), cA, voffA); PG8_STAGE(PG8_SA(0, 1), cA + hstep, voffA);
    if (wr == 1) PG8_BAR;
    PG8_WAIT_V(2); PG8_BAR;
    PG8_STAGE(PG8_SB(1, 0), cB + kstep, voffB); PG8_STAGE(PG8_SA(1, 0), cA + kstep, voffA); PG8_STAGE(PG8_SB(1, 1), cB + hstep + kstep, voffB);
    PG8_WAIT_V(6); PG8_BAR;
#else
    PG8_STAGE(PG8_SB(0, 0), cB, voffB); PG8_STAGE(PG8_SA(0, 0), cA, voffA); PG8_STAGE(PG8_SB(0, 1), cB + hstep, voffB); PG8_STAGE(PG8_SA(0, 1), cA + hstep, voffA);
    if (wr == 1) PG8_BAR;
    PG8_WAIT_V(4); PG8_BAR;
    PG8_STAGE(PG8_SB(1, 0), cB + kstep, voffB); PG8_STAGE(PG8_SA(1, 0), cA + kstep, voffA); PG8_STAGE(PG8_SB(1, 1), cB + hstep + kstep, voffB);
    PG8_WAIT_V(6); PG8_BAR;
#endif
    for (;;) {
        const bool has_next = S.next(ui + 1, nxt);
        const char* nA = has_next ? (const char*)g.A + (size_t)nxt.pm * tstep : cA; const char* nB = has_next ? (const char*)g.Bt + (size_t)nxt.pn * tstep : cB;
        for (int t = 0; t < nt; t += 2) {
            const bool last = (t == nt - 2);
            const char* a1 = cA + (size_t)(t + 1) * kstep;
            const char* a2 = last ? nA : cA + (size_t)(t + 2) * kstep; const char* b2 = last ? nB : cB + (size_t)(t + 2) * kstep;
            const char* a3 = a2 + kstep; const char* b3 = b2 + kstep;
            if constexpr (Epi::HOOKS) { if (t == Epi::MIDT) E.mid(acc, ui, wr, fr); }
#if MK_SP2
            PG8_LDB(B0, 0, 0); PG8_LDB(B1, 0, 1); PG8_SCHED; PG8_LDA(At, 0, 0); PG8_STAGE(PG8_SA(1, 1), a1 + hstep, voffA);
            PG8_WAIT_V(8); PG8_WAIT_L(0); PG8_BAR; PG8_MMA(0, 0, At, B0); PG8_MMA(0, 1, At, B1); PG8_BAR; PG8_SCHED;
            PG8_LDA(At, 0, 1); PG8_STAGE(PG8_SB(0, 0), b2, voffB); PG8_STAGE(PG8_SB(0, 1), b2 + hstep, voffB); PG8_STAGE(PG8_SA(0, 0), a2, voffA);
            PG8_WAIT_V(8); PG8_WAIT_L(0); PG8_BAR; PG8_MMA(1, 0, At, B0); PG8_MMA(1, 1, At, B1); PG8_BAR; PG8_SCHED;
            PG8_LDB(B0, 1, 0); PG8_LDB(B1, 1, 1); PG8_SCHED; PG8_LDA(At, 1, 0); PG8_STAGE(PG8_SA(0, 1), a2 + hstep, voffA);
            PG8_WAIT_V(8); PG8_WAIT_L(0); PG8_BAR; PG8_MMA(0, 0, At, B0); PG8_MMA(0, 1, At, B1); PG8_BAR; PG8_SCHED;
            PG8_LDA(At, 1, 1); PG8_STAGE(PG8_SB(1, 0), b3, voffB); PG8_STAGE(PG8_SB(1, 1), b3 + hstep, voffB); PG8_STAGE(PG8_SA(1, 0), a3, voffA);
            PG8_WAIT_V(8); PG8_WAIT_L(0); PG8_BAR; PG8_MMA(1, 0, At, B0); PG8_MMA(1, 1, At, B1); PG8_BAR; PG8_SCHED;
#else
            PG8_LDB(B0, 0, 0); PG8_SCHED; PG8_LDA(At, 0, 0); PG8_STAGE(PG8_SA(1, 1), a1 + hstep, voffA);
            PG8_WAIT_L(8); PG8_BAR; PG8_WAIT_L(0); PG8_MMA(0, 0, At, B0); PG8_BAR; PG8_SCHED;
            PG8_LDB(B1, 0, 1); PG8_STAGE(PG8_SB(0, 0), b2, voffB);
            PG8_BAR; PG8_WAIT_L(0); PG8_MMA(0, 1, At, B1); PG8_BAR;
            PG8_LDA(At, 0, 1); PG8_STAGE(PG8_SA(0, 0), a2, voffA);
            PG8_BAR; PG8_WAIT_L(0); PG8_MMA(1, 0, At, B0); PG8_BAR; PG8_SCHED;
            PG8_STAGE(PG8_SB(0, 1), b2 + hstep, voffB);
            PG8_WAIT_V(6); PG8_BAR; PG8_MMA(1, 1, At, B1); PG8_BAR;
            PG8_LDB(B0, 1, 0); PG8_SCHED; PG8_LDA(At, 1, 0); PG8_STAGE(PG8_SA(0, 1), a2 + hstep, voffA);
            PG8_WAIT_L(8); PG8_BAR; PG8_WAIT_L(0); PG8_MMA(0, 0, At, B0); PG8_BAR; PG8_SCHED;
            PG8_LDB(B1, 1, 1); PG8_STAGE(PG8_SB(1, 0), b3, voffB);
            PG8_BAR; PG8_WAIT_L(0); PG8_MMA(0, 1, At, B1); PG8_BAR;
            PG8_LDA(At, 1, 1); PG8_STAGE(PG8_SA(1, 0), a3, voffA);
            PG8_BAR; PG8_WAIT_L(0); PG8_MMA(1, 0, At, B0); PG8_BAR; PG8_SCHED;
            PG8_STAGE(PG8_SB(1, 1), b3 + hstep, voffB);
            PG8_WAIT_V(6); PG8_BAR; PG8_MMA(1, 1, At, B1); PG8_BAR;
#endif
        }
        if constexpr (Epi::ALIGN) { if (wr == 0) PG8_BAR; }
        E(acc, cur, ui, wr, wc, fr, fq);
        if (!has_next) break;
#pragma unroll
        for (int a = 0; a < 2; ++a)
#pragma unroll
            for (int b = 0; b < 2; ++b)
#pragma unroll
                for (int m = 0; m < 4; ++m)
#pragma unroll
                    for (int n = 0; n < 2; ++n) acc[a][b][m][n] = (f32x4){0.f, 0.f, 0.f, 0.f};
        cur = nxt; cA = nA; cB = nB; ++ui;
        if constexpr (Epi::ALIGN) { if (wr == 1) PG8_BAR; }
    }
    PG8_WAIT_V(0);
    if constexpr (!Epi::ALIGN) { if (wr == 0) PG8_BAR; }
    PG8_BAR;
#undef PG8_SA
#undef PG8_SB
#undef PG8_STAGE
#undef PG8_LDA
#undef PG8_LDB
#undef PG8_MMA
#undef PG8_WAIT_V
#undef PG8_WAIT_L
#undef PG8_BAR
#undef PG8_SCHED
}
}

typedef GAS unsigned gu32;
#define RLX_AGENT __ATOMIC_RELAXED, __HIP_MEMORY_SCOPE_AGENT
#define XB_TMO      128
#define XB_XCNT(j)  (256  + 64 * (j))
#define XB_XSUB(j)  (1280 + 64 * (j))
#define XB_XGEN(j)  (2304 + 64 * (j))
#define XB_TOP      3328
#define XB_TOPGEN   3392
#define XCD_BAR_WORDS 3456
#define XB_SPIN_CAP (1u << 20)
__device__ __forceinline__ unsigned xb_ld(unsigned* p)              { return __hip_atomic_load(p, __ATOMIC_RELAXED, __HIP_MEMORY_SCOPE_AGENT); }
__device__ __forceinline__ unsigned xb_add(unsigned* p, unsigned v) { return __hip_atomic_fetch_add(p, v, __ATOMIC_RELAXED, __HIP_MEMORY_SCOPE_AGENT); }
__device__ __forceinline__ unsigned xb_xcc_id() { return (unsigned)__builtin_amdgcn_s_getreg((3 << 11) | 20) & 0xFu; }
#define XB_SPIN(cond, bar) do { unsigned _sp = 0; while (cond) { __builtin_amdgcn_s_sleep(1); \
    if ((++_sp & 255u) == 0u) { if (xb_ld(&(bar)[XB_TMO])) break; if (_sp > XB_SPIN_CAP) { atomicAdd(&(bar)[XB_TMO], 1u); break; } } } } while (0)
struct XcdBarrier { unsigned* bar; unsigned x; volatile LAS unsigned* st; };
__device__ __forceinline__ XcdBarrier xcd_barrier_post(unsigned* bar, volatile LAS unsigned* st) {
    XcdBarrier b; b.bar = bar; b.x = xb_xcc_id(); b.st = st;
    if (threadIdx.x == 0) (void)xb_add(&bar[XB_XCNT(b.x)], 1u);
    return b;
}
__device__ __forceinline__ void xcd_barrier_complete(unsigned* bar, unsigned x, unsigned& nloc, unsigned& nx) {
    const unsigned G = gridDim.x * gridDim.y * gridDim.z;
    unsigned sum, cnt, mine, sp = 0u;
    for (;;) {
        sum = 0u; cnt = 0u; mine = 0u;
#pragma unroll
        for (unsigned j = 0; j < 16; ++j) { const unsigned c = xb_ld(&bar[XB_XCNT(j)]); sum += c; cnt += (c > 0u) ? 1u : 0u; mine = (j == x) ? c : mine; }
        if (sum == G) break;
        __builtin_amdgcn_s_sleep(1);
        if ((++sp & 255u) == 0u) { if (xb_ld(&bar[XB_TMO])) break; if (sp > XB_SPIN_CAP) { atomicAdd(&bar[XB_TMO], 1u); break; } }
    }
    nloc = mine > 0u ? mine : 1u; nx = cnt > 0u ? cnt : 1u;
}
__device__ __forceinline__ void xcd_barrier(const XcdBarrier& b) {
    asm volatile("s_waitcnt vmcnt(0)" ::: "memory");
    __syncthreads();
    if (threadIdx.x == 0) {
        unsigned* bar = b.bar;
        __builtin_amdgcn_s_waitcnt(0);
        unsigned nloc = b.st[0], nx = b.st[1];
        if (nloc == 0u) { xcd_barrier_complete(bar, b.x, nloc, nx); b.st[0] = nloc; b.st[1] = nx; }
        const unsigned old = xb_add(&bar[XB_XSUB(b.x)], 1u);
        const unsigned gen = old / nloc;
        if (old + 1u == (gen + 1u) * nloc) {
            __builtin_amdgcn_fence(__ATOMIC_RELEASE, "agent");
            asm volatile("s_waitcnt vmcnt(0)" ::: "memory");
            const unsigned og = xb_add(&bar[XB_TOP], 1u);
            const unsigned tg = og / nx;
            if (og + 1u == (tg + 1u) * nx) xb_add(&bar[XB_TOPGEN], 1u);
            else XB_SPIN(xb_ld(&bar[XB_TOPGEN]) == tg, bar);
            __builtin_amdgcn_fence(__ATOMIC_ACQUIRE, "agent");
            xb_add(&bar[XB_XGEN(b.x)], 1u);
            asm volatile("s_waitcnt vmcnt(0)" ::: "memory");
        } else {
            XB_SPIN(xb_ld(&bar[XB_XGEN(b.x)]) == gen, bar);
            __builtin_amdgcn_fence(__ATOMIC_ACQUIRE, "agent");
            asm volatile("s_waitcnt vmcnt(0)" ::: "memory");
        }
    }
    __syncthreads();
}

struct Args { const float* in[18]; float* out; unsigned char* ws; int ph_lo, ph_hi, li, pad; };
struct Frame {
    LAS unsigned char* lds;
    int tid, lane, wave, vcu, G;
};
#define LDS_WAIT() asm volatile("s_waitcnt lgkmcnt(0)" ::: "memory")

__device__ __forceinline__ void p0_ada(const Frame& F, const float* c, const float* w_ada, const float* b_ada, float* mod) {
    LAS float* sc = (LAS float*)F.lds;
    LAS float* part = (LAS float*)(F.lds + 65536);
    for (int i = F.tid; i < NBATCH * DM; i += 512) { const int b = i >> 11, k = i & 2047; const float v = c[i]; sc[k * 8 + b] = v / (1.0f + __expf(-v)); }
    __syncthreads();
    const int kk = F.lane / 12, c4 = F.lane % 12;
    for (int item = blockIdx.x; item < 256; item += F.G) {
        const int n0 = 48 * item, kb = 256 * F.wave;
        f32x4 acc[8];
#pragma unroll
        for (int b = 0; b < 8; ++b) acc[b] = (f32x4){0.f, 0.f, 0.f, 0.f};
        if (F.lane < 60) {
            const float* wp = w_ada + (size_t)(kb + kk) * NMOD + n0 + 4 * c4;
#pragma unroll 17
            for (int i = 0; i < 51; ++i) {
                const int k = kb + kk + 5 * i;
                const f32x4 w = *(const f32x4*)(wp + (size_t)(5 * i) * NMOD);
                const f32x4 s0 = *(const LAS f32x4*)(sc + k * 8), s1 = *(const LAS f32x4*)(sc + k * 8 + 4);
                acc[0] += w * s0[0]; acc[1] += w * s0[1]; acc[2] += w * s0[2]; acc[3] += w * s0[3];
                acc[4] += w * s1[0]; acc[5] += w * s1[1]; acc[6] += w * s1[2]; acc[7] += w * s1[3];
            }
            if (kk == 0) {
                const int k = kb + 255;
                const f32x4 w = *(const f32x4*)(w_ada + (size_t)k * NMOD + n0 + 4 * c4);
                const f32x4 s0 = *(const LAS f32x4*)(sc + k * 8), s1 = *(const LAS f32x4*)(sc + k * 8 + 4);
                acc[0] += w * s0[0]; acc[1] += w * s0[1]; acc[2] += w * s0[2]; acc[3] += w * s0[3];
                acc[4] += w * s1[0]; acc[5] += w * s1[1]; acc[6] += w * s1[2]; acc[7] += w * s1[3];
            }
#pragma unroll
            for (int b = 0; b < 8; ++b) *(LAS f32x4*)(part + (F.wave * 5 + kk) * 384 + b * 48 + 4 * c4) = acc[b];
        }
        __syncthreads();
        if (F.tid < 384) { float s = 0.f;
#pragma unroll 8
            for (int j = 0; j < 40; ++j) s += part[j * 384 + F.tid];
            const int b = F.tid / 48, n = F.tid % 48; mod[(size_t)b * NMOD + n0 + n] = s + b_ada[n0 + n]; }
        __syncthreads();
    }
}

__device__ __forceinline__ void p1_transpose_item(const float* W, int K, int N, bf16_t* WT, int item, int lane, const float* ks0, const float* ks1) {
    const int nblk = N / 32, kb = item / nblk, nb = item % nblk, k0 = 64 * kb, n0 = 32 * nb, lc = lane & 7, lr = lane >> 3;
    const float* wp = W + (size_t)(k0 + 8 * lr) * N + n0 + 4 * lc;
    f32x4 v[8];
#pragma unroll
    for (int i = 0; i < 8; ++i) v[i] = *(const f32x4*)(wp + (size_t)i * N);
    if (ks0) { const int k = k0 + 8 * lr; const float* kp = k < 1024 ? ks0 + k : ks1 + (k - 1024); const f32x4 s0 = *(const f32x4*)kp, s1 = *(const f32x4*)(kp + 4);
        v[0] = v[0] * s0[0]; v[1] = v[1] * s0[1]; v[2] = v[2] * s0[2]; v[3] = v[3] * s0[3]; v[4] = v[4] * s1[0]; v[5] = v[5] * s1[1]; v[6] = v[6] * s1[2]; v[7] = v[7] * s1[3]; }
    bf16_t* op = WT + blk_off((size_t)(n0 + 4 * lc), k0 + 8 * lr, K);
#pragma unroll
    for (int e = 0; e < 4; ++e) { u32x4 o; o.x = cvtpk(v[0][e], v[1][e]); o.y = cvtpk(v[2][e], v[3][e]); o.z = cvtpk(v[4][e], v[5][e]); o.w = cvtpk(v[6][e], v[7][e]);
        *(u32x4*)(op + e * 64) = o; }
}
__device__ __forceinline__ void norm_mod_row(const float* xrow, const float* g, const float* shift, const float* scale, bf16_t* Hb, int m, int lane) {
    const f32x4* xr = (const f32x4*)xrow + lane;
    f32x4 v[8]; float s = 0.f;
#pragma unroll
    for (int j = 0; j < 8; ++j) { v[j] = xr[64 * j]; s += (v[j][0] * v[j][0] + v[j][1] * v[j][1]) + (v[j][2] * v[j][2] + v[j][3] * v[j][3]); }
    const float rinv = 1.0f / sqrtf(wave_sum(s) * (1.0f / DM) + EPS);
    bf16_t* ob = Hb + blk_off((size_t)m, 4 * lane, DM);
#pragma unroll
    for (int j = 0; j < 8; ++j) { const f32x4 gg = ((const f32x4*)g)[lane + 64 * j], sc = ((const f32x4*)scale)[lane + 64 * j], sh = ((const f32x4*)shift)[lane + 64 * j];
        const f32x4 o = (v[j] * rinv) * gg * (sc + 1.0f) + sh; u32x2 w; w.x = cvtpk(o[0], o[1]); w.y = cvtpk(o[2], o[3]); *(u32x2*)(ob + (size_t)j * 4 * 16384) = w; }
}
__device__ __forceinline__ void norm_mod_row_bf(const bf16_t* xrow, const float* g, const float* shift, const float* scale, bf16_t* Hb, int m, int lane) {
    const u32x4* xr = (const u32x4*)xrow + lane;
    f32x4 v[4][2]; float s = 0.f;
#pragma unroll
    for (int j = 0; j < 4; ++j) { const u32x4 r = xr[64 * j];
        v[j][0] = (f32x4){__uint_as_float(r.x << 16), __uint_as_float(r.x & 0xffff0000u), __uint_as_float(r.y << 16), __uint_as_float(r.y & 0xffff0000u)};
        v[j][1] = (f32x4){__uint_as_float(r.z << 16), __uint_as_float(r.z & 0xffff0000u), __uint_as_float(r.w << 16), __uint_as_float(r.w & 0xffff0000u)};
#pragma unroll
        for (int e = 0; e < 2; ++e) s += (v[j][e][0] * v[j][e][0] + v[j][e][1] * v[j][e][1]) + (v[j][e][2] * v[j][e][2] + v[j][e][3] * v[j][e][3]); }
    const float rinv = 1.0f / sqrtf(wave_sum(s) * (1.0f / DM) + EPS);
    bf16_t* ob = Hb + blk_off((size_t)m, 8 * lane, DM);
#pragma unroll
    for (int j = 0; j < 4; ++j) { u32x4 w;
#pragma unroll
        for (int e = 0; e < 2; ++e) { const int ci = 2 * lane + 128 * j + e;
            const f32x4 gg = ((const f32x4*)g)[ci], sc = ((const f32x4*)scale)[ci], sh = ((const f32x4*)shift)[ci];
            const f32x4 o = (v[j][e] * rinv) * gg * (sc + 1.0f) + sh; if (e == 0) { w.x = cvtpk(o[0], o[1]); w.y = cvtpk(o[2], o[3]); } else { w.z = cvtpk(o[0], o[1]); w.w = cvtpk(o[2], o[3]); } }
        *(u32x4*)(ob + (size_t)j * 8 * 16384) = w; }
}

__device__ __forceinline__ unsigned off_b(unsigned row, unsigned ch) { return 256u * row + 16u * (ch ^ (((row & 3) << 2) | ((row >> 2) & 3))); }
__device__ __forceinline__ v4i16_t vtr(LAS unsigned char* p) { return __builtin_amdgcn_ds_read_tr16_b64_v4i16((LAS v4i16_t*)p); }
__device__ __forceinline__ int crow(int r, int hi) { return (r & 3) + 8 * (r >> 2) + 4 * hi; }

constexpr int AT_BT = 0;
constexpr int AT_K = 2048, AT_V = AT_K + 2 * 16384;
constexpr float ATT_THR = 6.0f;

__device__ __forceinline__ void attn_unit(const Frame& F, const bf16_t* Q, const bf16_t* Kg, const bf16_t* Vg, bf16_t* MIX, float* SSA, const float* relb, int b, int h, int g4) {
    LAS unsigned char* lds = F.lds;
    const int tid = F.tid, lane = F.lane, wid = F.wave, r32 = lane & 31, hi = lane >> 5;
    LAS float* bt = (LAS float*)(lds + AT_BT);
    if (tid < NREL) bt[tid] = relb[h * NREL + tid] * LOG2E;
    const int c = 4 * g4 + (wid >> 1);
    const size_t qrow = (size_t)b * SEQ + 64 * c + 32 * (wid & 1) + r32;
    bf16x8 qf[8];
#pragma unroll
    for (int ks = 0; ks < 8; ++ks) qf[ks] = *(const bf16x8*)(Q + qrow * AW + h * HD + 16 * ks + 8 * hi);
    const int kc_lo = (4 * g4 - LEFT) > 0 ? (4 * g4 - LEFT) : 0, kc_hi = 4 * g4 + 3, nsteps = kc_hi - kc_lo + 1;
    const int srow = tid >> 4, sch = tid & 15;
    const bf16_t* kp = Kg + ((size_t)b * SEQ + (size_t)kc_lo * CHUNK + srow) * AW + h * HD + sch * 8;
    const bf16_t* vp = Vg + ((size_t)b * SEQ + (size_t)kc_lo * CHUNK + srow) * AW + h * HD + sch * 8;
    const unsigned so0 = off_b(srow, sch), so1 = off_b(srow + 32, sch);
    u32x4 sk0, sk1, sv0, sv1;
    sk0 = *(const u32x4*)kp; sk1 = *(const u32x4*)(kp + 32 * AW); sv0 = *(const u32x4*)vp; sv1 = *(const u32x4*)(vp + 32 * AW);
    unsigned ka[8];
#pragma unroll
    for (int ks = 0; ks < 8; ++ks) ka[ks] = off_b(r32, 2 * ks + hi);
    const unsigned blk = (lane >> 4) & 1, q4 = (lane & 15) >> 2, p4 = lane & 3;
    unsigned va[4][2];
#pragma unroll
    for (int dt = 0; dt < 4; ++dt)
#pragma unroll
        for (int tp = 0; tp < 2; ++tp) va[dt][tp] = off_b(4 * hi + q4 + 8 * tp, 4 * dt + 2 * blk + (p4 >> 1)) + 8 * (p4 & 1);
    float m_run = -1e30f, l_run = 0.f;
    f32x16 o[4];
#pragma unroll
    for (int dt = 0; dt < 4; ++dt) o[dt] = (f32x16){};
    const int qin = 32 * (wid & 1) + r32;
    for (int s = 0; s < nsteps; ++s) {
        const int kc = kc_lo + s, buf = s & 1;
        LAS unsigned char* Kb = lds + AT_K + buf * 16384; LAS unsigned char* Vb = lds + AT_V + buf * 16384;
        *(LAS u32x4*)(Kb + so0) = sk0; *(LAS u32x4*)(Kb + so1) = sk1; *(LAS u32x4*)(Vb + so0) = sv0; *(LAS u32x4*)(Vb + so1) = sv1;
        if (s + 1 < nsteps) { kp += (size_t)CHUNK * AW; vp += (size_t)CHUNK * AW;
            sk0 = *(const u32x4*)kp; sk1 = *(const u32x4*)(kp + 32 * AW); sv0 = *(const u32x4*)vp; sv1 = *(const u32x4*)(vp + 32 * AW); }
        LDS_WAIT(); __builtin_amdgcn_s_barrier(); asm volatile("" ::: "memory");
        const int delta = c - kc;
        if (delta >= 0 && delta <= LEFT) {
#pragma unroll
            for (int t = 0; t < 2; ++t) {
                f32x16 sc = (f32x16){};
#pragma unroll
                for (int ks = 0; ks < 8; ++ks) { const bf16x8 kf = *(const LAS bf16x8*)(Kb + ka[ks] + t * 8192); sc = __builtin_amdgcn_mfma_f32_32x32x16_bf16(kf, qf[ks], sc, 0, 0, 0); }
                if (delta >= 3) { const float bc = bt[2 * MAXREL];
#pragma unroll
                    for (int r = 0; r < 16; ++r) sc[r] += bc;
                } else { const int lb = 64 * delta + qin - 32 * t - 4 * hi + MAXREL;
#pragma unroll
                    for (int r = 0; r < 16; ++r) { int idx = lb - ((r & 3) + 8 * (r >> 2)); idx = idx > 2 * MAXREL ? 2 * MAXREL : idx; sc[r] += bt[idx]; } }
                float tm = sc[0];
#pragma unroll
                for (int r = 1; r < 16; ++r) tm = fmaxf(tm, sc[r]);
                tm = fmaxf(tm, __shfl_xor(tm, 32));
                if (!__all(tm <= m_run + ATT_THR)) {
                    const float mn = fmaxf(m_run, tm), al = __builtin_amdgcn_exp2f(m_run - mn); m_run = mn; l_run *= al;
#pragma unroll
                    for (int dt = 0; dt < 4; ++dt) o[dt] = o[dt] * al;
                }
                float ps = 0.f;
#pragma unroll
                for (int r = 0; r < 16; ++r) { sc[r] = __builtin_amdgcn_exp2f(sc[r] - m_run); ps += sc[r]; }
                l_run += ps;
                bf16x8 pb[2];
#pragma unroll
                for (int s2 = 0; s2 < 2; ++s2) { u32x4 w; w.x = cvtpk(sc[8 * s2 + 0], sc[8 * s2 + 1]); w.y = cvtpk(sc[8 * s2 + 2], sc[8 * s2 + 3]); w.z = cvtpk(sc[8 * s2 + 4], sc[8 * s2 + 5]); w.w = cvtpk(sc[8 * s2 + 6], sc[8 * s2 + 7]); pb[s2] = __builtin_bit_cast(bf16x8, w); }
#pragma unroll
                for (int dt = 0; dt < 4; ++dt)
#pragma unroll
                    for (int s2 = 0; s2 < 2; ++s2) {
                        const v4i16_t lo = vtr(Vb + va[dt][0] + (32 * t + 16 * s2) * 256), hh = vtr(Vb + va[dt][1] + (32 * t + 16 * s2) * 256);
                        const bf16x8 vf = (bf16x8){lo[0], lo[1], lo[2], lo[3], hh[0], hh[1], hh[2], hh[3]};
                        o[dt] = __builtin_amdgcn_mfma_f32_32x32x16_bf16(vf, pb[s2], o[dt], 0, 0, 0);
                    }
            }
        }
    }
    const float lt = l_run + __shfl_xor(l_run, 32), inv = 1.0f / lt;
    float ss = 0.f;
    bf16_t* orow = MIX + blk_off(qrow, h * HD, DM);
#pragma unroll
    for (int dt = 0; dt < 4; ++dt)
#pragma unroll
        for (int rg = 0; rg < 4; ++rg) {
            const float a0 = o[dt][4 * rg] * inv, a1 = o[dt][4 * rg + 1] * inv, a2 = o[dt][4 * rg + 2] * inv, a3 = o[dt][4 * rg + 3] * inv;
            ss += (a0 * a0 + a1 * a1) + (a2 * a2 + a3 * a3);
            u32x2 w; w.x = cvtpk(a0, a1); w.y = cvtpk(a2, a3);
            *(u32x2*)(orow + (dt >> 1) * 16384 + 32 * (dt & 1) + 8 * rg + 4 * hi) = w;
        }
    ss += __shfl_xor(ss, 32);
    if (hi == 0) SSA[qrow * 8 + h] = ss;
    LDS_WAIT(); __builtin_amdgcn_s_barrier(); asm volatile("" ::: "memory");
}

__device__ __forceinline__ void gmlp_unit(const Frame& F, const bf16_t* U, const bf16_t* ZN, const bf16_t* WSP, const float* bsp, bf16_t* MIX, float* SSG, int b, int nb, int g) {
    LAS unsigned char* lds = F.lds + AT_K;
    const int tid = F.tid, lane = F.lane, wid = F.wave, r32 = lane & 31, hi = lane >> 5;
    const size_t row0 = (size_t)b * SEQ + 128 * nb;
#pragma unroll
    for (int i = 0; i < 4; ++i) { const int n = tid + 512 * i, row = n >> 4, ch = n & 15;
        const u32x4 v = *(const u32x4*)(ZN + (row0 + row) * AW + g * HD + ch * 8); *(LAS u32x4*)(lds + off_b(row, ch)) = v; }
    const int tt = wid & 3, chh = wid >> 2;
    const int trow = 32 * tt + r32;
    const bf16_t* wrow = WSP + ((size_t)g * 128 + trow) * 128 + 8 * hi;
    const int nks = tt < 2 ? 4 : 8;
    LDS_WAIT(); __builtin_amdgcn_s_barrier(); asm volatile("" ::: "memory");
    const unsigned blk = (lane >> 4) & 1, q4 = (lane & 15) >> 2, p4 = lane & 3;
    f32x16 acc[2]; acc[0] = (f32x16){}; acc[1] = (f32x16){};
    for (int ks = 0; ks < nks; ++ks) {
        const bf16x8 wf = *(const bf16x8*)(wrow + 16 * ks);
#pragma unroll
        for (int c2 = 0; c2 < 2; ++c2) { const int ct = 2 * chh + c2;
            const v4i16_t lo = vtr(lds + off_b(16 * ks + 8 * hi + q4, 4 * ct + 2 * blk + (p4 >> 1)) + 8 * (p4 & 1));
            const v4i16_t hh = vtr(lds + off_b(16 * ks + 8 * hi + 4 + q4, 4 * ct + 2 * blk + (p4 >> 1)) + 8 * (p4 & 1));
            const bf16x8 zf = (bf16x8){lo[0], lo[1], lo[2], lo[3], hh[0], hh[1], hh[2], hh[3]};
            acc[c2] = __builtin_amdgcn_mfma_f32_32x32x16_bf16(zf, wf, acc[c2], 0, 0, 0); }
    }
    const float bs = bsp[g * 128 + trow];
    const size_t grow = row0 + trow;
    float ss = 0.f;
#pragma unroll
    for (int c2 = 0; c2 < 2; ++c2)
#pragma unroll
        for (int rg = 0; rg < 4; ++rg) { const int c0 = 32 * (2 * chh + c2) + 8 * rg + 4 * hi;
            const u32x2 uu = *(const u32x2*)(U + grow * AW + g * HD + c0);
            const float o0 = bf2f((unsigned short)(uu.x & 0xffff)) * (acc[c2][4 * rg] + bs), o1 = bf2f((unsigned short)(uu.x >> 16)) * (acc[c2][4 * rg + 1] + bs);
            const float o2 = bf2f((unsigned short)(uu.y & 0xffff)) * (acc[c2][4 * rg + 2] + bs), o3 = bf2f((unsigned short)(uu.y >> 16)) * (acc[c2][4 * rg + 3] + bs);
            ss += (o0 * o0 + o1 * o1) + (o2 * o2 + o3 * o3);
            u32x2 w; w.x = cvtpk(o0, o1); w.y = cvtpk(o2, o3);
            *(u32x2*)(MIX + blk_off(grow, AW + g * HD + c0, DM)) = w; }
    ss += __shfl_xor(ss, 32);
    if (hi == 0) SSG[grow * 16 + g * 2 + chh] = ss;
    LDS_WAIT(); __builtin_amdgcn_s_barrier(); asm volatile("" ::: "memory");
}

constexpr int NPH = 8;
__global__ void __launch_bounds__(512, 2) mk_fwd(Args args) {
    extern __shared__ __attribute__((aligned(16))) unsigned char lds_raw[];
    Frame F;
    F.lds = (LAS unsigned char*)lds_raw;
    F.tid = threadIdx.x; F.lane = F.tid & 63; F.wave = __builtin_amdgcn_readfirstlane(F.tid >> 6);
    F.G = gridDim.x; { const int bx = blockIdx.x; F.vcu = (F.G % 8 == 0) ? (bx % 8) * (F.G / 8) + bx / 8 : bx; }
    unsigned char* ws = args.ws;
    unsigned* ctl = (unsigned*)(ws + WS_CTL);
    for (int u = F.tid; u < (LDS_BYTES - LDSCTL_OFF) / 4; u += 512) ((LAS unsigned*)(F.lds + LDSCTL_OFF))[u] = 0u;
    __syncthreads();
    XcdBarrier bar; bar.bar = ctl + 4096; bar.x = 0; bar.st = nullptr;
    if (MK_N_LAUNCHES == 1) bar = xcd_barrier_post(ctl + 4096, (volatile LAS unsigned*)(F.lds + MISC_OFF) + 8);
    const int lo = args.ph_lo, hi = args.ph_hi;
#ifndef MK_PHASE_MASK
#define MK_PHASE_MASK 255
#endif
#define IN(k) (((MK_PHASE_MASK >> (k)) & 1) && lo <= (k) && (k) < hi)
#ifndef MK_REP_MASK
#define MK_REP_MASK 0
#endif
#define REP(k) for (int rep_ = 0; rep_ < 1 + ((MK_REP_MASK >> (k)) & 1); ++rep_)
#define SEAM(k) do { if (IN(k) && IN((k) + 1)) xcd_barrier(bar); } while (0)

    const float* x = args.in[0]; const float* cnd = args.in[1]; const float* w_ada = args.in[2]; const float* b_ada = args.in[3]; const float* mix_g = args.in[4];
    const float* w_in = args.in[5]; const float* q_g = args.in[6]; const float* k_g = args.in[7]; const float* relb = args.in[8]; const float* gm_g = args.in[9];
    const float* w_sp = args.in[10]; const float* b_sp = args.in[11]; const float* ao_g = args.in[12]; const float* go_g = args.in[13]; const float* w_out = args.in[14];
    const float* ff_g = args.in[15]; const float* w_f1 = args.in[16]; const float* w_f2 = args.in[17];
    float* out = args.out;
    float* MOD = (float*)(ws + WS_MOD); float* SSA = (float*)(ws + WS_SSA); float* SSG = (float*)(ws + WS_SSG);
    bf16_t* WSP = (bf16_t*)(ws + WS_WSP); bf16_t* WIN = (bf16_t*)(ws + WS_WIN); bf16_t* WOUT = (bf16_t*)(ws + WS_WOUT); bf16_t* WF1 = (bf16_t*)(ws + WS_WF1); bf16_t* WF2 = (bf16_t*)(ws + WS_WF2);
    bf16_t* H = (bf16_t*)(ws + WS_H); bf16_t* QB = (bf16_t*)(ws + WS_Q); bf16_t* KB = (bf16_t*)(ws + WS_K); bf16_t* VB = (bf16_t*)(ws + WS_V); bf16_t* UB = (bf16_t*)(ws + WS_U); bf16_t* ZB = (bf16_t*)(ws + WS_ZN);
    bf16_t* MIX = (bf16_t*)(ws + WS_MIX); bf16_t* ACT = (bf16_t*)(ws + WS_ACT); bf16_t* X1 = (bf16_t*)(ws + WS_X1);
    const int gw = F.vcu * 8 + F.wave, NGW = F.G * 8;

    if (IN(0)) REP(0) { p0_ada(F, cnd, w_ada, b_ada, MOD); }
    SEAM(0);

    if (IN(1)) REP(1) {
        constexpr int I_IN = (DM / 64) * (INW / 32), I_OUT = (DM / 64) * (DM / 32), I_F1 = (DM / 64) * (DFF / 32), I_F2 = (DFF / 64) * (DM / 32), I_SP = 64;
        constexpr int NITEMS = I_IN + I_OUT + I_F1 + I_F2 + I_SP;
        for (int it = gw; it < NITEMS; it += NGW) {
            int r = it;
            if (r < I_IN) { p1_transpose_item(w_in, DM, INW, WIN, r, F.lane, nullptr, nullptr); continue; } r -= I_IN;
            if (r < I_OUT) { p1_transpose_item(w_out, DM, DM, WOUT, r, F.lane, ao_g, go_g); continue; } r -= I_OUT;
            if (r < I_F1) { p1_transpose_item(w_f1, DM, DFF, WF1, r, F.lane, nullptr, nullptr); continue; } r -= I_F1;
            if (r < I_F2) { p1_transpose_item(w_f2, DFF, DM, WF2, r, F.lane, nullptr, nullptr); continue; } r -= I_F2;
#pragma unroll
            for (int i = 0; i < 8; ++i) { const int e = r * 2048 + (i * 64 + F.lane) * 4, t = (e >> 7) & 127, s = e & 127;
                f32x4 v = *(const f32x4*)(w_sp + e); if ((t >> 6) < (s >> 6)) v = (f32x4){0.f, 0.f, 0.f, 0.f};
                u32x2 w; w.x = cvtpk(v[0], v[1]); w.y = cvtpk(v[2], v[3]); *(u32x2*)(WSP + e) = w; }
        }
        for (int m = gw; m < MROWS; m += NGW) { const float* mb = MOD + (size_t)(m >> 11) * NMOD;
            norm_mod_row(x + (size_t)m * DM, mix_g, mb, mb + DM, H, m, F.lane); }
    }
    SEAM(1);

    if (IN(2)) REP(2) {
        pg8::Gemm g{H, WIN, MROWS, INW, DM}; pg8::StaticOrder S; S.init(MROWS, INW, F.G, (int)blockIdx.x, 4);
        pg8::EpiProj E{QB, (size_t)(WS_K - WS_Q) / 2, q_g, k_g, gm_g, (LAS float*)(F.lds + XCH_OFF)};
        pg8::gemm_phase<pg8::EpiProj, pg8::StaticOrder>(F.lds, g, S, E);
    }
    SEAM(2);

    if (IN(3)) REP(3) {
        for (int u = F.vcu; u < NBATCH * NH * 8; u += F.G) { const int g4 = u & 7, h = (u >> 3) & 7, b = u >> 6;
            attn_unit(F, QB, KB, VB, MIX, SSA, relb, b, h, g4); }
        for (int u = F.vcu; u < NBATCH * 16 * 8; u += F.G) { const int g = u & 7, nb = (u >> 3) & 15, b = u >> 7;
            gmlp_unit(F, UB, ZB, WSP, b_sp, MIX, SSG, b, nb, g); }
    }
    SEAM(3);

    if (IN(4)) REP(4) {
        pg8::Gemm g{MIX, WOUT, MROWS, DM, DM}; pg8::StaticOrder S; S.init(MROWS, DM, F.G, (int)blockIdx.x, 4);
        pg8::EpiRes1 E{x, X1, MOD, SSA, SSG, (LAS float*)(F.lds + XCH_OFF)};
        { pg8::Unit uu; for (int i = F.tid >> 8; i < 4 && S.next(i, uu); i += 2) E.fill(uu, i, F.tid & 255); }
        __syncthreads();
        pg8::gemm_phase<pg8::EpiRes1, pg8::StaticOrder>(F.lds, g, S, E);
    }
    SEAM(4);

    if (IN(5)) REP(5) {
        for (int m = gw; m < MROWS; m += NGW) { const float* mb = MOD + (size_t)(m >> 11) * NMOD;
            norm_mod_row_bf(X1 + (size_t)m * DM, ff_g, mb + 3 * DM, mb + 4 * DM, H, m, F.lane); }
    }
    SEAM(5);

    if (IN(6)) REP(6) {
        pg8::Gemm g{H, WF1, MROWS, DFF, DM}; pg8::StaticOrder S; S.init(MROWS, DFF, F.G, (int)blockIdx.x, 4);
        pg8::EpiRelu2 E{ACT, DFF};
        pg8::gemm_phase<pg8::EpiRelu2, pg8::StaticOrder>(F.lds, g, S, E);
    }
    SEAM(6);

    if (IN(7)) REP(7) {
        pg8::Gemm g{ACT, WF2, MROWS, DM, DFF}; pg8::StaticOrder S; S.init(MROWS, DM, F.G, (int)blockIdx.x, 4);
        pg8::EpiRes2 E{X1, out, MOD};
        pg8::gemm_phase<pg8::EpiRes2, pg8::StaticOrder>(F.lds, g, S, E);
    }
#undef IN
#undef SEAM
}

extern "C" void kernel_launch(void* const* d_in, const int* in_sizes, int n_in, void* d_out, int out_size, void* d_ws, size_t ws_size, hipStream_t stream) {
    static int grid = 0;
    if (grid == 0) {
        if (n_in != 18 || in_sizes[0] != MROWS * DM || out_size != MROWS * DM || ws_size < WS_END) {
            fprintf(stderr, "kernel_launch: unexpected shapes (n_in %d, in0 %d, out %d, ws %zu); nothing launched\n", n_in, n_in > 0 ? in_sizes[0] : -1, out_size, ws_size); grid = -1; return; }
        int dev = 0, cus = 0, per_cu = 0;
        if (hipGetDevice(&dev) != hipSuccess || hipDeviceGetAttribute(&cus, hipDeviceAttributeMultiprocessorCount, dev) != hipSuccess) { fprintf(stderr, "kernel_launch: device query failed\n"); grid = -1; return; }
        if (hipFuncSetAttribute((const void*)mk_fwd, hipFuncAttributeMaxDynamicSharedMemorySize, LDS_BYTES) != hipSuccess) { fprintf(stderr, "kernel_launch: hipFuncSetAttribute failed\n"); grid = -1; return; }
        if (hipOccupancyMaxActiveBlocksPerMultiprocessor(&per_cu, (const void*)mk_fwd, 512, LDS_BYTES) != hipSuccess || per_cu < 1) {
            fprintf(stderr, "kernel_launch: occupancy query reports %d workgroups per CU\n", per_cu); per_cu = 1; }
        (void)hipGetLastError();
        grid = cus;
    }
    if (grid < 0) return;
    (void)hipMemsetAsync((char*)d_ws + WS_CTL, 0, CTL_ZERO_BYTES, stream);
    Args a{};
    for (int i = 0; i < 18; ++i) a.in[i] = (const float*)d_in[i];
    a.out = (float*)d_out; a.ws = (unsigned char*)d_ws;
#ifndef MK_PROG
#define MK_PROG {0, 1, 2, 3, 4, 5, 6, 7}
#endif
    static const int prog[] = MK_PROG; const int nprog = (MK_N_LAUNCHES == 1) ? 1 : (int)(sizeof(prog) / sizeof(prog[0]));
    for (int li = 0; li < nprog; ++li) {
        if (MK_N_LAUNCHES == 1) { a.ph_lo = 0; a.ph_hi = NPH; } else { a.ph_lo = prog[li]; a.ph_hi = prog[li] + 1; }
        a.li = li;
        hipLaunchKernelGGL(mk_fwd, dim3(grid), dim3(512), LDS_BYTES, stream, a);
        const hipError_t le = hipPeekAtLastError();
        if (le != hipSuccess) { fprintf(stderr, "kernel_launch: launch %d failed: %s\n", li, hipGetErrorName(le)); break; }
    }
}
```

```cpp
#include <hip/hip_runtime.h>
#include <cstdio>
#include <cstdint>

#ifndef MK_N_LAUNCHES
#define MK_N_LAUNCHES 1
#endif

#ifndef MK_SP2
#define MK_SP2 1
#endif
#ifndef MK_ALIGN
#define MK_ALIGN true
#endif
#define LAS __attribute__((address_space(3)))
#define GAS __attribute__((address_space(1)))
typedef unsigned short bf16_t;
typedef short bf16x8 __attribute__((ext_vector_type(8)));
typedef short v4i16_t __attribute__((ext_vector_type(4)));
typedef float f32x4 __attribute__((ext_vector_type(4)));
typedef float f32x2 __attribute__((ext_vector_type(2)));
typedef float f32x16 __attribute__((ext_vector_type(16)));
typedef unsigned u32x4 __attribute__((ext_vector_type(4)));
typedef unsigned u32x2 __attribute__((ext_vector_type(2)));
typedef __bf16 bf16x2_t __attribute__((ext_vector_type(2)));

constexpr int DM = 2048, NBATCH = 8, SEQ = 2048, MROWS = NBATCH * SEQ;
constexpr int AW = 1024, NH = 8, HD = 128, INW = 5120, DFF = 8192, NMOD = 6 * DM;
constexpr int CHUNK = 64, LEFT = 8, MAXREL = 128, NREL = 2 * MAXREL + 1;
constexpr float EPS = 1e-6f;
constexpr float LOG2E = 1.4426950408889634f;
constexpr float QSCALE = 0.08838834764831845f * LOG2E;

constexpr size_t MiB = 1u << 20;
constexpr size_t WS_CTL = 0, CTL_ZERO_BYTES = 64 * 1024;
constexpr size_t WS_MOD = 1 * MiB;
constexpr size_t WS_SSA = 2 * MiB;
constexpr size_t WS_SSG = 3 * MiB;
constexpr size_t WS_WSP = 6 * MiB;
constexpr size_t WS_WIN = 8 * MiB, WS_WOUT = 28 * MiB, WS_WF1 = 36 * MiB, WS_WF2 = 68 * MiB;
constexpr size_t WS_H = 100 * MiB;
constexpr size_t WS_Q = 164 * MiB, WS_K = 196 * MiB, WS_V = 228 * MiB, WS_U = 260 * MiB, WS_ZN = 292 * MiB;
constexpr size_t WS_MIX = 324 * MiB;
constexpr size_t WS_ACT = 164 * MiB;
constexpr size_t WS_X1 = 420 * MiB;
constexpr size_t WS_END = 484 * MiB;

constexpr int RING_BYTES = 131072;
constexpr int XCH_OFF = RING_BYTES;
constexpr int LDSCTL_OFF = RING_BYTES + 8192, MISC_OFF = LDSCTL_OFF + 320;
constexpr int LDS_BYTES = 147456;

__device__ __forceinline__ unsigned cvtpk(float lo, float hi) { f32x2 v = {lo, hi}; bf16x2_t b = __builtin_convertvector(v, bf16x2_t); return __builtin_bit_cast(unsigned, b); }
__device__ __forceinline__ float bf2f(unsigned short h) { return __uint_as_float((unsigned)h << 16); }
__device__ __forceinline__ float wave_sum(float v) {
#pragma unroll
    for (int o = 1; o < 64; o <<= 1) v += __shfl_xor(v, o);
    return v;
}
__device__ __forceinline__ f32x2 gelu_pk(f32x2 v) {
    const f32x2 av = __builtin_elementwise_abs(v), d = av * 0.2316418882f + 1.0f;
    f32x2 t; t.x = __builtin_amdgcn_rcpf(d.x); t.y = __builtin_amdgcn_rcpf(d.y);
    f32x2 q = t * 0.5307027145f + (-0.7265760135f); q = q * t + 0.7107068705f; q = q * t + (-0.142248368f); q = q * t + 0.127414796f; q = q * t;
    const f32x2 s = (v * v) * (-0.72134752044f);
    f32x2 e; e.x = __builtin_amdgcn_exp2f(s.x); e.y = __builtin_amdgcn_exp2f(s.y);
    const f32x2 m = v * (q * e), r = v - m;
    f32x2 o; o.x = v.x < 0.f ? m.x : r.x; o.y = v.y < 0.f ? m.y : r.y; return o;
}
__device__ __forceinline__ f32x4 gelu4(f32x4 v) { const f32x2 a = gelu_pk((f32x2){v[0], v[1]}), b = gelu_pk((f32x2){v[2], v[3]}); return (f32x4){a.x, a.y, b.x, b.y}; }

__host__ __device__ __forceinline__ size_t blk_off(size_t row, int k, int K) { return (row >> 8) * ((size_t)256 * K) + (size_t)(k >> 6) * 16384 + (row & 255) * 64 + (k & 63); }

namespace pg8 {
constexpr int BM = 256, BK = 64, HALF = 128, HTB = HALF * BK * 2, STAGE_BYTES = 8 * HTB, NXCD = 8;
__host__ __device__ __forceinline__ int lds_byte(int r, int c) { return r * 128 + ((((c >> 3) ^ (r >> 1)) & 7) << 4) + (c & 7) * 2; }
__host__ __device__ __forceinline__ void stage_rc(int b, int& R, int& C) { R = b >> 7; C = ((((b >> 4) & 7) ^ (R >> 1)) & 7) * 8; }
__host__ __device__ __forceinline__ int perm32(int rho) { const int n = rho >> 4, i = rho & 15; return 8 * (i >> 2) + 4 * n + (i & 3); }

struct Unit { int pm, pn; };
struct Gemm { const bf16_t* A; const bf16_t* Bt; int M, N, K; };

struct StaticOrder {
    int nM, nN, nwg, G, c, WGM;
    __device__ void init(int M, int N, int G_, int c_, int wgm) { nM = M / BM; nN = N / BM; nwg = nM * nN; G = G_; c = c_; WGM = wgm; }
    __device__ bool next(int i, Unit& u) const {
        const long L = (long)i * G + c; if (L >= nwg) return false;
        int wgid = (int)L; { const int q = nwg / NXCD, r = nwg % NXCD, xcd = wgid % NXCD, off = wgid / NXCD; wgid = (xcd < r ? xcd * (q + 1) : r * (q + 1) + (xcd - r) * q) + off; }
        const int nig = WGM * nN, gid = wgid / nig, fm = gid * WGM, gsz = (nM - fm) < WGM ? (nM - fm) : WGM;
        u.pm = fm + ((wgid % nig) % gsz); u.pn = (wgid % nig) / gsz; return true;
    }
};

#define PG8_BARRIER() do { asm volatile("s_waitcnt lgkmcnt(0)" ::: "memory"); __builtin_amdgcn_s_barrier(); asm volatile("" ::: "memory"); } while (0)

struct EpiProj {
    static constexpr bool PERM = true, HOOKS = false, ALIGN = true; static constexpr int MIDT = 0;
    bf16_t* base;
    size_t tstride;
    const float *qg, *kg, *zg;
    LAS float* xch;
    __device__ __forceinline__ void begin(const Unit&, int, int) const {}
    __device__ __forceinline__ void mid(f32x4 (&)[2][2][4][2], int, int, int) const {}
    __device__ __forceinline__ void operator()(f32x4 (&acc)[2][2][4][2], const Unit& u, int ui, int wr, int wc, int fr, int fq) const {
        const int type = u.pn >> 2, colt = (u.pn & 3) * 256;
        bf16_t* O = base + (size_t)type * tstride;
        const int row0 = u.pm * BM + wr * 64 + fr, col0 = colt + wc * 32 + 8 * fq;
        if (type >= 3) {
#pragma unroll
            for (int ai = 0; ai < 2; ++ai)
#pragma unroll
                for (int bj = 0; bj < 2; ++bj)
#pragma unroll
                    for (int m = 0; m < 4; ++m)
#pragma unroll
                        for (int n = 0; n < 2; ++n) acc[ai][bj][m][n] = gelu4(acc[ai][bj][m][n]);
        }
        if (type == 0 || type == 1 || type == 4) {
#pragma unroll
            for (int ai = 0; ai < 2; ++ai)
#pragma unroll
                for (int m = 0; m < 4; ++m)
#pragma unroll
                    for (int bj = 0; bj < 2; ++bj) {
                        const f32x4 a = acc[ai][bj][m][0], b = acc[ai][bj][m][1];
                        float s = (a[0] * a[0] + a[1] * a[1]) + (a[2] * a[2] + a[3] * a[3]) + (b[0] * b[0] + b[1] * b[1]) + (b[2] * b[2] + b[3] * b[3]);
                        s += __shfl_xor(s, 16); s += __shfl_xor(s, 32);
                        if (fq == 0) xch[((ai * HALF + wr * 64 + m * 16 + fr) * 2 + bj) * 4 + wc] = s;
                    }
            PG8_BARRIER();
            const float* gp = type == 0 ? qg : (type == 1 ? kg : zg + (u.pn & 3) * 256);
            const float sc = type == 0 ? QSCALE : 1.0f;
            f32x4 gv[2][2];
#pragma unroll
            for (int bj = 0; bj < 2; ++bj)
#pragma unroll
                for (int n = 0; n < 2; ++n) gv[bj][n] = *(const f32x4*)(gp + (type == 4 ? bj * 128 : 0) + wc * 32 + 8 * fq + 4 * n) * sc;
#pragma unroll
            for (int ai = 0; ai < 2; ++ai)
#pragma unroll
                for (int m = 0; m < 4; ++m)
#pragma unroll
                    for (int bj = 0; bj < 2; ++bj) {
                        const f32x4 p = *(const LAS f32x4*)(xch + ((ai * HALF + wr * 64 + m * 16 + fr) * 2 + bj) * 4);
                        const float rinv = 1.0f / sqrtf(((p[0] + p[1]) + (p[2] + p[3])) * (1.0f / 128.0f) + EPS);
                        acc[ai][bj][m][0] = acc[ai][bj][m][0] * rinv * gv[bj][0]; acc[ai][bj][m][1] = acc[ai][bj][m][1] * rinv * gv[bj][1];
                    }
        }
#pragma unroll
        for (int ai = 0; ai < 2; ++ai)
#pragma unroll
            for (int m = 0; m < 4; ++m) { bf16_t* rowp = O + (size_t)(row0 + ai * HALF + m * 16) * AW + col0;
#pragma unroll
                for (int bj = 0; bj < 2; ++bj) { const f32x4 v0 = acc[ai][bj][m][0], v1 = acc[ai][bj][m][1];
                    u32x4 w; w.x = cvtpk(v0[0], v0[1]); w.y = cvtpk(v0[2], v0[3]); w.z = cvtpk(v1[0], v1[1]); w.w = cvtpk(v1[2], v1[3]);
                    *(u32x4*)(rowp + bj * HALF) = w; } }
    }
};

struct EpiRes1 {
    static constexpr bool PERM = true, HOOKS = true, ALIGN = MK_ALIGN; static constexpr int MIDT = 16;
    const float* x; bf16_t* x1; const float* mod;
    const float *ssa, *ssg;
    LAS float* rt;
    __device__ __forceinline__ void begin(const Unit&, int, int) const {}
    __device__ __forceinline__ void fill(const Unit& u, int ui, int row) const {
        const size_t gr = (size_t)u.pm * BM + row;
        const f32x4 a0 = *(const f32x4*)(ssa + gr * 8), a1 = *(const f32x4*)(ssa + gr * 8 + 4);
        const float sa = ((a0[0] + a0[1]) + (a0[2] + a0[3])) + ((a1[0] + a1[1]) + (a1[2] + a1[3]));
        const f32x4 a = *(const f32x4*)(ssg + gr * 16), b = *(const f32x4*)(ssg + gr * 16 + 4), c = *(const f32x4*)(ssg + gr * 16 + 8), d = *(const f32x4*)(ssg + gr * 16 + 12);
        const float sg = (((a[0] + a[1]) + (a[2] + a[3])) + ((b[0] + b[1]) + (b[2] + b[3]))) + (((c[0] + c[1]) + (c[2] + c[3])) + ((d[0] + d[1]) + (d[2] + d[3])));
        const float ra = 1.0f / sqrtf(sa * (1.0f / 1024.0f) + EPS), rg = 1.0f / sqrtf(sg * (1.0f / 1024.0f) + EPS);
        *(LAS f32x2*)(rt + ((ui & 3) * 256 + row) * 2) = (f32x2){ra / rg, rg};
    }
    __device__ __forceinline__ void mid(f32x4 (&acc)[2][2][4][2], int ui, int wr, int fr) const {
#pragma unroll
        for (int ai = 0; ai < 2; ++ai)
#pragma unroll
            for (int m = 0; m < 4; ++m) { const float f = rt[((ui & 3) * 256 + ai * HALF + wr * 64 + m * 16 + fr) * 2];
#pragma unroll
                for (int bj = 0; bj < 2; ++bj)
#pragma unroll
                    for (int n = 0; n < 2; ++n) acc[ai][bj][m][n] = acc[ai][bj][m][n] * f; }
    }
    __device__ __forceinline__ void operator()(f32x4 (&acc)[2][2][4][2], const Unit& u, int ui, int wr, int wc, int fr, int fq) const {
        const int row0 = u.pm * BM + wr * 64 + fr, col0 = u.pn * BM + wc * 32 + 8 * fq;
        const float* gp = mod + (size_t)(u.pm >> 3) * NMOD + 2 * DM + col0;
        f32x4 gv[2][2];
#pragma unroll
        for (int bj = 0; bj < 2; ++bj)
#pragma unroll
            for (int n = 0; n < 2; ++n) gv[bj][n] = *(const f32x4*)(gp + bj * HALF + n * 4);
#pragma unroll
        for (int ai = 0; ai < 2; ++ai)
#pragma unroll
            for (int m = 0; m < 4; ++m) { const size_t off = (size_t)(row0 + ai * HALF + m * 16) * DM + col0;
                const float rg = rt[((ui & 3) * 256 + ai * HALF + wr * 64 + m * 16 + fr) * 2 + 1];
#pragma unroll
                for (int bj = 0; bj < 2; ++bj) {
                    const f32x4 x0 = *(const f32x4*)(x + off + bj * HALF), xb = *(const f32x4*)(x + off + bj * HALF + 4);
                    const f32x4 v0 = x0 + gv[bj][0] * (acc[ai][bj][m][0] * rg), v1 = xb + gv[bj][1] * (acc[ai][bj][m][1] * rg);
                    u32x4 w; w.x = cvtpk(v0[0], v0[1]); w.y = cvtpk(v0[2], v0[3]); w.z = cvtpk(v1[0], v1[1]); w.w = cvtpk(v1[2], v1[3]);
                    *(u32x4*)(x1 + off + bj * HALF) = w; } }
    }
};

struct EpiRelu2 {
    static constexpr bool PERM = true, HOOKS = false, ALIGN = MK_ALIGN; static constexpr int MIDT = 0;
    bf16_t* O; int ldc;
    __device__ __forceinline__ void begin(const Unit&, int, int) const {}
    __device__ __forceinline__ void mid(f32x4 (&)[2][2][4][2], int, int, int) const {}
    __device__ __forceinline__ void operator()(f32x4 (&acc)[2][2][4][2], const Unit& u, int ui, int wr, int wc, int fr, int fq) const {
        const int row0 = u.pm * BM + wr * 64 + fr, col0 = u.pn * BM + wc * 32 + 8 * fq;
#pragma unroll
        for (int ai = 0; ai < 2; ++ai)
#pragma unroll
            for (int m = 0; m < 4; ++m) { bf16_t* rowp = O + blk_off((size_t)(row0 + ai * HALF + m * 16), col0, ldc);
#pragma unroll
                for (int bj = 0; bj < 2; ++bj) { f32x4 v0 = acc[ai][bj][m][0], v1 = acc[ai][bj][m][1];
                    v0 = __builtin_elementwise_max(v0, (f32x4){0.f, 0.f, 0.f, 0.f}); v1 = __builtin_elementwise_max(v1, (f32x4){0.f, 0.f, 0.f, 0.f}); v0 = v0 * v0; v1 = v1 * v1;
                    u32x4 w; w.x = cvtpk(v0[0], v0[1]); w.y = cvtpk(v0[2], v0[3]); w.z = cvtpk(v1[0], v1[1]); w.w = cvtpk(v1[2], v1[3]);
                    *(u32x4*)(rowp + bj * 2 * 16384) = w; } }
    }
};

struct EpiRes2 {
    static constexpr bool PERM = false, HOOKS = false, ALIGN = MK_ALIGN; static constexpr int MIDT = 0;
    const bf16_t* x1; float* out; const float* mod;
    __device__ __forceinline__ void begin(const Unit&, int, int) const {}
    __device__ __forceinline__ void mid(f32x4 (&)[2][2][4][2], int, int, int) const {}
    __device__ __forceinline__ void operator()(f32x4 (&acc)[2][2][4][2], const Unit& u, int ui, int wr, int wc, int fr, int fq) const {
        const int row0 = u.pm * BM + wr * 64 + fr, col0 = u.pn * BM + wc * 32 + 4 * fq;
        const float* gp = mod + (size_t)(u.pm >> 3) * NMOD + 5 * DM + col0;
        f32x4 gv[2][2];
#pragma unroll
        for (int bj = 0; bj < 2; ++bj)
#pragma unroll
            for (int n = 0; n < 2; ++n) gv[bj][n] = *(const f32x4*)(gp + bj * HALF + n * 16);
#pragma unroll
        for (int ai = 0; ai < 2; ++ai)
#pragma unroll
            for (int m = 0; m < 4; ++m) { const size_t off = (size_t)(row0 + ai * HALF + m * 16) * DM + col0;
#pragma unroll
                for (int bj = 0; bj < 2; ++bj)
#pragma unroll
                    for (int n = 0; n < 2; ++n) { const u32x2 xr = *(const u32x2*)(x1 + off + bj * HALF + n * 16);
                        const f32x4 xv = (f32x4){__uint_as_float(xr.x << 16), __uint_as_float(xr.x & 0xffff0000u), __uint_as_float(xr.y << 16), __uint_as_float(xr.y & 0xffff0000u)};
                        *(f32x4*)(out + off + bj * HALF + n * 16) = xv + gv[bj][n] * acc[ai][bj][m][n]; } }
    }
};

template <class Epi, class Sched>
__device__ __forceinline__ void gemm_phase(LAS unsigned char* lds, const Gemm g, const Sched& S, const Epi& E) {
    const int tid = threadIdx.x, wid = __builtin_amdgcn_readfirstlane(tid >> 6), lane = tid & 63, wr = wid >> 2, wc = wid & 3, fr = lane & 15, fq = lane >> 4;
    const int K = g.K, nt = K / BK;
    unsigned voffA[2], voffB[2];
#pragma unroll
    for (int i = 0; i < 2; ++i) { int R, C; stage_rc(tid * 16 + i * 8192, R, C); const int Rb = Epi::PERM ? ((R & ~31) + perm32(R & 31)) : R;
        voffA[i] = (unsigned)(R * 64 + C) * 2u; voffB[i] = (unsigned)(Rb * 64 + C) * 2u; }
    const size_t kstep = (size_t)(256 * BK * 2);
    const size_t hstep = (size_t)HALF * BK * 2;
    const size_t tstep = (size_t)256 * K * 2;
    const unsigned ldsw = (unsigned)wid * 1024u;
    const int aoff[2] = {lds_byte(wr * 64 + fr, fq * 8), lds_byte(wr * 64 + fr, 32 + fq * 8)}, boff[2] = {lds_byte(wc * 32 + fr, fq * 8), lds_byte(wc * 32 + fr, 32 + fq * 8)};
#define PG8_SA(b, h) (((b) * 2 + (h)) * HTB)
#define PG8_SB(b, h) ((4 + (b) * 2 + (h)) * HTB)
#define PG8_STAGE(bufoff, gbase, voff) do { _Pragma("unroll") for (int _i = 0; _i < 2; ++_i) \
        __builtin_amdgcn_global_load_lds((const unsigned*)((const char*)(gbase) + (voff)[_i]), (LAS unsigned*)(lds + (bufoff) + ldsw + _i * 8192), 16, 0, 0); } while (0)
#define PG8_LDA(dst, b, h) do { _Pragma("unroll") for (int m = 0; m < 4; ++m) _Pragma("unroll") for (int k = 0; k < 2; ++k) dst[m][k] = *(const LAS bf16x8*)(lds + PG8_SA(b, h) + aoff[k] + m * 2048); } while (0)
#define PG8_LDB(dst, b, h) do { _Pragma("unroll") for (int n = 0; n < 2; ++n) _Pragma("unroll") for (int k = 0; k < 2; ++k) dst[n][k] = *(const LAS bf16x8*)(lds + PG8_SB(b, h) + boff[k] + n * 2048); } while (0)
#define PG8_MMA(ai, bj, At, Bt) do { __builtin_amdgcn_s_setprio(1); _Pragma("unroll") for (int m = 0; m < 4; ++m) _Pragma("unroll") for (int n = 0; n < 2; ++n) _Pragma("unroll") for (int k = 0; k < 2; ++k) \
        acc[ai][bj][m][n] = __builtin_amdgcn_mfma_f32_16x16x32_bf16(Bt[n][k], At[m][k], acc[ai][bj][m][n], 0, 0, 0); __builtin_amdgcn_s_setprio(0); } while (0)
#define PG8_WAIT_V(n) asm volatile("s_waitcnt vmcnt(" #n ")" ::: "memory")
#define PG8_WAIT_L(n) asm volatile("s_waitcnt lgkmcnt(" #n ")" ::: "memory")
#define PG8_BAR __builtin_amdgcn_s_barrier()
#define PG8_SCHED __builtin_amdgcn_sched_barrier(0)
    Unit cur, nxt; int ui = 0;
    if (!S.next(0, cur)) return;
    f32x4 acc[2][2][4][2];
#pragma unroll
    for (int a = 0; a < 2; ++a)
#pragma unroll
        for (int b = 0; b < 2; ++b)
#pragma unroll
            for (int m = 0; m < 4; ++m)
#pragma unroll
                for (int n = 0; n < 2; ++n) acc[a][b][m][n] = (f32x4){0.f, 0.f, 0.f, 0.f};
    bf16x8 At[4][2], B0[2][2], B1[2][2];
    const char* cA = (const char*)g.A + (size_t)cur.pm * tstep; const char* cB = (const char*)g.Bt + (size_t)cur.pn * tstep;
#if MK_SP2
    PG8_STAGE(PG8_SB(0, 0), cB, voffB); PG8_STAGE(PG8_SB(0, 1), cB + hstep, voffB); PG8_STAGE(PG8_SA(0, 0), cA, voffA); PG8_STAGE(PG8_SA(0, 1), cA + hstep, voffA);
    if (wr == 1) PG8_BAR;
    PG8_WAIT_V(2); PG8_BAR;
    PG8_STAGE(PG8_SB(1, 0), cB + kstep, voffB); PG8_STAGE(PG8_SA(1, 0), cA + kstep, voffA); PG8_STAGE(PG8_SB(1, 1), cB + hstep + kstep, voffB);
    PG8_WAIT_V(6); PG8_BAR;
#else
    PG8_STAGE(PG8_SB(0, 0), cB, voffB); PG8_STAGE(PG8_SA(0, 0), cA, voffA); PG8_STAGE(PG8_SB(0, 1), cB + hstep, voffB); PG8_STAGE(PG8_SA(0, 1), cA + hstep, voffA);
    if (wr == 1) PG8_BAR;
    PG8_WAIT_V(4); PG8_BAR;
    PG8_STAGE(PG8_SB(1, 0), cB + kstep, voffB); PG8_STAGE(PG8_SA(1, 0), cA + kstep, voffA); PG8_STAGE(PG8_SB(1, 1), cB + hstep + kstep, voffB);
    PG8_WAIT_V(6); PG8_BAR;
#endif
    for (;;) {
        const bool has_next = S.next(ui + 1, nxt);
        const char* nA = has_next ? (const char*)g.A + (size_t)nxt.pm * tstep : cA; const char* nB = has_next ? (const char*)g.Bt + (size_t)nxt.pn * tstep : cB;
        for (int t = 0; t < nt; t += 2) {
            const bool last = (t == nt - 2);
            const char* a1 = cA + (size_t)(t + 1) * kstep;
            const char* a2 = last ? nA : cA + (size_t)(t + 2) * kstep; const char* b2 = last ? nB : cB + (size_t)(t + 2) * kstep;
            const char* a3 = a2 + kstep; const char* b3 = b2 + kstep;
            if constexpr (Epi::HOOKS) { if (t == Epi::MIDT) E.mid(acc, ui, wr, fr); }
#if MK_SP2
            PG8_LDB(B0, 0, 0); PG8_LDB(B1, 0, 1); PG8_SCHED; PG8_LDA(At, 0, 0); PG8_STAGE(PG8_SA(1, 1), a1 + hstep, voffA);
            PG8_WAIT_V(8); PG8_WAIT_L(0); PG8_BAR; PG8_MMA(0, 0, At, B0); PG8_MMA(0, 1, At, B1); PG8_BAR; PG8_SCHED;
            PG8_LDA(At, 0, 1); PG8_STAGE(PG8_SB(0, 0), b2, voffB); PG8_STAGE(PG8_SB(0, 1), b2 + hstep, voffB); PG8_STAGE(PG8_SA(0, 0), a2, voffA);
            PG8_WAIT_V(8); PG8_WAIT_L(0); PG8_BAR; PG8_MMA(1, 0, At, B0); PG8_MMA(1, 1, At, B1); PG8_BAR; PG8_SCHED;
            PG8_LDB(B0, 1, 0); PG8_LDB(B1, 1, 1); PG8_SCHED; PG8_LDA(At, 1, 0); PG8_STAGE(PG8_SA(0, 1), a2 + hstep, voffA);
            PG8_WAIT_V(8); PG8_WAIT_L(0); PG8_BAR; PG8_MMA(0, 0, At, B0); PG8_MMA(0, 1, At, B1); PG8_BAR; PG8_SCHED;
            PG8_LDA(At, 1, 1); PG8_STAGE(PG8_SB(1, 0), b3, voffB); PG8_STAGE(PG8_SB(1, 1), b3 + hstep, voffB); PG8_STAGE(PG8_SA(1, 0), a3, voffA);
            PG8_WAIT_V(8); PG8_WAIT_L(0); PG8_BAR; PG8_MMA(1, 0, At, B0); PG8_MMA(1, 1, At, B1); PG8_BAR; PG8_SCHED;
#else
            PG8_LDB(B0, 0, 0); PG8_SCHED; PG8_LDA(At, 0, 0); PG8_STAGE(PG8_SA(1, 1), a1 + hstep, voffA);
            PG8_WAIT_L(8); PG8_BAR; PG8_WAIT_L(0); PG8_MMA(0, 0, At, B0); PG8_BAR; PG8_SCHED;
            PG8_LDB(B1, 0, 1); PG8_STAGE(PG8_SB(0, 0), b2, voffB);
            PG8_BAR; PG8_WAIT_L(0); PG8_MMA(0, 1, At, B1); PG8_BAR;
            PG8_LDA(At, 0, 1); PG8_STAGE(PG8_SA(0, 0), a2, voffA);
            PG8_BAR; PG8_WAIT_L(0); PG8_MMA(1, 0, At, B0); PG8_BAR; PG8_SCHED;
            PG8_STAGE(PG8_SB(0, 1), b2 + hstep, voffB);
            PG8_WAIT_V(6); PG8_BAR; PG8_MMA(1, 1, At, B1); PG8_BAR;
            PG8_LDB(B0, 1, 0); PG8_SCHED; PG8_LDA(At, 1, 0); PG8_STAGE(PG8_SA(0, 1), a2 + hstep, voffA);
            PG8_WAIT_L(8); PG8_BAR; PG8_WAIT_L(0); PG8_MMA(0, 0, At, B0); PG8_BAR; PG8_SCHED;
            PG8_LDB(B1, 1, 1); PG8_STAGE(PG8_SB(1, 0), b3, voffB);
            PG8_BAR; PG8_WAIT_L(0); PG8_MMA(0, 1, At, B1); PG8_BAR;
            PG8_LDA(At, 1, 1); PG8_STAGE(PG8_SA(1, 0), a3, voffA);
            PG8_BAR; PG8_WAIT_L(0); PG8_MMA(1, 0, At, B0); PG8_BAR; PG8_SCHED;
            PG8_STAGE(PG8_SB(1, 1), b3 + hstep, voffB);
            PG8_WAIT_V(6); PG8_BAR; PG8_MMA(1, 1, At, B1); PG8_BAR;
#endif
        }
        if constexpr (Epi::ALIGN) { if (wr == 0) PG8_BAR; }
        E(acc, cur, ui, wr, wc, fr, fq);
        if (!has_next) break;
#pragma unroll
        for (int a = 0; a < 2; ++a)
#pragma unroll
            for (int b = 0; b < 2; ++b)
#pragma unroll
                for (int m = 0; m < 4; ++m)
#pragma unroll
                    for (int n = 0; n < 2; ++n) acc[a][b][m][n] = (f32x4){0.f, 0.f, 0.f, 0.f};
        cur = nxt; cA = nA; cB = nB; ++ui;
        if constexpr (Epi::ALIGN) { if (wr == 1) PG8_BAR; }
    }
    PG8_WAIT_V(0);
    if constexpr (!Epi::ALIGN) { if (wr == 0) PG8_BAR; }
    PG8_BAR;
#undef PG8_SA
#undef PG8_SB
#undef PG8_STAGE
#undef PG8_LDA
#undef PG8_LDB
#undef PG8_MMA
#undef PG8_WAIT_V
#undef PG8_WAIT_L
#undef PG8_BAR
#undef PG8_SCHED
}
}

typedef GAS unsigned gu32;
#define RLX_AGENT __ATOMIC_RELAXED, __HIP_MEMORY_SCOPE_AGENT
#define XB_TMO      128
#define XB_XCNT(j)  (256  + 64 * (j))
#define XB_XSUB(j)  (1280 + 64 * (j))
#define XB_XGEN(j)  (2304 + 64 * (j))
#define XB_TOP      3328
#define XB_TOPGEN   3392
#define XCD_BAR_WORDS 3456
#define XB_SPIN_CAP (1u << 20)
__device__ __forceinline__ unsigned xb_ld(unsigned* p)              { return __hip_atomic_load(p, __ATOMIC_RELAXED, __HIP_MEMORY_SCOPE_AGENT); }
__device__ __forceinline__ unsigned xb_add(unsigned* p, unsigned v) { return __hip_atomic_fetch_add(p, v, __ATOMIC_RELAXED, __HIP_MEMORY_SCOPE_AGENT); }
__device__ __forceinline__ unsigned xb_xcc_id() { return (unsigned)__builtin_amdgcn_s_getreg((3 << 11) | 20) & 0xFu; }
#define XB_SPIN(cond, bar) do { unsigned _sp = 0; while (cond) { __builtin_amdgcn_s_sleep(1); \
    if ((++_sp & 255u) == 0u) { if (xb_ld(&(bar)[XB_TMO])) break; if (_sp > XB_SPIN_CAP) { atomicAdd(&(bar)[XB_TMO], 1u); break; } } } } while (0)
struct XcdBarrier { unsigned* bar; unsigned x; volatile LAS unsigned* st; };
__device__ __forceinline__ XcdBarrier xcd_barrier_post(unsigned* bar, volatile LAS unsigned* st) {
    XcdBarrier b; b.bar = bar; b.x = xb_xcc_id(); b.st = st;
    if (threadIdx.x == 0) (void)xb_add(&bar[XB_XCNT(b.x)], 1u);
    return b;
}
__device__ __forceinline__ void xcd_barrier_complete(unsigned* bar, unsigned x, unsigned& nloc, unsigned& nx) {
    const unsigned G = gridDim.x * gridDim.y * gridDim.z;
    unsigned sum, cnt, mine, sp = 0u;
    for (;;) {
        sum = 0u; cnt = 0u; mine = 0u;
#pragma unroll
        for (unsigned j = 0; j < 16; ++j) { const unsigned c = xb_ld(&bar[XB_XCNT(j)]); sum += c; cnt += (c > 0u) ? 1u : 0u; mine = (j == x) ? c : mine; }
        if (sum == G) break;
        __builtin_amdgcn_s_sleep(1);
        if ((++sp & 255u) == 0u) { if (xb_ld(&bar[XB_TMO])) break; if (sp > XB_SPIN_CAP) { atomicAdd(&bar[XB_TMO], 1u); break; } }
    }
    nloc = mine > 0u ? mine : 1u; nx = cnt > 0u ? cnt : 1u;
}
__device__ __forceinline__ void xcd_barrier(const XcdBarrier& b) {
    asm volatile("s_waitcnt vmcnt(0)" ::: "memory");
    __syncthreads();
    if (threadIdx.x == 0) {
        unsigned* bar = b.bar;
        __builtin_amdgcn_s_waitcnt(0);
        unsigned nloc = b.st[0], nx = b.st[1];
        if (nloc == 0u) { xcd_barrier_complete(bar, b.x, nloc, nx); b.st[0] = nloc; b.st[1] = nx; }
        const unsigned old = xb_add(&bar[XB_XSUB(b.x)], 1u);
        const unsigned gen = old / nloc;
        if (old + 1u == (gen + 1u) * nloc) {
            __builtin_amdgcn_fence(__ATOMIC_RELEASE, "agent");
            asm volatile("s_waitcnt vmcnt(0)" ::: "memory");
            const unsigned og = xb_add(&bar[XB_TOP], 1u);
            const unsigned tg = og / nx;
            if (og + 1u == (tg + 1u) * nx) xb_add(&bar[XB_TOPGEN], 1u);
            else XB_SPIN(xb_ld(&bar[XB_TOPGEN]) == tg, bar);
            __builtin_amdgcn_fence(__ATOMIC_ACQUIRE, "agent");
            xb_add(&bar[XB_XGEN(b.x)], 1u);
            asm volatile("s_waitcnt vmcnt(0)" ::: "memory");
        } else {
            XB_SPIN(xb_ld(&bar[XB_XGEN(b.x)]) == gen, bar);
            __builtin_amdgcn_fence(__ATOMIC_ACQUIRE, "agent");
            asm volatile("s_waitcnt vmcnt(0)" ::: "memory");
        }
    }
    __syncthreads();
}

struct Args { const float* in[18]; float* out; unsigned char* ws; int ph_lo, ph_hi, li, pad; };
struct Frame {
    LAS unsigned char* lds;
    int tid, lane, wave, vcu, G;
};
#define LDS_WAIT() asm volatile("s_waitcnt lgkmcnt(0)" ::: "memory")

__device__ __forceinline__ void p0_ada(const Frame& F, const float* c, const float* w_ada, const float* b_ada, float* mod) {
    LAS float* sc = (LAS float*)F.lds;
    LAS float* part = (LAS float*)(F.lds + 65536);
    for (int i = F.tid; i < NBATCH * DM; i += 512) { const int b = i >> 11, k = i & 2047; const float v = c[i]; sc[k * 8 + b] = v / (1.0f + __expf(-v)); }
    __syncthreads();
    const int kk = F.lane / 12, c4 = F.lane % 12;
    for (int item = blockIdx.x; item < 256; item += F.G) {
        const int n0 = 48 * item, kb = 256 * F.wave;
        f32x4 acc[8];
#pragma unroll
        for (int b = 0; b < 8; ++b) acc[b] = (f32x4){0.f, 0.f, 0.f, 0.f};
        if (F.lane < 60) {
            const float* wp = w_ada + (size_t)(kb + kk) * NMOD + n0 + 4 * c4;
#pragma unroll 17
            for (int i = 0; i < 51; ++i) {
                const int k = kb + kk + 5 * i;
                const f32x4 w = __builtin_nontemporal_load((const f32x4*)(wp + (size_t)(5 * i) * NMOD));
                const f32x4 s0 = *(const LAS f32x4*)(sc + k * 8), s1 = *(const LAS f32x4*)(sc + k * 8 + 4);
                acc[0] += w * s0[0]; acc[1] += w * s0[1]; acc[2] += w * s0[2]; acc[3] += w * s0[3];
                acc[4] += w * s1[0]; acc[5] += w * s1[1]; acc[6] += w * s1[2]; acc[7] += w * s1[3];
            }
            if (kk == 0) {
                const int k = kb + 255;
                const f32x4 w = *(const f32x4*)(w_ada + (size_t)k * NMOD + n0 + 4 * c4);
                const f32x4 s0 = *(const LAS f32x4*)(sc + k * 8), s1 = *(const LAS f32x4*)(sc + k * 8 + 4);
                acc[0] += w * s0[0]; acc[1] += w * s0[1]; acc[2] += w * s0[2]; acc[3] += w * s0[3];
                acc[4] += w * s1[0]; acc[5] += w * s1[1]; acc[6] += w * s1[2]; acc[7] += w * s1[3];
            }
#pragma unroll
            for (int b = 0; b < 8; ++b) *(LAS f32x4*)(part + (F.wave * 5 + kk) * 384 + b * 48 + 4 * c4) = acc[b];
        }
        __syncthreads();
        if (F.tid < 384) { float s = 0.f;
#pragma unroll 8
            for (int j = 0; j < 40; ++j) s += part[j * 384 + F.tid];
            const int b = F.tid / 48, n = F.tid % 48; mod[(size_t)b * NMOD + n0 + n] = s + b_ada[n0 + n]; }
        __syncthreads();
    }
}

struct TrItem { const float* W; bf16_t* WT; int K, N, item; const float *ks0, *ks1; };
__device__ __forceinline__ void tr_load(const TrItem& t, int lane, f32x4 (&v)[8]) {
    const int nblk = t.N / 32, kb = t.item / nblk, nb = t.item % nblk, k0 = 64 * kb, n0 = 32 * nb, lc = lane & 7, lr = lane >> 3;
    const float* wp = t.W + (size_t)(k0 + 8 * lr) * t.N + n0 + 4 * lc;
#pragma unroll
    for (int i = 0; i < 8; ++i) v[i] = __builtin_nontemporal_load((const f32x4*)(wp + (size_t)i * t.N));
}
__device__ __forceinline__ void tr_store(const TrItem& t, int lane, f32x4 (&v)[8]) {
    const int nblk = t.N / 32, kb = t.item / nblk, nb = t.item % nblk, k0 = 64 * kb, n0 = 32 * nb, lc = lane & 7, lr = lane >> 3;
    if (t.ks0) { const int k = k0 + 8 * lr; const float* kp = k < 1024 ? t.ks0 + k : t.ks1 + (k - 1024); const f32x4 s0 = *(const f32x4*)kp, s1 = *(const f32x4*)(kp + 4);
        v[0] = v[0] * s0[0]; v[1] = v[1] * s0[1]; v[2] = v[2] * s0[2]; v[3] = v[3] * s0[3]; v[4] = v[4] * s1[0]; v[5] = v[5] * s1[1]; v[6] = v[6] * s1[2]; v[7] = v[7] * s1[3]; }
    bf16_t* op = t.WT + blk_off((size_t)(n0 + 4 * lc), k0 + 8 * lr, t.K);
#pragma unroll
    for (int e = 0; e < 4; ++e) { u32x4 o; o.x = cvtpk(v[0][e], v[1][e]); o.y = cvtpk(v[2][e], v[3][e]); o.z = cvtpk(v[4][e], v[5][e]); o.w = cvtpk(v[6][e], v[7][e]);
        *(u32x4*)(op + e * 64) = o; }
}
__device__ __forceinline__ void nm_load(const float* xrow, int lane, f32x4 (&v)[8]) {
    const f32x4* xr = (const f32x4*)xrow + lane;
#pragma unroll
    for (int j = 0; j < 8; ++j) v[j] = __builtin_nontemporal_load(xr + 64 * j);
}
__device__ __forceinline__ void nm_finish(f32x4 (&v)[8], const float* g, const float* shift, const float* scale, bf16_t* Hb, int m, int lane) {
    float s = 0.f;
#pragma unroll
    for (int j = 0; j < 8; ++j) s += (v[j][0] * v[j][0] + v[j][1] * v[j][1]) + (v[j][2] * v[j][2] + v[j][3] * v[j][3]);
    const float rinv = 1.0f / sqrtf(wave_sum(s) * (1.0f / DM) + EPS);
    bf16_t* ob = Hb + blk_off((size_t)m, 4 * lane, DM);
#pragma unroll
    for (int j = 0; j < 8; ++j) { const f32x4 gg = ((const f32x4*)g)[lane + 64 * j], sc = ((const f32x4*)scale)[lane + 64 * j], sh = ((const f32x4*)shift)[lane + 64 * j];
        const f32x4 o = (v[j] * rinv) * gg * (sc + 1.0f) + sh; u32x2 w; w.x = cvtpk(o[0], o[1]); w.y = cvtpk(o[2], o[3]); *(u32x2*)(ob + (size_t)j * 4 * 16384) = w; }
}
__device__ __forceinline__ void nmb_load(const bf16_t* xrow, int lane, u32x4 (&r)[4]) {
    const u32x4* xr = (const u32x4*)xrow + lane;
#pragma unroll
    for (int j = 0; j < 4; ++j) r[j] = xr[64 * j];
}
__device__ __forceinline__ void nmb_finish(const u32x4 (&r)[4], const float* g, const float* shift, const float* scale, bf16_t* Hb, int m, int lane) {
    f32x4 v[4][2]; float s = 0.f;
#pragma unroll
    for (int j = 0; j < 4; ++j) {
        v[j][0] = (f32x4){__uint_as_float(r[j].x << 16), __uint_as_float(r[j].x & 0xffff0000u), __uint_as_float(r[j].y << 16), __uint_as_float(r[j].y & 0xffff0000u)};
        v[j][1] = (f32x4){__uint_as_float(r[j].z << 16), __uint_as_float(r[j].z & 0xffff0000u), __uint_as_float(r[j].w << 16), __uint_as_float(r[j].w & 0xffff0000u)};
#pragma unroll
        for (int e = 0; e < 2; ++e) s += (v[j][e][0] * v[j][e][0] + v[j][e][1] * v[j][e][1]) + (v[j][e][2] * v[j][e][2] + v[j][e][3] * v[j][e][3]); }
    const float rinv = 1.0f / sqrtf(wave_sum(s) * (1.0f / DM) + EPS);
    bf16_t* ob = Hb + blk_off((size_t)m, 8 * lane, DM);
#pragma unroll
    for (int j = 0; j < 4; ++j) { u32x4 w;
#pragma unroll
        for (int e = 0; e < 2; ++e) { const int ci = 2 * lane + 128 * j + e;
            const f32x4 gg = ((const f32x4*)g)[ci], sc = ((const f32x4*)scale)[ci], sh = ((const f32x4*)shift)[ci];
            const f32x4 o = (v[j][e] * rinv) * gg * (sc + 1.0f) + sh; if (e == 0) { w.x = cvtpk(o[0], o[1]); w.y = cvtpk(o[2], o[3]); } else { w.z = cvtpk(o[0], o[1]); w.w = cvtpk(o[2], o[3]); } }
        *(u32x4*)(ob + (size_t)j * 8 * 16384) = w; }
}

__device__ __forceinline__ unsigned off_b(unsigned row, unsigned ch) { return 256u * row + 16u * (ch ^ (((row & 3) << 2) | ((row >> 2) & 3))); }
__device__ __forceinline__ v4i16_t vtr(LAS unsigned char* p) { return __builtin_amdgcn_ds_read_tr16_b64_v4i16((LAS v4i16_t*)p); }
__device__ __forceinline__ int crow(int r, int hi) { return (r & 3) + 8 * (r >> 2) + 4 * hi; }

constexpr int AT_BT = 0;
constexpr int AT_K = 2048, AT_V = AT_K + 2 * 16384;
constexpr float ATT_THR = 6.0f;

__device__ __forceinline__ void attn_unit(const Frame& F, const bf16_t* Q, const bf16_t* Kg, const bf16_t* Vg, bf16_t* MIX, float* SSA, const float* relb, int b, int h, int g4) {
    LAS unsigned char* lds = F.lds;
    const int tid = F.tid, lane = F.lane, wid = F.wave, r32 = lane & 31, hi = lane >> 5;
    LAS float* bt = (LAS float*)(lds + AT_BT);
    if (tid < NREL) bt[tid] = relb[h * NREL + tid] * LOG2E;
    const int c = 4 * g4 + (wid >> 1);
    const size_t qrow = (size_t)b * SEQ + 64 * c + 32 * (wid & 1) + r32;
    bf16x8 qf[8];
#pragma unroll
    for (int ks = 0; ks < 8; ++ks) qf[ks] = *(const bf16x8*)(Q + qrow * AW + h * HD + 16 * ks + 8 * hi);
    const int kc_lo = (4 * g4 - LEFT) > 0 ? (4 * g4 - LEFT) : 0, kc_hi = 4 * g4 + 3, nsteps = kc_hi - kc_lo + 1;
    const int srow = tid >> 4, sch = tid & 15;
    const bf16_t* kp = Kg + ((size_t)b * SEQ + (size_t)kc_lo * CHUNK + srow) * AW + h * HD + sch * 8;
    const bf16_t* vp = Vg + ((size_t)b * SEQ + (size_t)kc_lo * CHUNK + srow) * AW + h * HD + sch * 8;
    const unsigned so0 = off_b(srow, sch), so1 = off_b(srow + 32, sch);
    u32x4 sk0, sk1, sv0, sv1;
    sk0 = *(const u32x4*)kp; sk1 = *(const u32x4*)(kp + 32 * AW); sv0 = *(const u32x4*)vp; sv1 = *(const u32x4*)(vp + 32 * AW);
    unsigned ka[8];
#pragma unroll
    for (int ks = 0; ks < 8; ++ks) ka[ks] = off_b(r32, 2 * ks + hi);
    const unsigned blk = (lane >> 4) & 1, q4 = (lane & 15) >> 2, p4 = lane & 3;
    unsigned va[4][2];
#pragma unroll
    for (int dt = 0; dt < 4; ++dt)
#pragma unroll
        for (int tp = 0; tp < 2; ++tp) va[dt][tp] = off_b(4 * hi + q4 + 8 * tp, 4 * dt + 2 * blk + (p4 >> 1)) + 8 * (p4 & 1);
    float m_run = -1e30f, l_run = 0.f;
    f32x16 o[4];
#pragma unroll
    for (int dt = 0; dt < 4; ++dt) o[dt] = (f32x16){};
    const int qin = 32 * (wid & 1) + r32;
    for (int s = 0; s < nsteps; ++s) {
        const int kc = kc_lo + s, buf = s & 1;
        LAS unsigned char* Kb = lds + AT_K + buf * 16384; LAS unsigned char* Vb = lds + AT_V + buf * 16384;
        *(LAS u32x4*)(Kb + so0) = sk0; *(LAS u32x4*)(Kb + so1) = sk1; *(LAS u32x4*)(Vb + so0) = sv0; *(LAS u32x4*)(Vb + so1) = sv1;
        if (s + 1 < nsteps) { kp += (size_t)CHUNK * AW; vp += (size_t)CHUNK * AW;
            sk0 = *(const u32x4*)kp; sk1 = *(const u32x4*)(kp + 32 * AW); sv0 = *(const u32x4*)vp; sv1 = *(const u32x4*)(vp + 32 * AW); }
        LDS_WAIT(); __builtin_amdgcn_s_barrier(); asm volatile("" ::: "memory");
        const int delta = c - kc;
        if (delta >= 0 && delta <= LEFT) {
#pragma unroll
            for (int t = 0; t < 2; ++t) {
                f32x16 sc = (f32x16){};
#pragma unroll
                for (int ks = 0; ks < 8; ++ks) { const bf16x8 kf = *(const LAS bf16x8*)(Kb + ka[ks] + t * 8192); sc = __builtin_amdgcn_mfma_f32_32x32x16_bf16(kf, qf[ks], sc, 0, 0, 0); }
                if (delta >= 3) { const float bc = bt[2 * MAXREL];
#pragma unroll
                    for (int r = 0; r < 16; ++r) sc[r] += bc;
                } else { const int lb = 64 * delta + qin - 32 * t - 4 * hi + MAXREL;
#pragma unroll
                    for (int r = 0; r < 16; ++r) { int idx = lb - ((r & 3) + 8 * (r >> 2)); idx = idx > 2 * MAXREL ? 2 * MAXREL : idx; sc[r] += bt[idx]; } }
                float tm = sc[0];
#pragma unroll
                for (int r = 1; r < 16; ++r) tm = fmaxf(tm, sc[r]);
                tm = fmaxf(tm, __shfl_xor(tm, 32));
                if (!__all(tm <= m_run + ATT_THR)) {
                    const float mn = fmaxf(m_run, tm), al = __builtin_amdgcn_exp2f(m_run - mn); m_run = mn; l_run *= al;
#pragma unroll
                    for (int dt = 0; dt < 4; ++dt) o[dt] = o[dt] * al;
                }
                float ps = 0.f;
#pragma unroll
                for (int r = 0; r < 16; ++r) { sc[r] = __builtin_amdgcn_exp2f(sc[r] - m_run); ps += sc[r]; }
                l_run += ps;
                bf16x8 pb[2];
#pragma unroll
                for (int s2 = 0; s2 < 2; ++s2) { u32x4 w; w.x = cvtpk(sc[8 * s2 + 0], sc[8 * s2 + 1]); w.y = cvtpk(sc[8 * s2 + 2], sc[8 * s2 + 3]); w.z = cvtpk(sc[8 * s2 + 4], sc[8 * s2 + 5]); w.w = cvtpk(sc[8 * s2 + 6], sc[8 * s2 + 7]); pb[s2] = __builtin_bit_cast(bf16x8, w); }
#pragma unroll
                for (int dt = 0; dt < 4; ++dt)
#pragma unroll
                    for (int s2 = 0; s2 < 2; ++s2) {
                        const v4i16_t lo = vtr(Vb + va[dt][0] + (32 * t + 16 * s2) * 256), hh = vtr(Vb + va[dt][1] + (32 * t + 16 * s2) * 256);
                        const bf16x8 vf = (bf16x8){lo[0], lo[1], lo[2], lo[3], hh[0], hh[1], hh[2], hh[3]};
                        o[dt] = __builtin_amdgcn_mfma_f32_32x32x16_bf16(vf, pb[s2], o[dt], 0, 0, 0);
                    }
            }
        }
    }
    const float lt = l_run + __shfl_xor(l_run, 32), inv = 1.0f / lt;
    float ss = 0.f;
    bf16_t* orow = MIX + blk_off(qrow, h * HD, DM);
#pragma unroll
    for (int dt = 0; dt < 4; ++dt)
#pragma unroll
        for (int rg = 0; rg < 4; ++rg) {
            const float a0 = o[dt][4 * rg] * inv, a1 = o[dt][4 * rg + 1] * inv, a2 = o[dt][4 * rg + 2] * inv, a3 = o[dt][4 * rg + 3] * inv;
            ss += (a0 * a0 + a1 * a1) + (a2 * a2 + a3 * a3);
            u32x2 w; w.x = cvtpk(a0, a1); w.y = cvtpk(a2, a3);
            *(u32x2*)(orow + (dt >> 1) * 16384 + 32 * (dt & 1) + 8 * rg + 4 * hi) = w;
        }
    ss += __shfl_xor(ss, 32);
    if (hi == 0) SSA[qrow * 8 + h] = ss;
    LDS_WAIT(); __builtin_amdgcn_s_barrier(); asm volatile("" ::: "memory");
}

__device__ __forceinline__ void gmlp_phase(const Frame& F, const bf16_t* U, const bf16_t* ZN, const bf16_t* WSP, const float* bsp, bf16_t* MIX, float* SSG) {
    const int tid = F.tid, lane = F.lane, wid = F.wave, r32 = lane & 31, hi = lane >> 5;
    const int tt = wid & 3, chh = wid >> 2, trow = 32 * tt + r32;
    const unsigned blk = (lane >> 4) & 1, q4 = (lane & 15) >> 2, p4 = lane & 3;
    constexpr int NU = NBATCH * 16 * 8;
    const int srow = tid >> 4, sch = tid & 15;
    int u = F.vcu;
    u32x4 zt[4];
    if (u < NU) { const int g = u & 7, nb = (u >> 3) & 15, b = u >> 7; const bf16_t* zp = ZN + ((size_t)b * SEQ + 128 * nb + srow) * AW + g * HD + sch * 8;
#pragma unroll
        for (int i = 0; i < 4; ++i) zt[i] = *(const u32x4*)(zp + (size_t)(32 * i) * AW); }
    for (int it = 0; u < NU; u += F.G, ++it) {
        const int g = u & 7, nb = (u >> 3) & 15, b = u >> 7;
        LAS unsigned char* lds = F.lds + AT_K + (it & 1) * 32768;
#pragma unroll
        for (int i = 0; i < 4; ++i) *(LAS u32x4*)(lds + off_b(srow + 32 * i, sch)) = zt[i];
        const int un = u + F.G;
        if (un < NU) { const int g2 = un & 7, nb2 = (un >> 3) & 15, b2 = un >> 7; const bf16_t* zp = ZN + ((size_t)b2 * SEQ + 128 * nb2 + srow) * AW + g2 * HD + sch * 8;
#pragma unroll
            for (int i = 0; i < 4; ++i) zt[i] = *(const u32x4*)(zp + (size_t)(32 * i) * AW); }
        const size_t grow = (size_t)b * SEQ + 128 * nb + trow;
        const bf16_t* wrow = WSP + ((size_t)g * 128 + trow) * 128 + 8 * hi;
        bf16x8 wf[8];
#pragma unroll
        for (int ks = 0; ks < 8; ++ks) wf[ks] = *(const bf16x8*)(wrow + 16 * ks);
        u32x2 uu[2][4];
#pragma unroll
        for (int c2 = 0; c2 < 2; ++c2)
#pragma unroll
            for (int rg = 0; rg < 4; ++rg) uu[c2][rg] = *(const u32x2*)(U + grow * AW + g * HD + 32 * (2 * chh + c2) + 8 * rg + 4 * hi);
        const float bs = bsp[g * 128 + trow];
        LDS_WAIT(); __builtin_amdgcn_s_barrier(); asm volatile("" ::: "memory");
        f32x16 acc[2]; acc[0] = (f32x16){}; acc[1] = (f32x16){};
#pragma unroll
        for (int ks = 0; ks < 8; ++ks) {
            if (ks < 4 || tt >= 2) {
#pragma unroll
                for (int c2 = 0; c2 < 2; ++c2) { const int ct = 2 * chh + c2;
                    const v4i16_t lo = vtr(lds + off_b(16 * ks + 8 * hi + q4, 4 * ct + 2 * blk + (p4 >> 1)) + 8 * (p4 & 1));
                    const v4i16_t hh = vtr(lds + off_b(16 * ks + 8 * hi + 4 + q4, 4 * ct + 2 * blk + (p4 >> 1)) + 8 * (p4 & 1));
                    const bf16x8 zf = (bf16x8){lo[0], lo[1], lo[2], lo[3], hh[0], hh[1], hh[2], hh[3]};
                    acc[c2] = __builtin_amdgcn_mfma_f32_32x32x16_bf16(zf, wf[ks], acc[c2], 0, 0, 0); }
            }
        }
        float ss = 0.f;
#pragma unroll
        for (int c2 = 0; c2 < 2; ++c2)
#pragma unroll
            for (int rg = 0; rg < 4; ++rg) { const int c0 = 32 * (2 * chh + c2) + 8 * rg + 4 * hi; const u32x2 w0 = uu[c2][rg];
                const float o0 = __uint_as_float(w0.x << 16) * (acc[c2][4 * rg] + bs), o1 = __uint_as_float(w0.x & 0xffff0000u) * (acc[c2][4 * rg + 1] + bs);
                const float o2 = __uint_as_float(w0.y << 16) * (acc[c2][4 * rg + 2] + bs), o3 = __uint_as_float(w0.y & 0xffff0000u) * (acc[c2][4 * rg + 3] + bs);
                ss += (o0 * o0 + o1 * o1) + (o2 * o2 + o3 * o3);
                u32x2 w; w.x = cvtpk(o0, o1); w.y = cvtpk(o2, o3);
                *(u32x2*)(MIX + blk_off(grow, AW + g * HD + c0, DM)) = w; }
        ss += __shfl_xor(ss, 32);
        if (hi == 0) SSG[grow * 16 + g * 2 + chh] = ss;
    }
    LDS_WAIT(); __builtin_amdgcn_s_barrier(); asm volatile("" ::: "memory");
}

constexpr int NPH = 8;
__global__ void __launch_bounds__(512, 2) mk_fwd(Args args) {
    extern __shared__ __attribute__((aligned(16))) unsigned char lds_raw[];
    Frame F;
    F.lds = (LAS unsigned char*)lds_raw;
    F.tid = threadIdx.x; F.lane = F.tid & 63; F.wave = __builtin_amdgcn_readfirstlane(F.tid >> 6);
    F.G = gridDim.x; { const int bx = blockIdx.x; F.vcu = (F.G % 8 == 0) ? (bx % 8) * (F.G / 8) + bx / 8 : bx; }
    unsigned char* ws = args.ws;
    unsigned* ctl = (unsigned*)(ws + WS_CTL);
    for (int u = F.tid; u < (LDS_BYTES - LDSCTL_OFF) / 4; u += 512) ((LAS unsigned*)(F.lds + LDSCTL_OFF))[u] = 0u;
    __syncthreads();
    XcdBarrier bar; bar.bar = ctl + 4096; bar.x = 0; bar.st = nullptr;
    if (MK_N_LAUNCHES == 1) bar = xcd_barrier_post(ctl + 4096, (volatile LAS unsigned*)(F.lds + MISC_OFF) + 8);
    const int lo = args.ph_lo, hi = args.ph_hi;
#ifndef MK_PHASE_MASK
#define MK_PHASE_MASK 255
#endif
#define IN(k) (((MK_PHASE_MASK >> (k)) & 1) && lo <= (k) && (k) < hi)
#ifndef MK_REP_MASK
#define MK_REP_MASK 0
#endif
#define REP(k) for (int rep_ = 0; rep_ < 1 + ((MK_REP_MASK >> (k)) & 1); ++rep_)
#define SEAM(k) do { if (IN(k) && IN((k) + 1)) xcd_barrier(bar); } while (0)

    const float* x = args.in[0]; const float* cnd = args.in[1]; const float* w_ada = args.in[2]; const float* b_ada = args.in[3]; const float* mix_g = args.in[4];
    const float* w_in = args.in[5]; const float* q_g = args.in[6]; const float* k_g = args.in[7]; const float* relb = args.in[8]; const float* gm_g = args.in[9];
    const float* w_sp = args.in[10]; const float* b_sp = args.in[11]; const float* ao_g = args.in[12]; const float* go_g = args.in[13]; const float* w_out = args.in[14];
    const float* ff_g = args.in[15]; const float* w_f1 = args.in[16]; const float* w_f2 = args.in[17];
    float* out = args.out;
    float* MOD = (float*)(ws + WS_MOD); float* SSA = (float*)(ws + WS_SSA); float* SSG = (float*)(ws + WS_SSG);
    bf16_t* WSP = (bf16_t*)(ws + WS_WSP); bf16_t* WIN = (bf16_t*)(ws + WS_WIN); bf16_t* WOUT = (bf16_t*)(ws + WS_WOUT); bf16_t* WF1 = (bf16_t*)(ws + WS_WF1); bf16_t* WF2 = (bf16_t*)(ws + WS_WF2);
    bf16_t* H = (bf16_t*)(ws + WS_H); bf16_t* QB = (bf16_t*)(ws + WS_Q); bf16_t* KB = (bf16_t*)(ws + WS_K); bf16_t* VB = (bf16_t*)(ws + WS_V); bf16_t* UB = (bf16_t*)(ws + WS_U); bf16_t* ZB = (bf16_t*)(ws + WS_ZN);
    bf16_t* MIX = (bf16_t*)(ws + WS_MIX); bf16_t* ACT = (bf16_t*)(ws + WS_ACT); bf16_t* X1 = (bf16_t*)(ws + WS_X1);
    const int gw = F.vcu * 8 + F.wave, NGW = F.G * 8;

    if (IN(0)) REP(0) {
        p0_ada(F, cnd, w_ada, b_ada, MOD);
        constexpr int I_IN = (DM / 64) * (INW / 32), I_OUT = (DM / 64) * (DM / 32), I_F1 = (DM / 64) * (DFF / 32), I_F2 = (DFF / 64) * (DM / 32), I_SP = 64;
        auto mk = [&](int it) { TrItem t; int r = it;
            if (r < I_IN) { t = TrItem{w_in, WIN, DM, INW, r, nullptr, nullptr}; return t; } r -= I_IN;
            if (r < I_OUT) { t = TrItem{w_out, WOUT, DM, DM, r, ao_g, go_g}; return t; } r -= I_OUT;
            if (r < I_F1) { t = TrItem{w_f1, WF1, DM, DFF, r, nullptr, nullptr}; return t; } r -= I_F1;
            t = TrItem{w_f2, WF2, DFF, DM, r, nullptr, nullptr}; return t; };
        constexpr int NTR = I_IN + I_OUT + I_F1 + I_F2;
        for (int it = gw; it < NTR; it += 2 * NGW) {
            const TrItem ta = mk(it); f32x4 va[8], vb[8]; tr_load(ta, F.lane, va);
            const int it2 = it + NGW; TrItem tb = ta; if (it2 < NTR) { tb = mk(it2); tr_load(tb, F.lane, vb); }
            tr_store(ta, F.lane, va); if (it2 < NTR) tr_store(tb, F.lane, vb);
        }
        for (int r = gw; r < I_SP; r += NGW) {
#pragma unroll
            for (int i = 0; i < 8; ++i) { const int e = r * 2048 + (i * 64 + F.lane) * 4, t = (e >> 7) & 127, s = e & 127;
                f32x4 v = *(const f32x4*)(w_sp + e); if ((t >> 6) < (s >> 6)) v = (f32x4){0.f, 0.f, 0.f, 0.f};
                u32x2 w; w.x = cvtpk(v[0], v[1]); w.y = cvtpk(v[2], v[3]); *(u32x2*)(WSP + e) = w; }
        }
    }
    SEAM(0);

    if (IN(1)) REP(1) {
        for (int m = gw; m < MROWS; m += 2 * NGW) { const int m2 = m + NGW; f32x4 va[8], vb[8];
            nm_load(x + (size_t)m * DM, F.lane, va); if (m2 < MROWS) nm_load(x + (size_t)m2 * DM, F.lane, vb);
            { const float* mb = MOD + (size_t)(m >> 11) * NMOD; nm_finish(va, mix_g, mb, mb + DM, H, m, F.lane); }
            if (m2 < MROWS) { const float* mb = MOD + (size_t)(m2 >> 11) * NMOD; nm_finish(vb, mix_g, mb, mb + DM, H, m2, F.lane); } }
    }
    SEAM(1);

    if (IN(2)) REP(2) {
        pg8::Gemm g{H, WIN, MROWS, INW, DM}; pg8::StaticOrder S; S.init(MROWS, INW, F.G, (int)blockIdx.x, 4);
        pg8::EpiProj E{QB, (size_t)(WS_K - WS_Q) / 2, q_g, k_g, gm_g, (LAS float*)(F.lds + XCH_OFF)};
        pg8::gemm_phase<pg8::EpiProj, pg8::StaticOrder>(F.lds, g, S, E);
    }
    SEAM(2);

    if (IN(3)) REP(3) {
        for (int u = F.vcu; u < NBATCH * NH * 8; u += F.G) { const int g4 = u & 7, h = (u >> 3) & 7, b = u >> 6;
            attn_unit(F, QB, KB, VB, MIX, SSA, relb, b, h, g4); }
        gmlp_phase(F, UB, ZB, WSP, b_sp, MIX, SSG);
    }
    SEAM(3);

    if (IN(4)) REP(4) {
        pg8::Gemm g{MIX, WOUT, MROWS, DM, DM}; pg8::StaticOrder S; S.init(MROWS, DM, F.G, (int)blockIdx.x, 4);
        pg8::EpiRes1 E{x, X1, MOD, SSA, SSG, (LAS float*)(F.lds + XCH_OFF)};
        { pg8::Unit uu; for (int i = F.tid >> 8; i < 4 && S.next(i, uu); i += 2) E.fill(uu, i, F.tid & 255); }
        __syncthreads();
        pg8::gemm_phase<pg8::EpiRes1, pg8::StaticOrder>(F.lds, g, S, E);
    }
    SEAM(4);

    if (IN(5)) REP(5) {
        for (int m = gw; m < MROWS; m += 4 * NGW) { u32x4 ra[4][4];
#pragma unroll
            for (int q = 0; q < 4; ++q) { const int mq = m + q * NGW; if (mq < MROWS) nmb_load(X1 + (size_t)mq * DM, F.lane, ra[q]); }
#pragma unroll
            for (int q = 0; q < 4; ++q) { const int mq = m + q * NGW; if (mq < MROWS) { const float* mb = MOD + (size_t)(mq >> 11) * NMOD; nmb_finish(ra[q], ff_g, mb + 3 * DM, mb + 4 * DM, H, mq, F.lane); } } }
    }
    SEAM(5);

    if (IN(6)) REP(6) {
        pg8::Gemm g{H, WF1, MROWS, DFF, DM}; pg8::StaticOrder S; S.init(MROWS, DFF, F.G, (int)blockIdx.x, 4);
        pg8::EpiRelu2 E{ACT, DFF};
        pg8::gemm_phase<pg8::EpiRelu2, pg8::StaticOrder>(F.lds, g, S, E);
    }
    SEAM(6);

    if (IN(7)) REP(7) {
        pg8::Gemm g{ACT, WF2, MROWS, DM, DFF}; pg8::StaticOrder S; S.init(MROWS, DM, F.G, (int)blockIdx.x, 4);
        pg8::EpiRes2 E{X1, out, MOD};
        pg8::gemm_phase<pg8::EpiRes2, pg8::StaticOrder>(F.lds, g, S, E);
    }
#undef IN
#undef SEAM
}

extern "C" void kernel_launch(void* const* d_in, const int* in_sizes, int n_in, void* d_out, int out_size, void* d_ws, size_t ws_size, hipStream_t stream) {
    static int grid = 0;
    if (grid == 0) {
        if (n_in != 18 || in_sizes[0] != MROWS * DM || out_size != MROWS * DM || ws_size < WS_END) {
            fprintf(stderr, "kernel_launch: unexpected shapes (n_in %d, in0 %d, out %d, ws %zu); nothing launched\n", n_in, n_in > 0 ? in_sizes[0] : -1, out_size, ws_size); grid = -1; return; }
        int dev = 0, cus = 0, per_cu = 0;
        if (hipGetDevice(&dev) != hipSuccess || hipDeviceGetAttribute(&cus, hipDeviceAttributeMultiprocessorCount, dev) != hipSuccess) { fprintf(stderr, "kernel_launch: device query failed\n"); grid = -1; return; }
        if (hipFuncSetAttribute((const void*)mk_fwd, hipFuncAttributeMaxDynamicSharedMemorySize, LDS_BYTES) != hipSuccess) { fprintf(stderr, "kernel_launch: hipFuncSetAttribute failed\n"); grid = -1; return; }
        if (hipOccupancyMaxActiveBlocksPerMultiprocessor(&per_cu, (const void*)mk_fwd, 512, LDS_BYTES) != hipSuccess || per_cu < 1) {
            fprintf(stderr, "kernel_launch: occupancy query reports %d workgroups per CU\n", per_cu); per_cu = 1; }
        (void)hipGetLastError();
        grid = cus;
    }
    if (grid < 0) return;
    (void)hipMemsetAsync((char*)d_ws + WS_CTL, 0, CTL_ZERO_BYTES, stream);
    Args a{};
    for (int i = 0; i < 18; ++i) a.in[i] = (const float*)d_in[i];
    a.out = (float*)d_out; a.ws = (unsigned char*)d_ws;
#ifndef MK_PROG
#define MK_PROG {0, 1, 2, 3, 4, 5, 6, 7}
#endif
    static const int prog[] = MK_PROG; const int nprog = (MK_N_LAUNCHES == 1) ? 1 : (int)(sizeof(prog) / sizeof(prog[0]));
    for (int li = 0; li < nprog; ++li) {
        if (MK_N_LAUNCHES == 1) { a.ph_lo = 0; a.ph_hi = NPH; } else { a.ph_lo = prog[li]; a.ph_hi = prog[li] + 1; }
        a.li = li;
        hipLaunchKernelGGL(mk_fwd, dim3(grid), dim3(512), LDS_BYTES, stream, a);
        const hipError_t le = hipPeekAtLastError();
        if (le != hipSuccess) { fprintf(stderr, "kernel_launch: launch %d failed: %s\n", li, hipGetErrorName(le)); break; }
    }
}
```

```cpp
#include <hip/hip_runtime.h>
#include <cstdio>
#include <cstdint>

#ifndef MK_N_LAUNCHES
#define MK_N_LAUNCHES 1
#endif

#ifndef MK_SP2
#define MK_SP2 1
#endif
#ifndef MK_ALIGN
#define MK_ALIGN true
#endif
#define LAS __attribute__((address_space(3)))
#define GAS __attribute__((address_space(1)))
typedef unsigned short bf16_t;
typedef short bf16x8 __attribute__((ext_vector_type(8)));
typedef short v4i16_t __attribute__((ext_vector_type(4)));
typedef float f32x4 __attribute__((ext_vector_type(4)));
typedef float f32x2 __attribute__((ext_vector_type(2)));
typedef float f32x16 __attribute__((ext_vector_type(16)));
typedef unsigned u32x4 __attribute__((ext_vector_type(4)));
typedef unsigned u32x2 __attribute__((ext_vector_type(2)));
typedef __bf16 bf16x2_t __attribute__((ext_vector_type(2)));

constexpr int DM = 2048, NBATCH = 8, SEQ = 2048, MROWS = NBATCH * SEQ;
constexpr int AW = 1024, NH = 8, HD = 128, INW = 5120, DFF = 8192, NMOD = 6 * DM;
constexpr int CHUNK = 64, LEFT = 8, MAXREL = 128, NREL = 2 * MAXREL + 1;
constexpr float EPS = 1e-6f;
constexpr float LOG2E = 1.4426950408889634f;
constexpr float QSCALE = 0.08838834764831845f * LOG2E;

constexpr size_t MiB = 1u << 20;
constexpr size_t WS_CTL = 0, CTL_ZERO_BYTES = 64 * 1024;
constexpr size_t WS_MOD = 1 * MiB;
constexpr size_t WS_SSA = 2 * MiB;
constexpr size_t WS_SSG = 3 * MiB;
constexpr size_t WS_WSP = 6 * MiB;
constexpr size_t WS_WIN = 8 * MiB, WS_WOUT = 28 * MiB, WS_WF1 = 36 * MiB, WS_WF2 = 68 * MiB;
constexpr size_t WS_H = 100 * MiB;
constexpr size_t WS_Q = 164 * MiB, WS_K = 196 * MiB, WS_V = 228 * MiB, WS_U = 260 * MiB, WS_ZN = 292 * MiB;
constexpr size_t WS_MIX = 324 * MiB;
constexpr size_t WS_ACT = 164 * MiB;
constexpr size_t WS_X1 = 420 * MiB;
constexpr size_t WS_END = 484 * MiB;

constexpr int RING_BYTES = 131072;
constexpr int XCH_OFF = RING_BYTES;
constexpr int LDSCTL_OFF = RING_BYTES + 8192, MISC_OFF = LDSCTL_OFF + 320;
constexpr int LDS_BYTES = 147456;

__device__ __forceinline__ unsigned cvtpk(float lo, float hi) { f32x2 v = {lo, hi}; bf16x2_t b = __builtin_convertvector(v, bf16x2_t); return __builtin_bit_cast(unsigned, b); }
__device__ __forceinline__ float bf2f(unsigned short h) { return __uint_as_float((unsigned)h << 16); }
__device__ __forceinline__ float wave_sum(float v) {
#pragma unroll
    for (int o = 1; o < 64; o <<= 1) v += __shfl_xor(v, o);
    return v;
}
__device__ __forceinline__ f32x2 gelu_pk(f32x2 v) {
    const f32x2 av = __builtin_elementwise_abs(v), d = av * 0.2316418882f + 1.0f;
    f32x2 t; t.x = __builtin_amdgcn_rcpf(d.x); t.y = __builtin_amdgcn_rcpf(d.y);
    f32x2 q = t * 0.5307027145f + (-0.7265760135f); q = q * t + 0.7107068705f; q = q * t + (-0.142248368f); q = q * t + 0.127414796f; q = q * t;
    const f32x2 s = (v * v) * (-0.72134752044f);
    f32x2 e; e.x = __builtin_amdgcn_exp2f(s.x); e.y = __builtin_amdgcn_exp2f(s.y);
    const f32x2 m = v * (q * e), r = v - m;
    f32x2 o; o.x = v.x < 0.f ? m.x : r.x; o.y = v.y < 0.f ? m.y : r.y; return o;
}
__device__ __forceinline__ f32x4 gelu4(f32x4 v) { const f32x2 a = gelu_pk((f32x2){v[0], v[1]}), b = gelu_pk((f32x2){v[2], v[3]}); return (f32x4){a.x, a.y, b.x, b.y}; }

__host__ __device__ __forceinline__ size_t blk_off(size_t row, int k, int K) { return (row >> 8) * ((size_t)256 * K) + (size_t)(k >> 6) * 16384 + (row & 255) * 64 + (k & 63); }

namespace pg8 {
constexpr int BM = 256, BK = 64, HALF = 128, HTB = HALF * BK * 2, STAGE_BYTES = 8 * HTB, NXCD = 8;
__host__ __device__ __forceinline__ int lds_byte(int r, int c) { return r * 128 + ((((c >> 3) ^ (r >> 1)) & 7) << 4) + (c & 7) * 2; }
__host__ __device__ __forceinline__ void stage_rc(int b, int& R, int& C) { R = b >> 7; C = ((((b >> 4) & 7) ^ (R >> 1)) & 7) * 8; }
__host__ __device__ __forceinline__ int perm32(int rho) { const int n = rho >> 4, i = rho & 15; return 8 * (i >> 2) + 4 * n + (i & 3); }

struct Unit { int pm, pn; };
struct Gemm { const bf16_t* A; const bf16_t* Bt; int M, N, K; };

struct StaticOrder {
    int nM, nN, nwg, G, c, WGM;
    __device__ void init(int M, int N, int G_, int c_, int wgm) { nM = M / BM; nN = N / BM; nwg = nM * nN; G = G_; c = c_; WGM = wgm; }
    __device__ bool next(int i, Unit& u) const {
        const long L = (long)i * G + c; if (L >= nwg) return false;
        int wgid = (int)L; { const int q = nwg / NXCD, r = nwg % NXCD, xcd = wgid % NXCD, off = wgid / NXCD; wgid = (xcd < r ? xcd * (q + 1) : r * (q + 1) + (xcd - r) * q) + off; }
        const int nig = WGM * nN, gid = wgid / nig, fm = gid * WGM, gsz = (nM - fm) < WGM ? (nM - fm) : WGM;
        u.pm = fm + ((wgid % nig) % gsz); u.pn = (wgid % nig) / gsz; return true;
    }
};

#define PG8_BARRIER() do { asm volatile("s_waitcnt lgkmcnt(0)" ::: "memory"); __builtin_amdgcn_s_barrier(); asm volatile("" ::: "memory"); } while (0)

struct EpiProj {
    static constexpr bool PERM = true, HOOKS = false, ALIGN = true; static constexpr int MIDT = 0;
    bf16_t* base;
    size_t tstride;
    const float *qg, *kg, *zg;
    LAS float* xch;
    __device__ __forceinline__ void begin(const Unit&, int, int) const {}
    __device__ __forceinline__ void mid(f32x4 (&)[2][2][4][2], int, int, int) const {}
    __device__ __forceinline__ void operator()(f32x4 (&acc)[2][2][4][2], const Unit& u, int ui, int wr, int wc, int fr, int fq) const {
        const int type = u.pn >> 2, colt = (u.pn & 3) * 256;
        bf16_t* O = base + (size_t)type * tstride;
        const int row0 = u.pm * BM + wr * 64 + fr, col0 = colt + wc * 32 + 8 * fq;
        if (type >= 3) {
#pragma unroll
            for (int ai = 0; ai < 2; ++ai)
#pragma unroll
                for (int bj = 0; bj < 2; ++bj)
#pragma unroll
                    for (int m = 0; m < 4; ++m)
#pragma unroll
                        for (int n = 0; n < 2; ++n) acc[ai][bj][m][n] = gelu4(acc[ai][bj][m][n]);
        }
        if (type == 0 || type == 1 || type == 4) {
#pragma unroll
            for (int ai = 0; ai < 2; ++ai)
#pragma unroll
                for (int m = 0; m < 4; ++m)
#pragma unroll
                    for (int bj = 0; bj < 2; ++bj) {
                        const f32x4 a = acc[ai][bj][m][0], b = acc[ai][bj][m][1];
                        float s = (a[0] * a[0] + a[1] * a[1]) + (a[2] * a[2] + a[3] * a[3]) + (b[0] * b[0] + b[1] * b[1]) + (b[2] * b[2] + b[3] * b[3]);
                        s += __shfl_xor(s, 16); s += __shfl_xor(s, 32);
                        if (fq == 0) xch[((ai * HALF + wr * 64 + m * 16 + fr) * 2 + bj) * 4 + wc] = s;
                    }
            PG8_BARRIER();
            const float* gp = type == 0 ? qg : (type == 1 ? kg : zg + (u.pn & 3) * 256);
            const float sc = type == 0 ? QSCALE : 1.0f;
            f32x4 gv[2][2];
#pragma unroll
            for (int bj = 0; bj < 2; ++bj)
#pragma unroll
                for (int n = 0; n < 2; ++n) gv[bj][n] = *(const f32x4*)(gp + (type == 4 ? bj * 128 : 0) + wc * 32 + 8 * fq + 4 * n) * sc;
#pragma unroll
            for (int ai = 0; ai < 2; ++ai)
#pragma unroll
                for (int m = 0; m < 4; ++m)
#pragma unroll
                    for (int bj = 0; bj < 2; ++bj) {
                        const f32x4 p = *(const LAS f32x4*)(xch + ((ai * HALF + wr * 64 + m * 16 + fr) * 2 + bj) * 4);
                        const float rinv = 1.0f / sqrtf(((p[0] + p[1]) + (p[2] + p[3])) * (1.0f / 128.0f) + EPS);
                        acc[ai][bj][m][0] = acc[ai][bj][m][0] * rinv * gv[bj][0]; acc[ai][bj][m][1] = acc[ai][bj][m][1] * rinv * gv[bj][1];
                    }
        }
#pragma unroll
        for (int ai = 0; ai < 2; ++ai)
#pragma unroll
            for (int m = 0; m < 4; ++m) { bf16_t* rowp = O + (size_t)(row0 + ai * HALF + m * 16) * AW + col0;
#pragma unroll
                for (int bj = 0; bj < 2; ++bj) { const f32x4 v0 = acc[ai][bj][m][0], v1 = acc[ai][bj][m][1];
                    u32x4 w; w.x = cvtpk(v0[0], v0[1]); w.y = cvtpk(v0[2], v0[3]); w.z = cvtpk(v1[0], v1[1]); w.w = cvtpk(v1[2], v1[3]);
                    *(u32x4*)(rowp + bj * HALF) = w; } }
    }
};

struct EpiRes1 {
    static constexpr bool PERM = true, HOOKS = true, ALIGN = MK_ALIGN; static constexpr int MIDT = 16;
    const float* x; bf16_t* x1; const float* mod;
    const float *ssa, *ssg;
    LAS float* rt;
    __device__ __forceinline__ void begin(const Unit&, int, int) const {}
    __device__ __forceinline__ void fill(const Unit& u, int ui, int row) const {
        const size_t gr = (size_t)u.pm * BM + row;
        const f32x4 a0 = *(const f32x4*)(ssa + gr * 8), a1 = *(const f32x4*)(ssa + gr * 8 + 4);
        const float sa = ((a0[0] + a0[1]) + (a0[2] + a0[3])) + ((a1[0] + a1[1]) + (a1[2] + a1[3]));
        const f32x4 a = *(const f32x4*)(ssg + gr * 16), b = *(const f32x4*)(ssg + gr * 16 + 4), c = *(const f32x4*)(ssg + gr * 16 + 8), d = *(const f32x4*)(ssg + gr * 16 + 12);
        const float sg = (((a[0] + a[1]) + (a[2] + a[3])) + ((b[0] + b[1]) + (b[2] + b[3]))) + (((c[0] + c[1]) + (c[2] + c[3])) + ((d[0] + d[1]) + (d[2] + d[3])));
        const float ra = 1.0f / sqrtf(sa * (1.0f / 1024.0f) + EPS), rg = 1.0f / sqrtf(sg * (1.0f / 1024.0f) + EPS);
        *(LAS f32x2*)(rt + ((ui & 3) * 256 + row) * 2) = (f32x2){ra / rg, rg};
    }
    __device__ __forceinline__ void mid(f32x4 (&acc)[2][2][4][2], int ui, int wr, int fr) const {
#pragma unroll
        for (int ai = 0; ai < 2; ++ai)
#pragma unroll
            for (int m = 0; m < 4; ++m) { const float f = rt[((ui & 3) * 256 + ai * HALF + wr * 64 + m * 16 + fr) * 2];
#pragma unroll
                for (int bj = 0; bj < 2; ++bj)
#pragma unroll
                    for (int n = 0; n < 2; ++n) acc[ai][bj][m][n] = acc[ai][bj][m][n] * f; }
    }
    __device__ __forceinline__ void operator()(f32x4 (&acc)[2][2][4][2], const Unit& u, int ui, int wr, int wc, int fr, int fq) const {
        const int row0 = u.pm * BM + wr * 64 + fr, col0 = u.pn * BM + wc * 32 + 8 * fq;
        const float* gp = mod + (size_t)(u.pm >> 3) * NMOD + 2 * DM + col0;
        f32x4 gv[2][2];
#pragma unroll
        for (int bj = 0; bj < 2; ++bj)
#pragma unroll
            for (int n = 0; n < 2; ++n) gv[bj][n] = *(const f32x4*)(gp + bj * HALF + n * 4);
#pragma unroll
        for (int ai = 0; ai < 2; ++ai)
#pragma unroll
            for (int m = 0; m < 4; ++m) { const size_t off = (size_t)(row0 + ai * HALF + m * 16) * DM + col0;
                const float rg = rt[((ui & 3) * 256 + ai * HALF + wr * 64 + m * 16 + fr) * 2 + 1];
#pragma unroll
                for (int bj = 0; bj < 2; ++bj) {
                    const f32x4 x0 = *(const f32x4*)(x + off + bj * HALF), xb = *(const f32x4*)(x + off + bj * HALF + 4);
                    const f32x4 v0 = x0 + gv[bj][0] * (acc[ai][bj][m][0] * rg), v1 = xb + gv[bj][1] * (acc[ai][bj][m][1] * rg);
                    u32x4 w; w.x = cvtpk(v0[0], v0[1]); w.y = cvtpk(v0[2], v0[3]); w.z = cvtpk(v1[0], v1[1]); w.w = cvtpk(v1[2], v1[3]);
                    *(u32x4*)(x1 + off + bj * HALF) = w; } }
    }
};

struct EpiRelu2 {
    static constexpr bool PERM = true, HOOKS = false, ALIGN = MK_ALIGN; static constexpr int MIDT = 0;
    bf16_t* O; int ldc;
    __device__ __forceinline__ void begin(const Unit&, int, int) const {}
    __device__ __forceinline__ void mid(f32x4 (&)[2][2][4][2], int, int, int) const {}
    __device__ __forceinline__ void operator()(f32x4 (&acc)[2][2][4][2], const Unit& u, int ui, int wr, int wc, int fr, int fq) const {
        const int row0 = u.pm * BM + wr * 64 + fr, col0 = u.pn * BM + wc * 32 + 8 * fq;
#pragma unroll
        for (int ai = 0; ai < 2; ++ai)
#pragma unroll
            for (int m = 0; m < 4; ++m) { bf16_t* rowp = O + blk_off((size_t)(row0 + ai * HALF + m * 16), col0, ldc);
#pragma unroll
                for (int bj = 0; bj < 2; ++bj) { f32x4 v0 = acc[ai][bj][m][0], v1 = acc[ai][bj][m][1];
                    v0 = __builtin_elementwise_max(v0, (f32x4){0.f, 0.f, 0.f, 0.f}); v1 = __builtin_elementwise_max(v1, (f32x4){0.f, 0.f, 0.f, 0.f}); v0 = v0 * v0; v1 = v1 * v1;
                    u32x4 w; w.x = cvtpk(v0[0], v0[1]); w.y = cvtpk(v0[2], v0[3]); w.z = cvtpk(v1[0], v1[1]); w.w = cvtpk(v1[2], v1[3]);
                    *(u32x4*)(rowp + bj * 2 * 16384) = w; } }
    }
};

struct EpiRes2 {
    static constexpr bool PERM = false, HOOKS = false, ALIGN = MK_ALIGN; static constexpr int MIDT = 0;
    const bf16_t* x1; float* out; const float* mod;
    __device__ __forceinline__ void begin(const Unit&, int, int) const {}
    __device__ __forceinline__ void mid(f32x4 (&)[2][2][4][2], int, int, int) const {}
    __device__ __forceinline__ void operator()(f32x4 (&acc)[2][2][4][2], const Unit& u, int ui, int wr, int wc, int fr, int fq) const {
        const int row0 = u.pm * BM + wr * 64 + fr, col0 = u.pn * BM + wc * 32 + 4 * fq;
        const float* gp = mod + (size_t)(u.pm >> 3) * NMOD + 5 * DM + col0;
        f32x4 gv[2][2];
#pragma unroll
        for (int bj = 0; bj < 2; ++bj)
#pragma unroll
            for (int n = 0; n < 2; ++n) gv[bj][n] = *(const f32x4*)(gp + bj * HALF + n * 16);
#pragma unroll
        for (int ai = 0; ai < 2; ++ai)
#pragma unroll
            for (int m = 0; m < 4; ++m) { const size_t off = (size_t)(row0 + ai * HALF + m * 16) * DM + col0;
#pragma unroll
                for (int bj = 0; bj < 2; ++bj)
#pragma unroll
                    for (int n = 0; n < 2; ++n) { const u32x2 xr = *(const u32x2*)(x1 + off + bj * HALF + n * 16);
                        const f32x4 xv = (f32x4){__uint_as_float(xr.x << 16), __uint_as_float(xr.x & 0xffff0000u), __uint_as_float(xr.y << 16), __uint_as_float(xr.y & 0xffff0000u)};
                        *(f32x4*)(out + off + bj * HALF + n * 16) = xv + gv[bj][n] * acc[ai][bj][m][n]; } }
    }
};

template <class Epi, class Sched>
__device__ __forceinline__ void gemm_phase(LAS unsigned char* lds, const Gemm g, const Sched& S, const Epi& E) {
    const int tid = threadIdx.x, wid = __builtin_amdgcn_readfirstlane(tid >> 6), lane = tid & 63, wr = wid >> 2, wc = wid & 3, fr = lane & 15, fq = lane >> 4;
    const int K = g.K, nt = K / BK;
    unsigned voffA[2], voffB[2];
#pragma unroll
    for (int i = 0; i < 2; ++i) { int R, C; stage_rc(tid * 16 + i * 8192, R, C); const int Rb = Epi::PERM ? ((R & ~31) + perm32(R & 31)) : R;
        voffA[i] = (unsigned)(R * 64 + C) * 2u; voffB[i] = (unsigned)(Rb * 64 + C) * 2u; }
    const size_t kstep = (size_t)(256 * BK * 2);
    const size_t hstep = (size_t)HALF * BK * 2;
    const size_t tstep = (size_t)256 * K * 2;
    const unsigned ldsw = (unsigned)wid * 1024u;
    const int aoff[2] = {lds_byte(wr * 64 + fr, fq * 8), lds_byte(wr * 64 + fr, 32 + fq * 8)}, boff[2] = {lds_byte(wc * 32 + fr, fq * 8), lds_byte(wc * 32 + fr, 32 + fq * 8)};
#define PG8_SA(b, h) (((b) * 2 + (h)) * HTB)
#define PG8_SB(b, h) ((4 + (b) * 2 + (h)) * HTB)
#define PG8_STAGE(bufoff, gbase, voff) do { _Pragma("unroll") for (int _i = 0; _i < 2; ++_i) \
        __builtin_amdgcn_global_load_lds((const unsigned*)((const char*)(gbase) + (voff)[_i]), (LAS unsigned*)(lds + (bufoff) + ldsw + _i * 8192), 16, 0, 0); } while (0)
#define PG8_LDA(dst, b, h) do { _Pragma("unroll") for (int m = 0; m < 4; ++m) _Pragma("unroll") for (int k = 0; k < 2; ++k) dst[m][k] = *(const LAS bf16x8*)(lds + PG8_SA(b, h) + aoff[k] + m * 2048); } while (0)
#define PG8_LDB(dst, b, h) do { _Pragma("unroll") for (int n = 0; n < 2; ++n) _Pragma("unroll") for (int k = 0; k < 2; ++k) dst[n][k] = *(const LAS bf16x8*)(lds + PG8_SB(b, h) + boff[k] + n * 2048); } while (0)
#define PG8_MMA(ai, bj, At, Bt) do { __builtin_amdgcn_s_setprio(1); _Pragma("unroll") for (int m = 0; m < 4; ++m) _Pragma("unroll") for (int n = 0; n < 2; ++n) _Pragma("unroll") for (int k = 0; k < 2; ++k) \
        acc[ai][bj][m][n] = __builtin_amdgcn_mfma_f32_16x16x32_bf16(Bt[n][k], At[m][k], acc[ai][bj][m][n], 0, 0, 0); __builtin_amdgcn_s_setprio(0); } while (0)
#define PG8_WAIT_V(n) asm volatile("s_waitcnt vmcnt(" #n ")" ::: "memory")
#define PG8_WAIT_L(n) asm volatile("s_waitcnt lgkmcnt(" #n ")" ::: "memory")
#define PG8_BAR __builtin_amdgcn_s_barrier()
#define PG8_SCHED __builtin_amdgcn_sched_barrier(0)
    Unit cur, nxt; int ui = 0;
    if (!S.next(0, cur)) return;
    f32x4 acc[2][2][4][2];
#pragma unroll
    for (int a = 0; a < 2; ++a)
#pragma unroll
        for (int b = 0; b < 2; ++b)
#pragma unroll
            for (int m = 0; m < 4; ++m)
#pragma unroll
                for (int n = 0; n < 2; ++n) acc[a][b][m][n] = (f32x4){0.f, 0.f, 0.f, 0.f};
    bf16x8 At[4][2], B0[2][2], B1[2][2];
    const char* cA = (const char*)g.A + (size_t)cur.pm * tstep; const char* cB = (const char*)g.Bt + (size_t)cur.pn * tstep;
#if MK_SP2
    PG8_STAGE(PG8_SB(0, 0), cB, voffB); PG8_STAGE(PG8_SB(0, 1), cB + hstep, voffB); PG8_STAGE(PG8_SA(0, 0), cA, voffA); PG8_STAGE(PG8_SA(0, 1), cA + hstep, voffA);
    if (wr == 1) PG8_BAR;
    PG8_WAIT_V(2); PG8_BAR;
    PG8_STAGE(PG8_SB(1, 0), cB + kstep, voffB); PG8_STAGE(PG8_SA(1, 0), cA + kstep, voffA); PG8_STAGE(PG8_SB(1, 1), cB + hstep + kstep, voffB);
    PG8_WAIT_V(6); PG8_BAR;
#else
    PG8_STAGE(PG8_SB(0, 0), cB, voffB); PG8_STAGE(PG8_SA(0, 0), cA, voffA); PG8_STAGE(PG8_SB(0, 1), cB + hstep, voffB); PG8_STAGE(PG8_SA(0, 1), cA + hstep, voffA);
    if (wr == 1) PG8_BAR;
    PG8_WAIT_V(4); PG8_BAR;
    PG8_STAGE(PG8_SB(1, 0), cB + kstep, voffB); PG8_STAGE(PG8_SA(1, 0), cA + kstep, voffA); PG8_STAGE(PG8_SB(1, 1), cB + hstep + kstep, voffB);
    PG8_WAIT_V(6); PG8_BAR;
#endif
    for (;;) {
        const bool has_next = S.next(ui + 1, nxt);
        const char* nA = has_next ? (const char*)g.A + (size_t)nxt.pm * tstep : cA; const char* nB = has_next ? (const char*)g.Bt + (size_t)nxt.pn * tstep : cB;
        for (int t = 0; t < nt; t += 2) {
            const bool last = (t == nt - 2);
            const char* a1 = cA + (size_t)(t + 1) * kstep;
            const char* a2 = last ? nA : cA + (size_t)(t + 2) * kstep; const char* b2 = last ? nB : cB + (size_t)(t + 2) * kstep;
            const char* a3 = a2 + kstep; const char* b3 = b2 + kstep;
            if constexpr (Epi::HOOKS) { if (t == Epi::MIDT) E.mid(acc, ui, wr, fr); }
#if MK_SP2
            PG8_LDB(B0, 0, 0); PG8_LDB(B1, 0, 1); PG8_SCHED; PG8_LDA(At, 0, 0); PG8_STAGE(PG8_SA(1, 1), a1 + hstep, voffA);
            PG8_WAIT_V(8); PG8_WAIT_L(0); PG8_BAR; PG8_MMA(0, 0, At, B0); PG8_MMA(0, 1, At, B1); PG8_BAR; PG8_SCHED;
            PG8_LDA(At, 0, 1); PG8_STAGE(PG8_SB(0, 0), b2, voffB); PG8_STAGE(PG8_SB(0, 1), b2 + hstep, voffB); PG8_STAGE(PG8_SA(0, 0), a2, voffA);
            PG8_WAIT_V(8); PG8_WAIT_L(0); PG8_BAR; PG8_MMA(1, 0, At, B0); PG8_MMA(1, 1, At, B1); PG8_BAR; PG8_SCHED;
            PG8_LDB(B0, 1, 0); PG8_LDB(B1, 1, 1); PG8_SCHED; PG8_LDA(At, 1, 0); PG8_STAGE(PG8_SA(0, 1), a2 + hstep, voffA);
            PG8_WAIT_V(8); PG8_WAIT_L(0); PG8_BAR; PG8_MMA(0, 0, At, B0); PG8_MMA(0, 1, At, B1); PG8_BAR; PG8_SCHED;
            PG8_LDA(At, 1, 1); PG8_STAGE(PG8_SB(1, 0), b3, voffB); PG8_STAGE(PG8_SB(1, 1), b3 + hstep, voffB); PG8_STAGE(PG8_SA(1, 0), a3, voffA);
            PG8_WAIT_V(8); PG8_WAIT_L(0); PG8_BAR; PG8_MMA(1, 0, At, B0); PG8_MMA(1, 1, At, B1); PG8_BAR; PG8_SCHED;
#else
            PG8_LDB(B0, 0, 0); PG8_SCHED; PG8_LDA(At, 0, 0); PG8_STAGE(PG8_SA(1, 1), a1 + hstep, voffA);
            PG8_WAIT_L(8); PG8_BAR; PG8_WAIT_L(0); PG8_MMA(0, 0, At, B0); PG8_BAR; PG8_SCHED;
            PG8_LDB(B1, 0, 1); PG8_STAGE(PG8_SB(0, 0), b2, voffB);
            PG8_BAR; PG8_WAIT_L(0); PG8_MMA(0, 1, At, B1); PG8_BAR;
            PG8_LDA(At, 0, 1); PG8_STAGE(PG8_SA(0, 0), a2, voffA);
            PG8_BAR; PG8_WAIT_L(0); PG8_MMA(1, 0, At, B0); PG8_BAR; PG8_SCHED;
            PG8_STAGE(PG8_SB(0, 1), b2 + hstep, voffB);
            PG8_WAIT_V(6); PG8_BAR; PG8_MMA(1, 1, At, B1); PG8_BAR;
            PG8_LDB(B0, 1, 0); PG8_SCHED; PG8_LDA(At, 1, 0); PG8_STAGE(PG8_SA(0, 1), a2 + hstep, voffA);
            PG8_WAIT_L(8); PG8_BAR; PG8_WAIT_L(0); PG8_MMA(0, 0, At, B0); PG8_BAR; PG8_SCHED;
            PG8_LDB(B1, 1, 1); PG8_STAGE(PG8_SB(1, 0), b3, voffB);
            PG8_BAR; PG8_WAIT_L(0); PG8_MMA(0, 1, At, B1); PG8_BAR;
            PG8_LDA(At, 1, 1); PG8_STAGE(PG8_SA(1, 0), a3, voffA);
            PG8_BAR; PG8_WAIT_L(0); PG8_MMA(1, 0, At, B0); PG8_BAR; PG8_SCHED;
            PG8_STAGE(PG8_SB(1, 1), b3 + hstep, voffB);
            PG8_WAIT_V(6); PG8_BAR; PG8_MMA(1, 1, At, B1); PG8_BAR;
#endif
        }
        if constexpr (Epi::ALIGN) { if (wr == 0) PG8_BAR; }
        E(acc, cur, ui, wr, wc, fr, fq);
        if (!has_next) break;
#pragma unroll
        for (int a = 0; a < 2; ++a)
#pragma unroll
            for (int b = 0; b < 2; ++b)
#pragma unroll
                for (int m = 0; m < 4; ++m)
#pragma unroll
                    for (int n = 0; n < 2; ++n) acc[a][b][m][n] = (f32x4){0.f, 0.f, 0.f, 0.f};
        cur = nxt; cA = nA; cB = nB; ++ui;
        if constexpr (Epi::ALIGN) { if (wr == 1) PG8_BAR; }
    }
    PG8_WAIT_V(0);
    if constexpr (!Epi::ALIGN) { if (wr == 0) PG8_BAR; }
    PG8_BAR;
#undef PG8_SA
#undef PG8_SB
#undef PG8_STAGE
#undef PG8_LDA
#undef PG8_LDB
#undef PG8_MMA
#undef PG8_WAIT_V
#undef PG8_WAIT_L
#undef PG8_BAR
#undef PG8_SCHED
}
}

typedef GAS unsigned gu32;
#define RLX_AGENT __ATOMIC_RELAXED, __HIP_MEMORY_SCOPE_AGENT
#define XB_TMO      128
#define XB_XCNT(j)  (256  + 64 * (j))
#define XB_XSUB(j)  (1280 + 64 * (j))
#define XB_XGEN(j)  (2304 + 64 * (j))
#define XB_TOP      3328
#define XB_TOPGEN   3392
#define XCD_BAR_WORDS 3456
#define XB_SPIN_CAP (1u << 20)
__device__ __forceinline__ unsigned xb_ld(unsigned* p)              { return __hip_atomic_load(p, __ATOMIC_RELAXED, __HIP_MEMORY_SCOPE_AGENT); }
__device__ __forceinline__ unsigned xb_add(unsigned* p, unsigned v) { return __hip_atomic_fetch_add(p, v, __ATOMIC_RELAXED, __HIP_MEMORY_SCOPE_AGENT); }
__device__ __forceinline__ unsigned xb_xcc_id() { return (unsigned)__builtin_amdgcn_s_getreg((3 << 11) | 20) & 0xFu; }
#define XB_SPIN(cond, bar) do { unsigned _sp = 0; while (cond) { __builtin_amdgcn_s_sleep(1); \
    if ((++_sp & 255u) == 0u) { if (xb_ld(&(bar)[XB_TMO])) break; if (_sp > XB_SPIN_CAP) { atomicAdd(&(bar)[XB_TMO], 1u); break; } } } } while (0)
struct XcdBarrier { unsigned* bar; unsigned x; volatile LAS unsigned* st; };
__device__ __forceinline__ XcdBarrier xcd_barrier_post(unsigned* bar, volatile LAS unsigned* st) {
    XcdBarrier b; b.bar = bar; b.x = xb_xcc_id(); b.st = st;
    if (threadIdx.x == 0) (void)xb_add(&bar[XB_XCNT(b.x)], 1u);
    return b;
}
__device__ __forceinline__ void xcd_barrier_complete(unsigned* bar, unsigned x, unsigned& nloc, unsigned& nx) {
    const unsigned G = gridDim.x * gridDim.y * gridDim.z;
    unsigned sum, cnt, mine, sp = 0u;
    for (;;) {
        sum = 0u; cnt = 0u; mine = 0u;
#pragma unroll
        for (unsigned j = 0; j < 16; ++j) { const unsigned c = xb_ld(&bar[XB_XCNT(j)]); sum += c; cnt += (c > 0u) ? 1u : 0u; mine = (j == x) ? c : mine; }
        if (sum == G) break;
        __builtin_amdgcn_s_sleep(1);
        if ((++sp & 255u) == 0u) { if (xb_ld(&bar[XB_TMO])) break; if (sp > XB_SPIN_CAP) { atomicAdd(&bar[XB_TMO], 1u); break; } }
    }
    nloc = mine > 0u ? mine : 1u; nx = cnt > 0u ? cnt : 1u;
}
__device__ __forceinline__ void xcd_barrier(const XcdBarrier& b) {
    asm volatile("s_waitcnt vmcnt(0)" ::: "memory");
    __syncthreads();
    if (threadIdx.x == 0) {
        unsigned* bar = b.bar;
        __builtin_amdgcn_s_waitcnt(0);
        unsigned nloc = b.st[0], nx = b.st[1];
        if (nloc == 0u) { xcd_barrier_complete(bar, b.x, nloc, nx); b.st[0] = nloc; b.st[1] = nx; }
        const unsigned old = xb_add(&bar[XB_XSUB(b.x)], 1u);
        const unsigned gen = old / nloc;
        if (old + 1u == (gen + 1u) * nloc) {
            __builtin_amdgcn_fence(__ATOMIC_RELEASE, "agent");
            asm volatile("s_waitcnt vmcnt(0)" ::: "memory");
            const unsigned og = xb_add(&bar[XB_TOP], 1u);
            const unsigned tg = og / nx;
            if (og + 1u == (tg + 1u) * nx) xb_add(&bar[XB_TOPGEN], 1u);
            else XB_SPIN(xb_ld(&bar[XB_TOPGEN]) == tg, bar);
            __builtin_amdgcn_fence(__ATOMIC_ACQUIRE, "agent");
            xb_add(&bar[XB_XGEN(b.x)], 1u);
            asm volatile("s_waitcnt vmcnt(0)" ::: "memory");
        } else {
            XB_SPIN(xb_ld(&bar[XB_XGEN(b.x)]) == gen, bar);
            __builtin_amdgcn_fence(__ATOMIC_ACQUIRE, "agent");
            asm volatile("s_waitcnt vmcnt(0)" ::: "memory");
        }
    }
    __syncthreads();
}

struct Args { const float* in[18]; float* out; unsigned char* ws; int ph_lo, ph_hi, li, pad; };
struct Frame {
    LAS unsigned char* lds;
    int tid, lane, wave, vcu, G;
};
#define LDS_WAIT() asm volatile("s_waitcnt lgkmcnt(0)" ::: "memory")

__device__ __forceinline__ void p0_ada(const Frame& F, const float* c, const float* w_ada, const float* b_ada, float* mod) {
    LAS float* sc = (LAS float*)F.lds;
    LAS float* part = (LAS float*)(F.lds + 65536);
    for (int i = F.tid; i < NBATCH * DM; i += 512) { const int b = i >> 11, k = i & 2047; const float v = c[i]; sc[k * 8 + b] = v / (1.0f + __expf(-v)); }
    __syncthreads();
    const int kk = F.lane / 12, c4 = F.lane % 12;
    for (int item = blockIdx.x; item < 256; item += F.G) {
        const int n0 = 48 * item, kb = 256 * F.wave;
        f32x4 acc[8];
#pragma unroll
        for (int b = 0; b < 8; ++b) acc[b] = (f32x4){0.f, 0.f, 0.f, 0.f};
        if (F.lane < 60) {
            const float* wp = w_ada + (size_t)(kb + kk) * NMOD + n0 + 4 * c4;
#pragma unroll 17
            for (int i = 0; i < 51; ++i) {
                const int k = kb + kk + 5 * i;
                const f32x4 w = __builtin_nontemporal_load((const f32x4*)(wp + (size_t)(5 * i) * NMOD));
                const f32x4 s0 = *(const LAS f32x4*)(sc + k * 8), s1 = *(const LAS f32x4*)(sc + k * 8 + 4);
                acc[0] += w * s0[0]; acc[1] += w * s0[1]; acc[2] += w * s0[2]; acc[3] += w * s0[3];
                acc[4] += w * s1[0]; acc[5] += w * s1[1]; acc[6] += w * s1[2]; acc[7] += w * s1[3];
            }
            if (kk == 0) {
                const int k = kb + 255;
                const f32x4 w = *(const f32x4*)(w_ada + (size_t)k * NMOD + n0 + 4 * c4);
                const f32x4 s0 = *(const LAS f32x4*)(sc + k * 8), s1 = *(const LAS f32x4*)(sc + k * 8 + 4);
                acc[0] += w * s0[0]; acc[1] += w * s0[1]; acc[2] += w * s0[2]; acc[3] += w * s0[3];
                acc[4] += w * s1[0]; acc[5] += w * s1[1]; acc[6] += w * s1[2]; acc[7] += w * s1[3];
            }
#pragma unroll
            for (int b = 0; b < 8; ++b) *(LAS f32x4*)(part + (F.wave * 5 + kk) * 384 + b * 48 + 4 * c4) = acc[b];
        }
        __syncthreads();
        if (F.tid < 384) { float s = 0.f;
#pragma unroll 8
            for (int j = 0; j < 40; ++j) s += part[j * 384 + F.tid];
            const int b = F.tid / 48, n = F.tid % 48; mod[(size_t)b * NMOD + n0 + n] = s + b_ada[n0 + n]; }
        __syncthreads();
    }
}

struct TrItem { const float* W; bf16_t* WT; int K, N, item; const float *ks0, *ks1; };
__device__ __forceinline__ void tr_load(const TrItem& t, int lane, f32x4 (&v)[8]) {
    const int nblk = t.N / 32, kb = t.item / nblk, nb = t.item % nblk, k0 = 64 * kb, n0 = 32 * nb, lc = lane & 7, lr = lane >> 3;
    const float* wp = t.W + (size_t)(k0 + 8 * lr) * t.N + n0 + 4 * lc;
#pragma unroll
    for (int i = 0; i < 8; ++i) v[i] = __builtin_nontemporal_load((const f32x4*)(wp + (size_t)i * t.N));
}
__device__ __forceinline__ void tr_store(const TrItem& t, int lane, f32x4 (&v)[8]) {
    const int nblk = t.N / 32, kb = t.item / nblk, nb = t.item % nblk, k0 = 64 * kb, n0 = 32 * nb, lc = lane & 7, lr = lane >> 3;
    if (t.ks0) { const int k = k0 + 8 * lr; const float* kp = k < 1024 ? t.ks0 + k : t.ks1 + (k - 1024); const f32x4 s0 = *(const f32x4*)kp, s1 = *(const f32x4*)(kp + 4);
        v[0] = v[0] * s0[0]; v[1] = v[1] * s0[1]; v[2] = v[2] * s0[2]; v[3] = v[3] * s0[3]; v[4] = v[4] * s1[0]; v[5] = v[5] * s1[1]; v[6] = v[6] * s1[2]; v[7] = v[7] * s1[3]; }
    bf16_t* op = t.WT + blk_off((size_t)(n0 + 4 * lc), k0 + 8 * lr, t.K);
#pragma unroll
    for (int e = 0; e < 4; ++e) { u32x4 o; o.x = cvtpk(v[0][e], v[1][e]); o.y = cvtpk(v[2][e], v[3][e]); o.z = cvtpk(v[4][e], v[5][e]); o.w = cvtpk(v[6][e], v[7][e]);
        *(u32x4*)(op + e * 64) = o; }
}
__device__ __forceinline__ void nm_load(const float* xrow, int lane, f32x4 (&v)[8]) {
    const f32x4* xr = (const f32x4*)xrow + lane;
#pragma unroll
    for (int j = 0; j < 8; ++j) v[j] = __builtin_nontemporal_load(xr + 64 * j);
}
__device__ __forceinline__ void nm_finish(f32x4 (&v)[8], const float* g, const float* shift, const float* scale, bf16_t* Hb, int m, int lane) {
    float s = 0.f;
#pragma unroll
    for (int j = 0; j < 8; ++j) s += (v[j][0] * v[j][0] + v[j][1] * v[j][1]) + (v[j][2] * v[j][2] + v[j][3] * v[j][3]);
    const float rinv = 1.0f / sqrtf(wave_sum(s) * (1.0f / DM) + EPS);
    bf16_t* ob = Hb + blk_off((size_t)m, 4 * lane, DM);
#pragma unroll
    for (int j = 0; j < 8; ++j) { const f32x4 gg = ((const f32x4*)g)[lane + 64 * j], sc = ((const f32x4*)scale)[lane + 64 * j], sh = ((const f32x4*)shift)[lane + 64 * j];
        const f32x4 o = (v[j] * rinv) * gg * (sc + 1.0f) + sh; u32x2 w; w.x = cvtpk(o[0], o[1]); w.y = cvtpk(o[2], o[3]); *(u32x2*)(ob + (size_t)j * 4 * 16384) = w; }
}
__device__ __forceinline__ void nmb_load(const bf16_t* xrow, int lane, u32x4 (&r)[4]) {
    const u32x4* xr = (const u32x4*)xrow + lane;
#pragma unroll
    for (int j = 0; j < 4; ++j) r[j] = xr[64 * j];
}
__device__ __forceinline__ void nmb_finish(const u32x4 (&r)[4], const float* g, const float* shift, const float* scale, bf16_t* Hb, int m, int lane) {
    f32x4 v[4][2]; float s = 0.f;
#pragma unroll
    for (int j = 0; j < 4; ++j) {
        v[j][0] = (f32x4){__uint_as_float(r[j].x << 16), __uint_as_float(r[j].x & 0xffff0000u), __uint_as_float(r[j].y << 16), __uint_as_float(r[j].y & 0xffff0000u)};
        v[j][1] = (f32x4){__uint_as_float(r[j].z << 16), __uint_as_float(r[j].z & 0xffff0000u), __uint_as_float(r[j].w << 16), __uint_as_float(r[j].w & 0xffff0000u)};
#pragma unroll
        for (int e = 0; e < 2; ++e) s += (v[j][e][0] * v[j][e][0] + v[j][e][1] * v[j][e][1]) + (v[j][e][2] * v[j][e][2] + v[j][e][3] * v[j][e][3]); }
    const float rinv = 1.0f / sqrtf(wave_sum(s) * (1.0f / DM) + EPS);
    bf16_t* ob = Hb + blk_off((size_t)m, 8 * lane, DM);
#pragma unroll
    for (int j = 0; j < 4; ++j) { u32x4 w;
#pragma unroll
        for (int e = 0; e < 2; ++e) { const int ci = 2 * lane + 128 * j + e;
            const f32x4 gg = ((const f32x4*)g)[ci], sc = ((const f32x4*)scale)[ci], sh = ((const f32x4*)shift)[ci];
            const f32x4 o = (v[j][e] * rinv) * gg * (sc + 1.0f) + sh; if (e == 0) { w.x = cvtpk(o[0], o[1]); w.y = cvtpk(o[2], o[3]); } else { w.z = cvtpk(o[0], o[1]); w.w = cvtpk(o[2], o[3]); } }
        *(u32x4*)(ob + (size_t)j * 8 * 16384) = w; }
}

__device__ __forceinline__ unsigned off_b(unsigned row, unsigned ch) { return 256u * row + 16u * (ch ^ (((row & 3) << 2) | ((row >> 2) & 3))); }
__device__ __forceinline__ v4i16_t vtr(LAS unsigned char* p) { return __builtin_amdgcn_ds_read_tr16_b64_v4i16((LAS v4i16_t*)p); }
__device__ __forceinline__ int crow(int r, int hi) { return (r & 3) + 8 * (r >> 2) + 4 * hi; }

constexpr int AT_BT = 0;
constexpr int AT_K = 2048, AT_V = AT_K + 2 * 16384, AT_Q = AT_V + 2 * 16384;
constexpr float ATT_THR = 6.0f;

__device__ __forceinline__ void attn_unit(const Frame& F, const bf16_t* Q, const bf16_t* Kg, const bf16_t* Vg, bf16_t* MIX, float* SSA, const float* relb, int b, int h, int g4) {
    LAS unsigned char* lds = F.lds;
    int lane_ = F.lane; asm volatile("" : "+v"(lane_));
    const int lane = lane_, wid = F.wave, tid = wid * 64 + lane, r32 = lane & 31, hi = lane >> 5;
    LAS float* bt = (LAS float*)(lds + AT_BT);
    if (tid < NREL) bt[tid] = relb[h * NREL + tid] * LOG2E;
    const int c = 4 * g4 + (wid >> 1);
    const int kc_lo = (4 * g4 - LEFT) > 0 ? (4 * g4 - LEFT) : 0, kc_hi = 4 * g4 + 3, nsteps = kc_hi - kc_lo + 1;
    const int drow = lane >> 4, dslot = lane & 15;
    { const size_t q0 = (size_t)b * SEQ + 64 * c + 32 * (wid & 1);
#pragma unroll
        for (int j = 0; j < 8; ++j) { const int row = 4 * j + drow, sch = dslot ^ (((row & 3) << 2) | ((row >> 2) & 3));
            __builtin_amdgcn_global_load_lds((const unsigned*)(Q + (q0 + row) * AW + h * HD + sch * 8), (LAS unsigned*)(lds + AT_Q + wid * 8192 + j * 1024), 16, 0, 0); } }
    const bf16_t* kp[2]; const bf16_t* vp[2];
#pragma unroll
    for (int j = 0; j < 2; ++j) { const int row = 8 * wid + 4 * j + drow, sch = dslot ^ (((row & 3) << 2) | ((row >> 2) & 3));
        const size_t go = ((size_t)b * SEQ + (size_t)kc_lo * CHUNK + row) * AW + h * HD + sch * 8; kp[j] = Kg + go; vp[j] = Vg + go; }
#define AT_DMA(buf) do { _Pragma("unroll") for (int j_ = 0; j_ < 2; ++j_) { \
        __builtin_amdgcn_global_load_lds((const unsigned*)kp[j_], (LAS unsigned*)(lds + AT_K + (buf) * 16384 + (2 * wid + j_) * 1024), 16, 0, 0); \
        __builtin_amdgcn_global_load_lds((const unsigned*)vp[j_], (LAS unsigned*)(lds + AT_V + (buf) * 16384 + (2 * wid + j_) * 1024), 16, 0, 0); \
        kp[j_] += (size_t)CHUNK * AW; vp[j_] += (size_t)CHUNK * AW; } } while (0)
    AT_DMA(0);
    unsigned ka[8];
#pragma unroll
    for (int ks = 0; ks < 8; ++ks) ka[ks] = off_b(r32, 2 * ks + hi);
    const unsigned blk = (lane >> 4) & 1, q4 = (lane & 15) >> 2, p4 = lane & 3;
    unsigned va[4][2];
#pragma unroll
    for (int dt = 0; dt < 4; ++dt)
#pragma unroll
        for (int tp = 0; tp < 2; ++tp) va[dt][tp] = off_b(4 * hi + q4 + 8 * tp, 4 * dt + 2 * blk + (p4 >> 1)) + 8 * (p4 & 1);
    LAS unsigned char* Qw = lds + AT_Q + wid * 8192;
    float m_run = 0.f, l_run = 0.f; bool first = true;
    f32x16 o[4];
#pragma unroll
    for (int dt = 0; dt < 4; ++dt) o[dt] = (f32x16){};
    const int qin = 32 * (wid & 1) + r32;
    for (int s = 0; s < nsteps; ++s) {
        const int kc = kc_lo + s, buf = s & 1;
        LAS unsigned char* Kb = lds + AT_K + buf * 16384; LAS unsigned char* Vb = lds + AT_V + buf * 16384;
        asm volatile("s_waitcnt vmcnt(0) lgkmcnt(0)" ::: "memory"); __builtin_amdgcn_s_barrier(); asm volatile("" ::: "memory");
        if (s + 1 < nsteps) AT_DMA(buf ^ 1);
        const int delta = c - kc;
        if (delta >= 0 && delta <= LEFT) {
            f32x16 sc[2];
            if (delta >= 3) { const float bc = bt[2 * MAXREL] - m_run;
#pragma unroll
                for (int r = 0; r < 16; ++r) { sc[0][r] = bc; sc[1][r] = bc; }
            } else {
#pragma unroll
                for (int t = 0; t < 2; ++t) { const int lb = 64 * delta + qin - 32 * t - 4 * hi + MAXREL;
#pragma unroll
                    for (int r = 0; r < 16; ++r) { int idx = lb - ((r & 3) + 8 * (r >> 2)); idx = idx > 2 * MAXREL ? 2 * MAXREL : idx; sc[t][r] = bt[idx] - m_run; } }
            }
            {
                bf16x8 fq[2][2], fk0[2][2], fk1[2][2];
#define AT_LDG(set, g) do { _Pragma("unroll") for (int e_ = 0; e_ < 2; ++e_) { const int ks_ = 2 * (g) + e_; \
                    fq[set][e_] = *(const LAS bf16x8*)(Qw + ka[ks_]); fk0[set][e_] = *(const LAS bf16x8*)(Kb + ka[ks_]); fk1[set][e_] = *(const LAS bf16x8*)(Kb + ka[ks_] + 8192); } } while (0)
#define AT_MMG(set) do { _Pragma("unroll") for (int e_ = 0; e_ < 2; ++e_) { \
                    sc[0] = __builtin_amdgcn_mfma_f32_32x32x16_bf16(fk0[set][e_], fq[set][e_], sc[0], 0, 0, 0); sc[1] = __builtin_amdgcn_mfma_f32_32x32x16_bf16(fk1[set][e_], fq[set][e_], sc[1], 0, 0, 0); } } while (0)
                AT_LDG(0, 0); __builtin_amdgcn_sched_barrier(0);
                AT_LDG(1, 1); __builtin_amdgcn_sched_barrier(0); AT_MMG(0); __builtin_amdgcn_sched_barrier(0);
                AT_LDG(0, 2); __builtin_amdgcn_sched_barrier(0); AT_MMG(1); __builtin_amdgcn_sched_barrier(0);
                AT_LDG(1, 3); __builtin_amdgcn_sched_barrier(0); AT_MMG(0); __builtin_amdgcn_sched_barrier(0);
                AT_MMG(1); __builtin_amdgcn_sched_barrier(0);
#undef AT_LDG
#undef AT_MMG
            }
#pragma unroll
            for (int t = 0; t < 2; ++t) {
                float tm = fmaxf(fmaxf(sc[t][0], sc[t][1]), sc[t][2]);
#pragma unroll
                for (int r = 3; r < 15; r += 2) tm = fmaxf(fmaxf(tm, sc[t][r]), sc[t][r + 1]);
                tm = fmaxf(tm, sc[t][15]);
                tm = fmaxf(tm, __shfl_xor(tm, 32));
                if (first) {
                    m_run = tm;
#pragma unroll
                    for (int r = 0; r < 16; ++r) { sc[0][r] -= tm; sc[1][r] -= tm; }
                    first = false;
                } else if (!__all(tm <= ATT_THR)) {
                    const float d = fmaxf(tm, 0.f), al = __builtin_amdgcn_exp2f(-d); m_run += d; l_run *= al;
#pragma unroll
                    for (int dt = 0; dt < 4; ++dt) o[dt] = o[dt] * al;
#pragma unroll
                    for (int r = 0; r < 16; ++r) sc[t][r] -= d;
                    if (t == 0) {
#pragma unroll
                        for (int r = 0; r < 16; ++r) sc[1][r] -= d;
                    }
                }
                float ps = 0.f;
#pragma unroll
                for (int r = 0; r < 16; ++r) { sc[t][r] = __builtin_amdgcn_exp2f(sc[t][r]); ps += sc[t][r]; }
                l_run += ps;
                bf16x8 pb[2];
#pragma unroll
                for (int s2 = 0; s2 < 2; ++s2) { u32x4 w; w.x = cvtpk(sc[t][8 * s2 + 0], sc[t][8 * s2 + 1]); w.y = cvtpk(sc[t][8 * s2 + 2], sc[t][8 * s2 + 3]); w.z = cvtpk(sc[t][8 * s2 + 4], sc[t][8 * s2 + 5]); w.w = cvtpk(sc[t][8 * s2 + 6], sc[t][8 * s2 + 7]); pb[s2] = __builtin_bit_cast(bf16x8, w); }
                {
                    v4i16_t vl[2][2], vh[2][2];
#define AT_LDV(set, dt) do { _Pragma("unroll") for (int s2_ = 0; s2_ < 2; ++s2_) { vl[set][s2_] = vtr(Vb + va[dt][0] + (32 * t + 16 * s2_) * 256); vh[set][s2_] = vtr(Vb + va[dt][1] + (32 * t + 16 * s2_) * 256); } } while (0)
#define AT_MMV(set, dt) do { _Pragma("unroll") for (int s2_ = 0; s2_ < 2; ++s2_) { const bf16x8 vf_ = (bf16x8){vl[set][s2_][0], vl[set][s2_][1], vl[set][s2_][2], vl[set][s2_][3], vh[set][s2_][0], vh[set][s2_][1], vh[set][s2_][2], vh[set][s2_][3]}; \
                        o[dt] = __builtin_amdgcn_mfma_f32_32x32x16_bf16(vf_, pb[s2_], o[dt], 0, 0, 0); } } while (0)
                    AT_LDV(0, 0); __builtin_amdgcn_sched_barrier(0);
                    AT_LDV(1, 1); __builtin_amdgcn_sched_barrier(0); AT_MMV(0, 0); __builtin_amdgcn_sched_barrier(0);
                    AT_LDV(0, 2); __builtin_amdgcn_sched_barrier(0); AT_MMV(1, 1); __builtin_amdgcn_sched_barrier(0);
                    AT_LDV(1, 3); __builtin_amdgcn_sched_barrier(0); AT_MMV(0, 2); __builtin_amdgcn_sched_barrier(0);
                    AT_MMV(1, 3); __builtin_amdgcn_sched_barrier(0);
#undef AT_LDV
#undef AT_MMV
                }
            }
        }
    }
    int ln = lane; asm volatile("" : "+v"(ln));
    const int r32e = ln & 31, hie = ln >> 5, drowe = ln >> 4, dslote = ln & 15;
    const float lt = l_run + __shfl_xor(l_run, 32), inv = 1.0f / lt;
    float ss = 0.f;
#pragma unroll
    for (int dt = 0; dt < 4; ++dt)
#pragma unroll
        for (int rg = 0; rg < 4; ++rg) {
            const float a0 = o[dt][4 * rg] * inv, a1 = o[dt][4 * rg + 1] * inv, a2 = o[dt][4 * rg + 2] * inv, a3 = o[dt][4 * rg + 3] * inv;
            ss += (a0 * a0 + a1 * a1) + (a2 * a2 + a3 * a3);
            u32x2 w; w.x = cvtpk(a0, a1); w.y = cvtpk(a2, a3);
            *(LAS u32x2*)(Qw + off_b(r32e, 4 * dt + rg) + 8 * hie) = w;
        }
    ss += __shfl_xor(ss, 32);
    const size_t q0 = (size_t)b * SEQ + 64 * c + 32 * (wid & 1);
    if (hie == 0) SSA[(q0 + r32e) * 8 + h] = ss;
    LDS_WAIT(); asm volatile("" ::: "memory");
#pragma unroll
    for (int i = 0; i < 8; ++i) { const int row = 4 * i + drowe; const u32x4 v = *(const LAS u32x4*)(Qw + off_b(row, dslote));
        *(u32x4*)(MIX + blk_off(q0 + row, h * HD + dslote * 8, DM)) = v; }
    LDS_WAIT(); __builtin_amdgcn_s_barrier(); asm volatile("" ::: "memory");
#undef AT_DMA
}

constexpr int GM_W = 0, GM_Z = 32768, GM_U = 98304;
__device__ __forceinline__ void gmlp_phase(const Frame& F, const bf16_t* U, const bf16_t* ZN, const bf16_t* WSP, const float* bsp, bf16_t* MIX, float* SSG) {
    int lane_ = F.lane; asm volatile("" : "+v"(lane_));
    const int lane = lane_, wid = F.wave, tid = wid * 64 + lane, r32 = lane & 31, hi = lane >> 5;
    const int tt = wid & 3, chh = wid >> 2, trow = 32 * tt + r32;
    const unsigned blk = (lane >> 4) & 1, q4 = (lane & 15) >> 2, p4 = lane & 3;
    constexpr int NU = NBATCH * 16 * 8;
    const int srow = tid >> 4, sch = tid & 15;
    int u = F.vcu;
    if (u >= NU) return;
    const int g = u & 7;
    u32x4 zt[4], ut[4];
    { const int nb = (u >> 3) & 15, b = u >> 7; const size_t ro = ((size_t)b * SEQ + 128 * nb + srow) * AW + (u & 7) * HD + sch * 8;
#pragma unroll
        for (int i = 0; i < 4; ++i) { zt[i] = *(const u32x4*)(ZN + ro + (size_t)(32 * i) * AW); ut[i] = *(const u32x4*)(U + ro + (size_t)(32 * i) * AW); } }
    {
#pragma unroll
        for (int i = 0; i < 4; ++i) { const u32x4 w = *(const u32x4*)(WSP + ((size_t)g * 128 + srow + 32 * i) * 128 + sch * 8); *(LAS u32x4*)(F.lds + GM_W + off_b(srow + 32 * i, sch)) = w; } }
    unsigned wa[8];
#pragma unroll
    for (int ks = 0; ks < 8; ++ks) wa[ks] = GM_W + off_b(trow, 2 * ks + hi);
    for (int it = 0; u < NU; u += F.G, ++it) {
        const int gu = u & 7, nb = (u >> 3) & 15, b = u >> 7;
        LAS unsigned char* zl = F.lds + GM_Z + (it & 1) * 32768; LAS unsigned char* ul = F.lds + GM_U;
#pragma unroll
        for (int i = 0; i < 4; ++i) { *(LAS u32x4*)(zl + off_b(srow + 32 * i, sch)) = zt[i]; *(LAS u32x4*)(ul + off_b(srow + 32 * i, sch)) = ut[i]; }
        const int un = u + F.G;
        if (un < NU) { const int nb2 = (un >> 3) & 15, b2 = un >> 7; const size_t ro = ((size_t)b2 * SEQ + 128 * nb2 + srow) * AW + (un & 7) * HD + sch * 8;
#pragma unroll
            for (int i = 0; i < 4; ++i) { zt[i] = *(const u32x4*)(ZN + ro + (size_t)(32 * i) * AW); ut[i] = *(const u32x4*)(U + ro + (size_t)(32 * i) * AW); } }
        const size_t row0 = (size_t)b * SEQ + 128 * nb, grow = row0 + trow;
        const float bs = bsp[gu * 128 + trow];
        LDS_WAIT(); __builtin_amdgcn_s_barrier(); asm volatile("" ::: "memory");
        f32x16 acc[2]; acc[0] = (f32x16){}; acc[1] = (f32x16){};
#pragma unroll
        for (int ks = 0; ks < 8; ++ks) {
            if (ks < 4 || tt >= 2) {
                const bf16x8 wf = *(const LAS bf16x8*)(F.lds + wa[ks]);
#pragma unroll
                for (int c2 = 0; c2 < 2; ++c2) { const int ct = 2 * chh + c2;
                    const v4i16_t lo = vtr(zl + off_b(16 * ks + 8 * hi + q4, 4 * ct + 2 * blk + (p4 >> 1)) + 8 * (p4 & 1));
                    const v4i16_t hh = vtr(zl + off_b(16 * ks + 8 * hi + 4 + q4, 4 * ct + 2 * blk + (p4 >> 1)) + 8 * (p4 & 1));
                    const bf16x8 zf = (bf16x8){lo[0], lo[1], lo[2], lo[3], hh[0], hh[1], hh[2], hh[3]};
                    acc[c2] = __builtin_amdgcn_mfma_f32_32x32x16_bf16(zf, wf, acc[c2], 0, 0, 0); }
            }
        }
        float ss = 0.f;
#pragma unroll
        for (int c2 = 0; c2 < 2; ++c2)
#pragma unroll
            for (int rg = 0; rg < 4; ++rg) { const int c0 = 32 * (2 * chh + c2) + 8 * rg + 4 * hi;
                LAS u32x2* up = (LAS u32x2*)(ul + off_b(trow, c0 >> 3) + 8 * ((c0 >> 2) & 1)); const u32x2 w0 = *up;
                const float o0 = __uint_as_float(w0.x << 16) * (acc[c2][4 * rg] + bs), o1 = __uint_as_float(w0.x & 0xffff0000u) * (acc[c2][4 * rg + 1] + bs);
                const float o2 = __uint_as_float(w0.y << 16) * (acc[c2][4 * rg + 2] + bs), o3 = __uint_as_float(w0.y & 0xffff0000u) * (acc[c2][4 * rg + 3] + bs);
                ss += (o0 * o0 + o1 * o1) + (o2 * o2 + o3 * o3);
                u32x2 w; w.x = cvtpk(o0, o1); w.y = cvtpk(o2, o3); *up = w; }
        ss += __shfl_xor(ss, 32);
        if (hi == 0) SSG[grow * 16 + gu * 2 + chh] = ss;
        LDS_WAIT(); __builtin_amdgcn_s_barrier(); asm volatile("" ::: "memory");
#pragma unroll
        for (int i = 0; i < 4; ++i) { const int t = srow + 32 * i; const u32x4 v = *(const LAS u32x4*)(ul + off_b(t, sch)); *(u32x4*)(MIX + blk_off(row0 + t, AW + gu * HD + sch * 8, DM)) = v; }
        LDS_WAIT(); __builtin_amdgcn_s_barrier(); asm volatile("" ::: "memory");
    }
}

constexpr int NPH = 8;
__global__ void __launch_bounds__(512, 2) mk_fwd(Args args) {
    extern __shared__ __attribute__((aligned(16))) unsigned char lds_raw[];
    Frame F;
    F.lds = (LAS unsigned char*)lds_raw;
    F.tid = threadIdx.x; F.lane = F.tid & 63; F.wave = __builtin_amdgcn_readfirstlane(F.tid >> 6);
    F.G = gridDim.x; { const int bx = blockIdx.x; F.vcu = (F.G % 8 == 0) ? (bx % 8) * (F.G / 8) + bx / 8 : bx; }
    unsigned char* ws = args.ws;
    unsigned* ctl = (unsigned*)(ws + WS_CTL);
    for (int u = F.tid; u < (LDS_BYTES - LDSCTL_OFF) / 4; u += 512) ((LAS unsigned*)(F.lds + LDSCTL_OFF))[u] = 0u;
    __syncthreads();
    XcdBarrier bar; bar.bar = ctl + 4096; bar.x = 0; bar.st = nullptr;
    if (MK_N_LAUNCHES == 1) bar = xcd_barrier_post(ctl + 4096, (volatile LAS unsigned*)(F.lds + MISC_OFF) + 8);
    const int lo = args.ph_lo, hi = args.ph_hi;
#ifndef MK_PHASE_MASK
#define MK_PHASE_MASK 255
#endif
#define IN(k) (((MK_PHASE_MASK >> (k)) & 1) && lo <= (k) && (k) < hi)
#ifndef MK_REP_MASK
#define MK_REP_MASK 0
#endif
#define REP(k) for (int rep_ = 0; rep_ < 1 + ((MK_REP_MASK >> (k)) & 1); ++rep_)
#define SEAM(k) do { if (IN(k) && IN((k) + 1)) xcd_barrier(bar); } while (0)

    const float* x = args.in[0]; const float* cnd = args.in[1]; const float* w_ada = args.in[2]; const float* b_ada = args.in[3]; const float* mix_g = args.in[4];
    const float* w_in = args.in[5]; const float* q_g = args.in[6]; const float* k_g = args.in[7]; const float* relb = args.in[8]; const float* gm_g = args.in[9];
    const float* w_sp = args.in[10]; const float* b_sp = args.in[11]; const float* ao_g = args.in[12]; const float* go_g = args.in[13]; const float* w_out = args.in[14];
    const float* ff_g = args.in[15]; const float* w_f1 = args.in[16]; const float* w_f2 = args.in[17];
    float* out = args.out;
    float* MOD = (float*)(ws + WS_MOD); float* SSA = (float*)(ws + WS_SSA); float* SSG = (float*)(ws + WS_SSG);
    bf16_t* WSP = (bf16_t*)(ws + WS_WSP); bf16_t* WIN = (bf16_t*)(ws + WS_WIN); bf16_t* WOUT = (bf16_t*)(ws + WS_WOUT); bf16_t* WF1 = (bf16_t*)(ws + WS_WF1); bf16_t* WF2 = (bf16_t*)(ws + WS_WF2);
    bf16_t* H = (bf16_t*)(ws + WS_H); bf16_t* QB = (bf16_t*)(ws + WS_Q); bf16_t* KB = (bf16_t*)(ws + WS_K); bf16_t* VB = (bf16_t*)(ws + WS_V); bf16_t* UB = (bf16_t*)(ws + WS_U); bf16_t* ZB = (bf16_t*)(ws + WS_ZN);
    bf16_t* MIX = (bf16_t*)(ws + WS_MIX); bf16_t* ACT = (bf16_t*)(ws + WS_ACT); bf16_t* X1 = (bf16_t*)(ws + WS_X1);
    const int gw = F.vcu * 8 + F.wave, NGW = F.G * 8;

    if (IN(0)) REP(0) {
        p0_ada(F, cnd, w_ada, b_ada, MOD);
        constexpr int I_IN = (DM / 64) * (INW / 32), I_OUT = (DM / 64) * (DM / 32), I_F1 = (DM / 64) * (DFF / 32), I_F2 = (DFF / 64) * (DM / 32), I_SP = 64;
        auto mk = [&](int it) { TrItem t; int r = it;
            if (r < I_IN) { t = TrItem{w_in, WIN, DM, INW, r, nullptr, nullptr}; return t; } r -= I_IN;
            if (r < I_OUT) { t = TrItem{w_out, WOUT, DM, DM, r, ao_g, go_g}; return t; } r -= I_OUT;
            if (r < I_F1) { t = TrItem{w_f1, WF1, DM, DFF, r, nullptr, nullptr}; return t; } r -= I_F1;
            t = TrItem{w_f2, WF2, DFF, DM, r, nullptr, nullptr}; return t; };
        constexpr int NTR = I_IN + I_OUT + I_F1 + I_F2;
        for (int it = gw; it < NTR; it += 2 * NGW) {
            const TrItem ta = mk(it); f32x4 va[8], vb[8]; tr_load(ta, F.lane, va);
            const int it2 = it + NGW; TrItem tb = ta; if (it2 < NTR) { tb = mk(it2); tr_load(tb, F.lane, vb); }
            tr_store(ta, F.lane, va); if (it2 < NTR) tr_store(tb, F.lane, vb);
        }
        for (int r = gw; r < I_SP; r += NGW) {
#pragma unroll
            for (int i = 0; i < 8; ++i) { const int e = r * 2048 + (i * 64 + F.lane) * 4, t = (e >> 7) & 127, s = e & 127;
                f32x4 v = *(const f32x4*)(w_sp + e); if ((t >> 6) < (s >> 6)) v = (f32x4){0.f, 0.f, 0.f, 0.f};
                u32x2 w; w.x = cvtpk(v[0], v[1]); w.y = cvtpk(v[2], v[3]); *(u32x2*)(WSP + e) = w; }
        }
    }
    SEAM(0);

    if (IN(1)) REP(1) {
        for (int m = gw; m < MROWS; m += 2 * NGW) { const int m2 = m + NGW; f32x4 va[8], vb[8];
            nm_load(x + (size_t)m * DM, F.lane, va); if (m2 < MROWS) nm_load(x + (size_t)m2 * DM, F.lane, vb);
            { const float* mb = MOD + (size_t)(m >> 11) * NMOD; nm_finish(va, mix_g, mb, mb + DM, H, m, F.lane); }
            if (m2 < MROWS) { const float* mb = MOD + (size_t)(m2 >> 11) * NMOD; nm_finish(vb, mix_g, mb, mb + DM, H, m2, F.lane); } }
    }
    SEAM(1);

    if (IN(2)) REP(2) {
        pg8::Gemm g{H, WIN, MROWS, INW, DM}; pg8::StaticOrder S; S.init(MROWS, INW, F.G, (int)blockIdx.x, 4);
        pg8::EpiProj E{QB, (size_t)(WS_K - WS_Q) / 2, q_g, k_g, gm_g, (LAS float*)(F.lds + XCH_OFF)};
        pg8::gemm_phase<pg8::EpiProj, pg8::StaticOrder>(F.lds, g, S, E);
    }
    SEAM(2);

    if (IN(3)) REP(3) {
        for (int u = F.vcu; u < NBATCH * NH * 8; u += F.G) { const int g4 = u & 7, h = (u >> 3) & 7, b = u >> 6;
            attn_unit(F, QB, KB, VB, MIX, SSA, relb, b, h, g4); }
        gmlp_phase(F, UB, ZB, WSP, b_sp, MIX, SSG);
    }
    SEAM(3);

    if (IN(4)) REP(4) {
        pg8::Gemm g{MIX, WOUT, MROWS, DM, DM}; pg8::StaticOrder S; S.init(MROWS, DM, F.G, (int)blockIdx.x, 4);
        pg8::EpiRes1 E{x, X1, MOD, SSA, SSG, (LAS float*)(F.lds + XCH_OFF)};
        { pg8::Unit uu; for (int i = F.tid >> 8; i < 4 && S.next(i, uu); i += 2) E.fill(uu, i, F.tid & 255); }
        __syncthreads();
        pg8::gemm_phase<pg8::EpiRes1, pg8::StaticOrder>(F.lds, g, S, E);
    }
    SEAM(4);

    if (IN(5)) REP(5) {
        for (int m = gw; m < MROWS; m += 4 * NGW) { u32x4 ra[4][4];
#pragma unroll
            for (int q = 0; q < 4; ++q) { const int mq = m + q * NGW; if (mq < MROWS) nmb_load(X1 + (size_t)mq * DM, F.lane, ra[q]); }
#pragma unroll
            for (int q = 0; q < 4; ++q) { const int mq = m + q * NGW; if (mq < MROWS) { const float* mb = MOD + (size_t)(mq >> 11) * NMOD; nmb_finish(ra[q], ff_g, mb + 3 * DM, mb + 4 * DM, H, mq, F.lane); } } }
    }
    SEAM(5);

    if (IN(6)) REP(6) {
        pg8::Gemm g{H, WF1, MROWS, DFF, DM}; pg8::StaticOrder S; S.init(MROWS, DFF, F.G, (int)blockIdx.x, 4);
        pg8::EpiRelu2 E{ACT, DFF};
        pg8::gemm_phase<pg8::EpiRelu2, pg8::StaticOrder>(F.lds, g, S, E);
    }
    SEAM(6);

    if (IN(7)) REP(7) {
        pg8::Gemm g{ACT, WF2, MROWS, DM, DFF}; pg8::StaticOrder S; S.init(MROWS, DM, F.G, (int)blockIdx.x, 4);
        pg8::EpiRes2 E{X1, out, MOD};
        pg8::gemm_phase<pg8::EpiRes2, pg8::StaticOrder>(F.lds, g, S, E);
    }
#undef IN
#undef SEAM
}

extern "C" void kernel_launch(void* const* d_in, const int* in_sizes, int n_in, void* d_out, int out_size, void* d_ws, size_t ws_size, hipStream_t stream) {
    static int grid = 0;
    if (grid == 0) {
        if (n_in != 18 || in_sizes[0] != MROWS * DM || out_size != MROWS * DM || ws_size < WS_END) {
            fprintf(stderr, "kernel_launch: unexpected shapes (n_in %d, in0 %d, out %d, ws %zu); nothing launched\n", n_in, n_in > 0 ? in_sizes[0] : -1, out_size, ws_size); grid = -1; return; }
        int dev = 0, cus = 0, per_cu = 0;
        if (hipGetDevice(&dev) != hipSuccess || hipDeviceGetAttribute(&cus, hipDeviceAttributeMultiprocessorCount, dev) != hipSuccess) { fprintf(stderr, "kernel_launch: device query failed\n"); grid = -1; return; }
        if (hipFuncSetAttribute((const void*)mk_fwd, hipFuncAttributeMaxDynamicSharedMemorySize, LDS_BYTES) != hipSuccess) { fprintf(stderr, "kernel_launch: hipFuncSetAttribute failed\n"); grid = -1; return; }
        if (hipOccupancyMaxActiveBlocksPerMultiprocessor(&per_cu, (const void*)mk_fwd, 512, LDS_BYTES) != hipSuccess || per_cu < 1) {
            fprintf(stderr, "kernel_launch: occupancy query reports %d workgroups per CU\n", per_cu); per_cu = 1; }
        (void)hipGetLastError();
        grid = cus;
    }
    if (grid < 0) return;
    (void)hipMemsetAsync((char*)d_ws + WS_CTL, 0, CTL_ZERO_BYTES, stream);
    Args a{};
    for (int i = 0; i < 18; ++i) a.in[i] = (const float*)d_in[i];
    a.out = (float*)d_out; a.ws = (unsigned char*)d_ws;
#ifndef MK_PROG
#define MK_PROG {0, 1, 2, 3, 4, 5, 6, 7}
#endif
    static const int prog[] = MK_PROG; const int nprog = (MK_N_LAUNCHES == 1) ? 1 : (int)(sizeof(prog) / sizeof(prog[0]));
    for (int li = 0; li < nprog; ++li) {
        if (MK_N_LAUNCHES == 1) { a.ph_lo = 0; a.ph_hi = NPH; } else { a.ph_lo = prog[li]; a.ph_hi = prog[li] + 1; }
        a.li = li;
        hipLaunchKernelGGL(mk_fwd, dim3(grid), dim3(512), LDS_BYTES, stream, a);
        const hipError_t le = hipPeekAtLastError();
        if (le != hipSuccess) { fprintf(stderr, "kernel_launch: launch %d failed: %s\n", li, hipGetErrorName(le)); break; }
    }
}
```
